# Optimizing an MI355X kernel written in HIP

```python
import jax
import jax.numpy as jnp
from jax import lax
import numpy as np

D_MODEL = 1024
BATCH = 8
SEQ = 2048
DEPTH = 2

HEAD_DIM = 64
ROT_DIM = HEAD_DIM // 4
ROPE_THETA = 500000.0
DIL_GROUPS = ((128, 1), (512, 4), (2048, 16))
HEADS_PER_DIL_GROUP = 2
N_HEADS_A = len(DIL_GROUPS) * HEADS_PER_DIL_GROUP
N_HEADS_B = 6
N_HEADS_M = 4
MOBA_BLOCK = 256
MOBA_TOPK = 3
MOBA_Q_CHUNK = 32
N_MEM = 256
D_FF = 4 * D_MODEL
N_BRANCH = 3
WIDTH_A = N_HEADS_A * HEAD_DIM
WIDTH_A_OUT = HEADS_PER_DIL_GROUP * HEAD_DIM
WIDTH_B = N_HEADS_B * HEAD_DIM
WIDTH_M = N_HEADS_M * HEAD_DIM
D_IN = 3 * WIDTH_A + 3 * WIDTH_B + WIDTH_M + N_BRANCH * D_MODEL
RMS_EPS = 1e-6
NEG_INF = -1e30

kernel_name = 'hybrid_dilated_moba_memory_block'


def rms_norm(x, g):
    xf = x.astype(jnp.float32)
    y = xf * lax.rsqrt(jnp.mean(xf * xf, axis=-1, keepdims=True) + RMS_EPS)
    return (y * g.astype(jnp.float32)).astype(x.dtype)


def partial_rope(x, pos):
    inv_freq = 1.0 / (ROPE_THETA ** (jnp.arange(0, ROT_DIM, 2, dtype=jnp.float32) / ROT_DIM))
    ang = pos.astype(jnp.float32)[:, None] * inv_freq[None, :]
    cos = jnp.cos(ang)[None, :, None, :]
    sin = jnp.sin(ang)[None, :, None, :]
    xr = x[..., :ROT_DIM].astype(jnp.float32)
    x1, x2 = xr[..., :ROT_DIM // 2], xr[..., ROT_DIM // 2:]
    rot = jnp.concatenate([x1 * cos - x2 * sin, x2 * cos + x1 * sin], axis=-1).astype(x.dtype)
    return jnp.concatenate([rot, x[..., ROT_DIM:]], axis=-1)


def dilated_window_attn(q, k, v, window, dilation):
    B, S, H, Dh = q.shape
    n = window // dilation
    span = n * dilation
    Sp = -(-S // span) * span
    L = Sp // dilation
    nblk = L // n

    def to_blocks(t):
        t = jnp.pad(t, ((0, 0), (0, Sp - S), (0, 0), (0, 0)))
        t = t.reshape(B, L, dilation, H, Dh).transpose(0, 2, 3, 1, 4)
        return t.reshape(B, dilation, H, nblk, n, Dh)

    def with_prev(t):
        prev = jnp.pad(t, ((0, 0), (0, 0), (0, 0), (1, 0), (0, 0), (0, 0)))[:, :, :, :-1]
        return jnp.concatenate([prev, t], axis=-2)

    qb = to_blocks(q)
    kk = with_prev(to_blocks(k))
    vv = with_prev(to_blocks(v))
    s = jnp.einsum('brhnqd,brhnkd->brhnqk', qb, kk).astype(jnp.float32)
    i = jnp.arange(n)[:, None]
    j = jnp.arange(2 * n)[None, :]
    band = (j >= i) & (j <= i + n)
    first = (jnp.arange(nblk) == 0)[:, None, None] & (j < n)[None]
    mask = band[None] & ~first
    s = jnp.where(mask, s, NEG_INF)
    mx = jnp.max(s, axis=-1, keepdims=True)
    p = jnp.exp(s - mx)
    den = jnp.sum(p, axis=-1, keepdims=True)
    o = jnp.einsum('brhnqk,brhnkd->brhnqd', (p / den).astype(v.dtype), vv)
    lse = (mx + jnp.log(den))[..., 0]
    o = o.reshape(B, dilation, H, L, Dh).transpose(0, 3, 1, 2, 4).reshape(B, Sp, H, Dh)[:, :S]
    lse = lse.reshape(B, dilation, H, L).transpose(0, 3, 1, 2).reshape(B, Sp, H)[:, :S]
    return o, lse


def dilated_mixer(q, k, v):
    B, S = q.shape[0], q.shape[1]
    outs, lses = [], []
    for g, (win, dil) in enumerate(DIL_GROUPS):
        sl = slice(g * HEADS_PER_DIL_GROUP, (g + 1) * HEADS_PER_DIL_GROUP)
        o, l = dilated_window_attn(q[:, :, sl], k[:, :, sl], v[:, :, sl], win, dil)
        outs.append(o)
        lses.append(l)
    w = jax.nn.softmax(jnp.stack(lses, axis=0), axis=0)
    o = jnp.einsum('gbsh,gbshd->bshd', w, jnp.stack(outs, axis=0).astype(jnp.float32))
    return o.astype(q.dtype).reshape(B, S, WIDTH_A_OUT)


def moba_attn(q, k, v):
    B, S, H, Dh = q.shape
    nB = -(-S // MOBA_BLOCK)
    Sp = nB * MOBA_BLOCK
    padw = ((0, 0), (0, Sp - S), (0, 0), (0, 0))
    qt = jnp.pad(q, padw).transpose(0, 2, 1, 3)
    kt = jnp.pad(k, padw).transpose(0, 2, 1, 3)
    vt = jnp.pad(v, padw).transpose(0, 2, 1, 3)
    kb = kt.reshape(B, H, nB, MOBA_BLOCK, Dh)
    vb = vt.reshape(B, H, nB, MOBA_BLOCK, Dh)
    qpos = jnp.arange(Sp, dtype=jnp.int32)
    qblk = qpos // MOBA_BLOCK
    own = jnp.broadcast_to(qblk[None, None, :, None], (B, H, Sp, 1))
    n_sel = min(MOBA_TOPK, nB - 1)
    if n_sel > 0:
        kmean = jnp.mean(kb.astype(jnp.float32), axis=3)
        gate = jnp.einsum('bhsd,bhnd->bhsn', qt.astype(jnp.float32), kmean)
        past = jnp.arange(nB, dtype=jnp.int32)[None, :] < qblk[:, None]
        _, top_idx = lax.top_k(jnp.where(past, gate, NEG_INF), n_sel)
        top_ok = jnp.take_along_axis(jnp.broadcast_to(past, gate.shape), top_idx, axis=-1)
        blk_idx = jnp.concatenate([top_idx.astype(jnp.int32), own], axis=-1)
        blk_ok = jnp.concatenate([top_ok, jnp.ones_like(own, dtype=bool)], axis=-1)
    else:
        blk_idx = own
        blk_ok = jnp.ones_like(own, dtype=bool)
    n_tot = blk_idx.shape[-1]
    nc = Sp // MOBA_Q_CHUNK
    C = MOBA_Q_CHUNK
    q_c = qt.reshape(B, H, nc, C, Dh).transpose(2, 0, 1, 3, 4)
    idx_c = blk_idx.reshape(B, H, nc, C, n_tot).transpose(2, 0, 1, 3, 4)
    ok_c = blk_ok.reshape(B, H, nc, C, n_tot).transpose(2, 0, 1, 3, 4)
    pos_c = qpos.reshape(nc, C)
    bi = jnp.arange(B)[:, None, None, None]
    hi = jnp.arange(H)[None, :, None, None]
    offs = jnp.arange(MOBA_BLOCK, dtype=jnp.int32)

    def chunk(args):
        qc, ic, okc, pc = args
        ks = kb[bi, hi, ic]
        vs = vb[bi, hi, ic]
        s = jnp.einsum('bhcd,bhcnkd->bhcnk', qc, ks).astype(jnp.float32)
        kpos = ic[..., None] * MOBA_BLOCK + offs
        mask = okc[..., None] & (kpos <= pc[None, None, :, None, None])
        s = jnp.where(mask, s, NEG_INF).reshape(B, H, C, n_tot * MOBA_BLOCK)
        p = jax.nn.softmax(s, axis=-1).reshape(B, H, C, n_tot, MOBA_BLOCK)
        return jnp.einsum('bhcnk,bhcnkd->bhcd', p.astype(vs.dtype), vs)

    o = lax.map(chunk, (q_c, idx_c, ok_c, pos_c))
    o = o.transpose(1, 2, 0, 3, 4).reshape(B, H, Sp, Dh)
    return o.transpose(0, 2, 1, 3)[:, :S]


def memory_attn(q, mem_n, w_mkv):
    B, S = q.shape[0], q.shape[1]
    M = mem_n.shape[1]
    kv = (mem_n @ w_mkv).reshape(B, M, 2, N_HEADS_M, HEAD_DIM)
    s = jnp.einsum('bshd,bmhd->bhsm', q, kv[:, :, 0]).astype(jnp.float32)
    p = jax.nn.softmax(s, axis=-1)
    o = jnp.einsum('bhsm,bmhd->bshd', p.astype(q.dtype), kv[:, :, 1])
    return o.reshape(B, S, WIDTH_M)


def hybrid_layer(x, mem, pos, g_mix, w_in, w_pa, w_pb, w_pm, w_o, g_mem, w_mkv, g_mlp, w_up, w_down):
    B, S, _ = x.shape
    scale = HEAD_DIM ** -0.5
    h = rms_norm(x, g_mix)
    z = h @ w_in
    o1 = 3 * WIDTH_A
    o2 = o1 + 3 * WIDTH_B
    o3 = o2 + WIDTH_M
    qkv_a = z[..., :o1].reshape(B, S, 3, N_HEADS_A, HEAD_DIM)
    qkv_b = z[..., o1:o2].reshape(B, S, 3, N_HEADS_B, HEAD_DIM)
    q_m = z[..., o2:o3].reshape(B, S, N_HEADS_M, HEAD_DIM)
    gates = jax.nn.sigmoid(z[..., o3:].reshape(B, S, N_BRANCH, D_MODEL))
    o_a = dilated_mixer(partial_rope(qkv_a[:, :, 0], pos) * scale,
                        partial_rope(qkv_a[:, :, 1], pos), qkv_a[:, :, 2])
    o_b = moba_attn(partial_rope(qkv_b[:, :, 0], pos) * scale,
                    partial_rope(qkv_b[:, :, 1], pos), qkv_b[:, :, 2]).reshape(B, S, WIDTH_B)
    o_m = memory_attn(q_m * scale, rms_norm(mem, g_mem), w_mkv)
    y = (gates[:, :, 0] * (o_a @ w_pa) + gates[:, :, 1] * (o_b @ w_pb)
         + gates[:, :, 2] * (o_m @ w_pm))
    x = x + y @ w_o
    hm = rms_norm(x, g_mlp)
    x = x + jnp.square(jax.nn.relu(hm @ w_up)) @ w_down
    return x


def setup_inputs(seed: int = 0) -> dict:
    key = jax.random.key(seed)
    ks = jax.random.split(key, 16)

    def nrm(k, shape, fan_in):
        return jax.random.normal(k, shape, jnp.float32) * (fan_in ** -0.5)

    def gain(k, shape):
        return 1.0 + 0.05 * jax.random.normal(k, shape, jnp.float32)

    return {
        'x': jax.random.normal(ks[0], (BATCH, SEQ, D_MODEL), jnp.float32),
        'mem': jax.random.normal(ks[1], (BATCH, N_MEM, D_MODEL), jnp.float32),
        'norm_mix': gain(ks[2], (DEPTH, D_MODEL)),
        'w_in': nrm(ks[3], (DEPTH, D_MODEL, D_IN), D_MODEL),
        'w_proj_a': nrm(ks[4], (DEPTH, WIDTH_A_OUT, D_MODEL), WIDTH_A_OUT),
        'w_proj_b': nrm(ks[5], (DEPTH, WIDTH_B, D_MODEL), WIDTH_B),
        'w_proj_m': nrm(ks[6], (DEPTH, WIDTH_M, D_MODEL), WIDTH_M),
        'w_out': nrm(ks[7], (DEPTH, D_MODEL, D_MODEL), D_MODEL),
        'norm_mem': gain(ks[8], (DEPTH, D_MODEL)),
        'w_mem_kv': nrm(ks[9], (DEPTH, D_MODEL, 2 * WIDTH_M), D_MODEL),
        'norm_mlp': gain(ks[10], (DEPTH, D_MODEL)),
        'w_up': nrm(ks[11], (DEPTH, D_MODEL, D_FF), D_MODEL),
        'w_down': nrm(ks[12], (DEPTH, D_FF, D_MODEL), D_FF),
        'norm_final': gain(ks[13], (D_MODEL,)),
    }


def reference(x, mem, norm_mix, w_in, w_proj_a, w_proj_b, w_proj_m, w_out, norm_mem, w_mem_kv,
              norm_mlp, w_up, w_down, norm_final):
    pos = jnp.arange(x.shape[1], dtype=jnp.int32)
    for l in range(DEPTH):
        x = hybrid_layer(x, mem, pos, norm_mix[l], w_in[l], w_proj_a[l], w_proj_b[l], w_proj_m[l],
                         w_out[l], norm_mem[l], w_mem_kv[l], norm_mlp[l], w_up[l], w_down[l])
    return rms_norm(x, norm_final)
```

```cpp
#include <hip/hip_runtime.h>
#include <cstdio>
#include <cstdint>
namespace pg8 {
#define PG8_LAS __attribute__((address_space(3)))
typedef unsigned short bf16_t;
typedef short bf16x8 __attribute__((ext_vector_type(8)));
typedef float f32x4 __attribute__((ext_vector_type(4)));
typedef unsigned u32x4 __attribute__((ext_vector_type(4)));
constexpr int BM = 256, BK = 64, HALF = 128, HTB = HALF * BK * 2  , STAGE_BYTES = 8 * HTB, NXCD = 8, WGM = 8;

__host__ __device__ __forceinline__ int lds_byte(int r, int c) { const int st = (r >> 4) * 2 + (c >> 5), rr = r & 15, cc = c & 31, ob = rr * 64 + cc * 2; return st * 1024 + (ob ^ (((ob >> 9) & 1) << 5)); }
__host__ __device__ __forceinline__ void stage_rc(int b, int& R, int& C) { const int st = b / 1024, sb = b % 1024, swz = sb ^ (((sb >> 9) & 1) << 5); R = (st >> 1) * 16 + swz / 64; C = (st & 1) * 32 + (swz % 64) / 2; }
__host__ __device__ __forceinline__ int perm32(int rho) { const int n = rho >> 4, i = rho & 15; return 8 * (i >> 2) + 4 * n + (i & 3); }

struct Unit { int pm, pn; };
struct Gemm { const bf16_t* A; const bf16_t* Bt; int lda, ldb, K; };

struct StaticOrder {
    int nM, nN, nwg, G, c;
    __host__ __device__ void init(int M, int N, int G_, int c_) { nM = M / BM; nN = N / BM; nwg = nM * nN; G = G_; c = c_; }
    __host__ __device__ bool next(int i, Unit& u) const {
        const long L = (long)i * G + c; if (L >= nwg) return false;
        int wgid = (int)L; { const int q = nwg / NXCD, r = nwg % NXCD, xcd = wgid % NXCD, off = wgid / NXCD; wgid = (xcd < r ? xcd * (q + 1) : r * (q + 1) + (xcd - r) * q) + off; }
        const int nig = WGM * nN, gid = wgid / nig, fm = gid * WGM, gsz = (nM - fm) < WGM ? (nM - fm) : WGM;
        u.pm = fm + ((wgid % nig) % gsz); u.pn = (wgid % nig) / gsz; return true;
    }
    __device__ __forceinline__ void a_ready(const Unit&) const {}
    __device__ __forceinline__ void done(const Unit&) const {}
};

typedef float f32x2c_t __attribute__((ext_vector_type(2))); typedef __bf16 bf16x2c_t __attribute__((ext_vector_type(2)));
__device__ __forceinline__ unsigned cvt_pk_bf16(float lo, float hi) { const f32x2c_t v = {lo, hi}; const bf16x2c_t b = __builtin_convertvector(v, bf16x2c_t); return __builtin_bit_cast(unsigned, b); }
typedef float f32x2 __attribute__((ext_vector_type(2)));
template <class Epi, class Sched, bool ALIGN_EPI = false, bool SP2 = false>
__device__ __forceinline__ void gemm_phase(PG8_LAS unsigned char* lds, const Gemm g, const Sched& S, const Epi& E) {
    int tid_ = threadIdx.x; asm volatile("" : "+v"(tid_));
    const int tid = tid_, wid = __builtin_amdgcn_readfirstlane(tid >> 6), lane = tid & 63, wr = wid >> 2, wc = wid & 3, fr = lane & 15, fq = lane >> 4;
    const int K = g.K, nt = K / BK;
    unsigned voffA[2], voffB[2];
#pragma unroll
    for (int i = 0; i < 2; ++i) { int R, C; stage_rc(tid * 16 + i * 8192, R, C); const int Rb = Epi::PERM ? ((R & ~31) + perm32(R & 31)) : R;
        voffA[i] = (unsigned)(R * g.lda + C) * 2u; voffB[i] = (unsigned)(Rb * g.ldb + C) * 2u; }
    const size_t kstep = (size_t)(BK * 2);
    const size_t hstepA = (size_t)HALF * g.lda * 2, hstepB = (size_t)HALF * g.ldb * 2;
    const size_t tstepA = 2 * hstepA, tstepB = 2 * hstepB;
    const unsigned ldsw = (unsigned)wid * 1024u;
    const int aoff = lds_byte(wr * 64 + fr, fq * 8), boff = lds_byte(wc * 32 + fr, fq * 8);
#define PG8_SA(b, h) (((b) * 2 + (h)) * HTB)
#define PG8_SB(b, h) ((4 + (b) * 2 + (h)) * HTB)
#define PG8_STAGE(bufoff, gbase, voff) do { _Pragma("unroll") for (int _i = 0; _i < 2; ++_i) \
        __builtin_amdgcn_global_load_lds((const unsigned*)((const char*)(gbase) + (voff)[_i]), (PG8_LAS unsigned*)(lds + (bufoff) + ldsw + _i * 8192), 16, 0, 0); } while (0)
#define PG8_LDA(dst, b, h) do { _Pragma("unroll") for (int m = 0; m < 4; ++m) _Pragma("unroll") for (int k = 0; k < 2; ++k) dst[m][k] = *(const PG8_LAS bf16x8*)(lds + PG8_SA(b, h) + aoff + m * 2048 + k * 1024); } while (0)
#define PG8_LDB(dst, b, h) do { _Pragma("unroll") for (int n = 0; n < 2; ++n) _Pragma("unroll") for (int k = 0; k < 2; ++k) dst[n][k] = *(const PG8_LAS bf16x8*)(lds + PG8_SB(b, h) + boff + n * 2048 + k * 1024); } while (0)
#define PG8_MMA(ai, bj, At, Bt) do { __builtin_amdgcn_s_setprio(1); _Pragma("unroll") for (int m = 0; m < 4; ++m) _Pragma("unroll") for (int n = 0; n < 2; ++n) _Pragma("unroll") for (int k = 0; k < 2; ++k) \
        acc[ai][bj][m][n] = __builtin_amdgcn_mfma_f32_16x16x32_bf16(Bt[n][k], At[m][k], acc[ai][bj][m][n], 0, 0, 0); __builtin_amdgcn_s_setprio(0); } while (0)
#define PG8_WAIT_V(n) asm volatile("s_waitcnt vmcnt(" #n ")" ::: "memory")
#define PG8_WAIT_L(n) asm volatile("s_waitcnt lgkmcnt(" #n ")" ::: "memory")
#define PG8_BAR __builtin_amdgcn_s_barrier()
#define PG8_SCHED __builtin_amdgcn_sched_barrier(0)
    Unit cur, nxt; int ui = 0;
    if (!S.next(0, cur)) return;
    f32x4 acc[2][2][4][2];
#pragma unroll
    for (int a = 0; a < 2; ++a)
#pragma unroll
        for (int b = 0; b < 2; ++b)
#pragma unroll
            for (int m = 0; m < 4; ++m)
#pragma unroll
                for (int n = 0; n < 2; ++n) acc[a][b][m][n] = (f32x4){0.f, 0.f, 0.f, 0.f};
    bf16x8 At[4][2], B0[2][2], B1[2][2];
    const char* cA = (const char*)g.A + (size_t)cur.pm * tstepA; const char* cB = (const char*)g.Bt + (size_t)cur.pn * tstepB;
    S.a_ready(cur);
    if constexpr (SP2) {
        PG8_STAGE(PG8_SB(0, 0), cB, voffB); PG8_STAGE(PG8_SB(0, 1), cB + hstepB, voffB); PG8_STAGE(PG8_SA(0, 0), cA, voffA); PG8_STAGE(PG8_SA(0, 1), cA + hstepA, voffA);
        if (wr == 1) PG8_BAR;
        PG8_WAIT_V(2); PG8_BAR;
        PG8_STAGE(PG8_SB(1, 0), cB + kstep, voffB); PG8_STAGE(PG8_SA(1, 0), cA + kstep, voffA); PG8_STAGE(PG8_SB(1, 1), cB + hstepB + kstep, voffB);
        PG8_WAIT_V(6); PG8_BAR;
    } else {
        PG8_STAGE(PG8_SB(0, 0), cB, voffB); PG8_STAGE(PG8_SA(0, 0), cA, voffA); PG8_STAGE(PG8_SB(0, 1), cB + hstepB, voffB); PG8_STAGE(PG8_SA(0, 1), cA + hstepA, voffA);
        if (wr == 1) PG8_BAR;
        PG8_WAIT_V(4); PG8_BAR;
        PG8_STAGE(PG8_SB(1, 0), cB + kstep, voffB); PG8_STAGE(PG8_SA(1, 0), cA + kstep, voffA); PG8_STAGE(PG8_SB(1, 1), cB + hstepB + kstep, voffB);
        PG8_WAIT_V(6); PG8_BAR;
    }
    for (;;) {
        const bool has_next = S.next(ui + 1, nxt);
        const char* nA = has_next ? (const char*)g.A + (size_t)nxt.pm * tstepA : cA; const char* nB = has_next ? (const char*)g.Bt + (size_t)nxt.pn * tstepB : cB;
        for (int t = 0; t < nt; t += 2) {
            const bool last = (t == nt - 2);
            const char* a1 = cA + (size_t)(t + 1) * kstep;
            const char* a2 = last ? nA : cA + (size_t)(t + 2) * kstep; const char* b2 = last ? nB : cB + (size_t)(t + 2) * kstep;
            const char* a3 = a2 + kstep; const char* b3 = b2 + kstep;
            if (last && has_next) S.a_ready(nxt);
            if constexpr (SP2) {
            PG8_LDB(B0, 0, 0); PG8_LDB(B1, 0, 1); PG8_SCHED; PG8_LDA(At, 0, 0); PG8_STAGE(PG8_SA(1, 1), a1 + hstepA, voffA);
            PG8_WAIT_V(8); PG8_WAIT_L(0); PG8_BAR; PG8_MMA(0, 0, At, B0); PG8_MMA(0, 1, At, B1); PG8_BAR; PG8_SCHED;
            PG8_LDA(At, 0, 1); PG8_STAGE(PG8_SB(0, 0), b2, voffB); PG8_STAGE(PG8_SB(0, 1), b2 + hstepB, voffB); PG8_STAGE(PG8_SA(0, 0), a2, voffA);
            PG8_WAIT_V(8); PG8_WAIT_L(0); PG8_BAR; PG8_MMA(1, 0, At, B0); PG8_MMA(1, 1, At, B1); PG8_BAR; PG8_SCHED;
            PG8_LDB(B0, 1, 0); PG8_LDB(B1, 1, 1); PG8_SCHED; PG8_LDA(At, 1, 0); PG8_STAGE(PG8_SA(0, 1), a2 + hstepA, voffA);
            PG8_WAIT_V(8); PG8_WAIT_L(0); PG8_BAR; PG8_MMA(0, 0, At, B0); PG8_MMA(0, 1, At, B1); PG8_BAR; PG8_SCHED;
            PG8_LDA(At, 1, 1); PG8_STAGE(PG8_SB(1, 0), b3, voffB); PG8_STAGE(PG8_SB(1, 1), b3 + hstepB, voffB); PG8_STAGE(PG8_SA(1, 0), a3, voffA);
            PG8_WAIT_V(8); PG8_WAIT_L(0); PG8_BAR; PG8_MMA(1, 0, At, B0); PG8_MMA(1, 1, At, B1); PG8_BAR; PG8_SCHED;
            } else {
            PG8_LDB(B0, 0, 0); PG8_SCHED; PG8_LDA(At, 0, 0); PG8_STAGE(PG8_SA(1, 1), a1 + hstepA, voffA);
            PG8_WAIT_L(8); PG8_BAR; PG8_WAIT_L(0); PG8_MMA(0, 0, At, B0); PG8_BAR; PG8_SCHED;
            PG8_LDB(B1, 0, 1); PG8_STAGE(PG8_SB(0, 0), b2, voffB);
            PG8_BAR; PG8_WAIT_L(0); PG8_MMA(0, 1, At, B1); PG8_BAR;
            PG8_LDA(At, 0, 1); PG8_STAGE(PG8_SA(0, 0), a2, voffA);
            PG8_BAR; PG8_WAIT_L(0); PG8_MMA(1, 0, At, B0); PG8_BAR; PG8_SCHED;
            PG8_STAGE(PG8_SB(0, 1), b2 + hstepB, voffB);
            PG8_WAIT_V(6); PG8_BAR; PG8_MMA(1, 1, At, B1); PG8_BAR;
            PG8_LDB(B0, 1, 0); PG8_SCHED; PG8_LDA(At, 1, 0); PG8_STAGE(PG8_SA(0, 1), a2 + hstepA, voffA);
            PG8_WAIT_L(8); PG8_BAR; PG8_WAIT_L(0); PG8_MMA(0, 0, At, B0); PG8_BAR; PG8_SCHED;
            PG8_LDB(B1, 1, 1); PG8_STAGE(PG8_SB(1, 0), b3, voffB);
            PG8_BAR; PG8_WAIT_L(0); PG8_MMA(0, 1, At, B1); PG8_BAR;
            PG8_LDA(At, 1, 1); PG8_STAGE(PG8_SA(1, 0), a3, voffA);
            PG8_BAR; PG8_WAIT_L(0); PG8_MMA(1, 0, At, B0); PG8_BAR; PG8_SCHED;
            PG8_STAGE(PG8_SB(1, 1), b3 + hstepB, voffB);
            PG8_WAIT_V(6); PG8_BAR; PG8_MMA(1, 1, At, B1); PG8_BAR;
            }
        }
        if constexpr (ALIGN_EPI) { if (wr == 0) PG8_BAR; }
        if constexpr (!Epi::AFTER_DRAIN) { E(acc, cur, wr, wc, fr, fq); S.done(cur); }
        if (!has_next) break;
#pragma unroll
        for (int a = 0; a < 2; ++a)
#pragma unroll
            for (int b = 0; b < 2; ++b)
#pragma unroll
                for (int m = 0; m < 4; ++m)
#pragma unroll
                    for (int n = 0; n < 2; ++n) acc[a][b][m][n] = (f32x4){0.f, 0.f, 0.f, 0.f};
        cur = nxt; cA = nA; cB = nB; ++ui;
        if constexpr (ALIGN_EPI) { if (wr == 1) PG8_BAR; }
    }
    PG8_WAIT_V(0);
    if constexpr (!ALIGN_EPI) { if (wr == 0) PG8_BAR; }
    PG8_BAR;
    if constexpr (Epi::AFTER_DRAIN) { E.fused(acc, cur, wr, wc, fr, fq, lds, wid, lane); S.done(cur); }
#undef PG8_SA
#undef PG8_SB
#undef PG8_STAGE
#undef PG8_LDA
#undef PG8_LDB
#undef PG8_MMA
#undef PG8_WAIT_V
#undef PG8_WAIT_L
#undef PG8_BAR
#undef PG8_SCHED
}
}
namespace pg8 {
__device__ __forceinline__ float row_rstd(const float* ssq, int row) {
    const f32x4* p = (const f32x4*)(ssq + (size_t)row * 16);
    const f32x4 a = p[0], b = p[1], c = p[2], d = p[3];
    const float s = (((a[0] + a[1]) + (a[2] + a[3])) + ((b[0] + b[1]) + (b[2] + b[3]))) + (((c[0] + c[1]) + (c[2] + c[3])) + ((d[0] + d[1]) + (d[2] + d[3])));
    return 1.0f / sqrtf(s * (1.0f / 1024.0f) + 1e-6f);
}
__device__ __forceinline__ u32x4 pack8(const float (&v)[8]) { u32x4 w; w.x = cvt_pk_bf16(v[0], v[1]); w.y = cvt_pk_bf16(v[2], v[3]); w.z = cvt_pk_bf16(v[4], v[5]); w.w = cvt_pk_bf16(v[6], v[7]); return w; }
__device__ __forceinline__ void unpack8(const u32x4 w, float (&v)[8]) {
    v[0] = __uint_as_float(w.x << 16); v[1] = __uint_as_float(w.x & 0xffff0000u); v[2] = __uint_as_float(w.y << 16); v[3] = __uint_as_float(w.y & 0xffff0000u);
    v[4] = __uint_as_float(w.z << 16); v[5] = __uint_as_float(w.z & 0xffff0000u); v[6] = __uint_as_float(w.w << 16); v[7] = __uint_as_float(w.w & 0xffff0000u);
}
#define PG8_V8(v, a, b, sc) do { v[0] = a[0] * (sc); v[1] = a[1] * (sc); v[2] = a[2] * (sc); v[3] = a[3] * (sc); v[4] = b[0] * (sc); v[5] = b[1] * (sc); v[6] = b[2] * (sc); v[7] = b[3] * (sc); } while (0)

struct EpiQKV {
    static constexpr bool PERM = true, AFTER_DRAIN = false;
    bf16_t* ZQ; bf16_t* ZKV; const float* ssq; const float* rope; float* ksum;
    __device__ __forceinline__ void operator()(const f32x4 (&acc)[2][2][4][2], const Unit& u, int wr, int wc, int fr, int fq) const {
        const int row0 = u.pm * BM + wr * 64 + fr, colt = u.pn * BM;
        bf16_t* base; int ldc, cb;
        if (colt < 1024) { base = ZQ; ldc = 1024; cb = colt; } else { base = ZKV; ldc = 1536; cb = colt - 1024; }
        const int hg0 = (colt + wc * 32) >> 6;
        const bool half0 = (wc & 1) == 0;
        float ks[2][8];
#pragma unroll
        for (int bj = 0; bj < 2; ++bj)
#pragma unroll
            for (int j = 0; j < 8; ++j) ks[bj][j] = 0.f;
#pragma unroll
        for (int ai = 0; ai < 2; ++ai)
#pragma unroll
            for (int m = 0; m < 4; ++m) {
                const int row = row0 + ai * HALF + m * 16;
                const float rstd = row_rstd(ssq, row);
                const f32x4* rp = (const f32x4*)(rope + (size_t)(row & 2047) * 16);
                float cs[8], sn[8];
                if (half0) { const f32x4 c0 = rp[0], c1 = rp[1], s0 = rp[2], s1 = rp[3];
                    cs[0] = c0[0]; cs[1] = c0[1]; cs[2] = c0[2]; cs[3] = c0[3]; cs[4] = c1[0]; cs[5] = c1[1]; cs[6] = c1[2]; cs[7] = c1[3];
                    sn[0] = s0[0]; sn[1] = s0[1]; sn[2] = s0[2]; sn[3] = s0[3]; sn[4] = s1[0]; sn[5] = s1[1]; sn[6] = s1[2]; sn[7] = s1[3]; }
                else {
#pragma unroll
                    for (int j = 0; j < 8; ++j) { cs[j] = 1.f; sn[j] = 0.f; } }
#pragma unroll
                for (int bj = 0; bj < 2; ++bj) {
                    const int hg = hg0 + 2 * bj;
                    const bool isrope = (hg < 12) || (hg >= 16 && hg < 22) || (hg >= 28 && hg < 34);
                    float v[8]; PG8_V8(v, acc[ai][bj][m][0], acc[ai][bj][m][1], rstd);
                    if (isrope && half0) {
                        float p[8];
#pragma unroll
                        for (int j = 0; j < 8; ++j) p[j] = __shfl_xor(v[j], 16);
                        if (fq < 2) { const float sg = (fq == 0) ? -1.f : 1.f;
#pragma unroll
                            for (int j = 0; j < 8; ++j) v[j] = v[j] * cs[j] + sg * (p[j] * sn[j]); }
                    }
                    if (hg < 16) {
#pragma unroll
                        for (int j = 0; j < 8; ++j) v[j] *= 0.125f; }
                    *(u32x4*)(base + (size_t)row * ldc + cb + bj * HALF + wc * 32 + 8 * fq) = pack8(v);
                    if (hg >= 28 && hg < 34) {
#pragma unroll
                        for (int j = 0; j < 8; ++j) ks[bj][j] += v[j]; }
                }
            }
#pragma unroll
        for (int bj = 0; bj < 2; ++bj) { const int hg = hg0 + 2 * bj;
            if (hg >= 28 && hg < 34) {
                float* kp = ksum + (size_t)(u.pm * 6 + (hg - 28)) * 64 + (wc & 1) * 32 + 8 * fq;
#pragma unroll
                for (int j = 0; j < 8; ++j) { float s = ks[bj][j]; s += __shfl_xor(s, 1); s += __shfl_xor(s, 2); s += __shfl_xor(s, 4); s += __shfl_xor(s, 8);
                    if (fr == 0) atomicAdd(kp + j, s); }
            } }
    }
};
struct EpiGate {
    static constexpr bool PERM = true, AFTER_DRAIN = false;
    bf16_t* ZG; const float* ssq;
    __device__ __forceinline__ void operator()(const f32x4 (&acc)[2][2][4][2], const Unit& u, int wr, int wc, int fr, int fq) const {
        const int row0 = u.pm * BM + wr * 64 + fr, col0 = u.pn * BM + wc * 32 + 8 * fq;
#pragma unroll
        for (int ai = 0; ai < 2; ++ai)
#pragma unroll
            for (int m = 0; m < 4; ++m) { const int row = row0 + ai * HALF + m * 16; const float rstd = row_rstd(ssq, row);
#pragma unroll
                for (int bj = 0; bj < 2; ++bj) { float v[8]; PG8_V8(v, acc[ai][bj][m][0], acc[ai][bj][m][1], rstd);
#pragma unroll
                    for (int j = 0; j < 8; ++j) v[j] = __builtin_amdgcn_rcpf(1.0f + __builtin_amdgcn_exp2f(v[j] * -1.4426950408889634f));
                    *(u32x4*)(ZG + (size_t)row * 3072 + col0 + bj * HALF) = pack8(v); } }
    }
};
struct EpiPlain {
    static constexpr bool PERM = true, AFTER_DRAIN = false;
    bf16_t* O; int ldc;
    __device__ __forceinline__ void operator()(const f32x4 (&acc)[2][2][4][2], const Unit& u, int wr, int wc, int fr, int fq) const {
        const int row0 = u.pm * BM + wr * 64 + fr, col0 = u.pn * BM + wc * 32 + 8 * fq;
#pragma unroll
        for (int ai = 0; ai < 2; ++ai)
#pragma unroll
            for (int m = 0; m < 4; ++m) { const int row = row0 + ai * HALF + m * 16;
#pragma unroll
                for (int bj = 0; bj < 2; ++bj) { float v[8]; PG8_V8(v, acc[ai][bj][m][0], acc[ai][bj][m][1], 1.0f);
                    *(u32x4*)(O + (size_t)row * ldc + col0 + bj * HALF) = pack8(v); } }
    }
};
template <int BR> struct EpiProj {
    static constexpr bool PERM = true, AFTER_DRAIN = false;
    bf16_t* ZG;
    __device__ __forceinline__ void operator()(const f32x4 (&acc)[2][2][4][2], const Unit& u, int wr, int wc, int fr, int fq) const {
        const int row0 = u.pm * BM + wr * 64 + fr, col0 = u.pn * BM + wc * 32 + 8 * fq;
#pragma unroll
        for (int ai = 0; ai < 2; ++ai)
#pragma unroll
            for (int m = 0; m < 4; ++m) { const int row = row0 + ai * HALF + m * 16;
#pragma unroll
                for (int bj = 0; bj < 2; ++bj) { bf16_t* yp = ZG + (size_t)row * 3072 + col0 + bj * HALF;
                    float g[8], v[8]; unpack8(*(const u32x4*)(yp + BR * 1024), g); PG8_V8(v, acc[ai][bj][m][0], acc[ai][bj][m][1], 1.0f);
                    if (BR > 0) { float y[8]; unpack8(*(const u32x4*)yp, y);
#pragma unroll
                        for (int j = 0; j < 8; ++j) v[j] = y[j] + g[j] * v[j]; }
                    else {
#pragma unroll
                        for (int j = 0; j < 8; ++j) v[j] = g[j] * v[j]; }
                    *(u32x4*)yp = pack8(v); } }
    }
};
struct EpiRes {
    static constexpr bool PERM = true, AFTER_DRAIN = false;
    const float* base; float* out; bf16_t* xb; float* ssq;
    __device__ __forceinline__ void operator()(const f32x4 (&acc)[2][2][4][2], const Unit& u, int wr, int wc, int fr, int fq) const {
        const int row0 = u.pm * BM + wr * 64 + fr, col0 = u.pn * BM + wc * 32 + 8 * fq;
#pragma unroll
        for (int ai = 0; ai < 2; ++ai)
#pragma unroll
            for (int m = 0; m < 4; ++m) { const int row = row0 + ai * HALF + m * 16; float sq = 0.f;
#pragma unroll
                for (int bj = 0; bj < 2; ++bj) { const size_t off = (size_t)row * 1024 + col0 + bj * HALF;
                    const f32x4 b0 = *(const f32x4*)(base + off), b1 = *(const f32x4*)(base + off + 4);
                    const f32x4 x0 = b0 + acc[ai][bj][m][0], x1 = b1 + acc[ai][bj][m][1];
                    *(f32x4*)(out + off) = x0; *(f32x4*)(out + off + 4) = x1;
                    float v[8]; PG8_V8(v, x0, x1, 1.0f);
                    *(u32x4*)(xb + off) = pack8(v);
#pragma unroll
                    for (int j = 0; j < 8; ++j) sq += v[j] * v[j]; }
                sq += __shfl_xor(sq, 16); sq += __shfl_xor(sq, 32);
                if (fq == 0) ssq[(size_t)row * 16 + u.pn * 4 + wc] = sq; }
    }
};
struct EpiUp {
    static constexpr bool PERM = true, AFTER_DRAIN = false;
    bf16_t* U; const float* ssq;
    __device__ __forceinline__ void operator()(const f32x4 (&acc)[2][2][4][2], const Unit& u, int wr, int wc, int fr, int fq) const {
        const int row0 = u.pm * BM + wr * 64 + fr, col0 = u.pn * BM + wc * 32 + 8 * fq;
#pragma unroll
        for (int ai = 0; ai < 2; ++ai)
#pragma unroll
            for (int m = 0; m < 4; ++m) { const int row = row0 + ai * HALF + m * 16; const float rstd = row_rstd(ssq, row);
#pragma unroll
                for (int bj = 0; bj < 2; ++bj) { float v[8]; PG8_V8(v, acc[ai][bj][m][0], acc[ai][bj][m][1], rstd);
#pragma unroll
                    for (int j = 0; j < 8; ++j) { const float r = fmaxf(v[j], 0.f); v[j] = r * r; }
                    *(u32x4*)(U + (size_t)row * 4096 + col0 + bj * HALF) = pack8(v); } }
    }
};
}
#define GAS __attribute__((address_space(1)))
#define LAS __attribute__((address_space(3)))
typedef unsigned short bf16;
typedef unsigned v4u __attribute__((ext_vector_type(4)));
typedef float f32x4 __attribute__((ext_vector_type(4)));
typedef short bf16x8 __attribute__((ext_vector_type(8)));
typedef GAS unsigned gu32;
typedef GAS unsigned long long gu64;
#define RLX_AGENT __ATOMIC_RELAXED, __HIP_MEMORY_SCOPE_AGENT
#define LDS_WAIT() asm volatile("s_waitcnt lgkmcnt(0)" ::: "memory")
#define VM_WAIT() asm volatile("s_waitcnt vmcnt(0)" ::: "memory")
__device__ __forceinline__ unsigned long long rt() { return __builtin_amdgcn_s_memrealtime(); }
__device__ __forceinline__ unsigned f2bf(float f) { unsigned u = __builtin_bit_cast(unsigned, f); return (u + 0x7fffu + ((u >> 16) & 1u)) >> 16; }
__device__ __forceinline__ unsigned pk2(float lo, float hi) { return f2bf(lo) | (f2bf(hi) << 16); }

#define XB_TMO      128
#define XB_XCNT(j)  (256  + 64 * (j))
#define XB_XSUB(j)  (1280 + 64 * (j))
#define XB_XGEN(j)  (2304 + 64 * (j))
#define XB_TOP      3328
#define XB_TOPGEN   3392
#define XCD_BAR_WORDS 3456
#define XB_SPIN_CAP (1u << 18)

__device__ __forceinline__ unsigned xb_ld(unsigned* p)              { return __hip_atomic_load(p, __ATOMIC_RELAXED, __HIP_MEMORY_SCOPE_AGENT); }
__device__ __forceinline__ unsigned xb_add(unsigned* p, unsigned v) { return __hip_atomic_fetch_add(p, v, __ATOMIC_RELAXED, __HIP_MEMORY_SCOPE_AGENT); }
__device__ __forceinline__ unsigned xb_xcc_id() { return (unsigned)__builtin_amdgcn_s_getreg((3 << 11) | 20) & 0xFu; }
#define XB_SPIN(cond, bar) do { unsigned _sp = 0; while (cond) { __builtin_amdgcn_s_sleep(1); \
    if ((++_sp & 255u) == 0u) { if (xb_ld(&(bar)[XB_TMO])) break; if (_sp > XB_SPIN_CAP) { atomicAdd(&(bar)[XB_TMO], 1u); break; } } } } while (0)

struct XcdBarrier {
    unsigned* bar; unsigned x;
    volatile LAS unsigned* st;
};

__device__ __forceinline__ XcdBarrier xcd_barrier_post(unsigned* bar, volatile LAS unsigned* st) {
    XcdBarrier b; b.bar = bar; b.x = xb_xcc_id(); b.st = st;
    if (threadIdx.x == 0) (void)xb_add(&bar[XB_XCNT(b.x)], 1u);
    return b;
}
__device__ __forceinline__ void xcd_barrier_complete(unsigned* bar, unsigned x, unsigned& nloc, unsigned& nx) {
    const unsigned G = gridDim.x * gridDim.y * gridDim.z;
    unsigned sum, cnt, mine, sp = 0u;
    for (;;) {
        sum = 0u; cnt = 0u; mine = 0u;
#pragma unroll
        for (unsigned j = 0; j < 16; ++j) { const unsigned c = xb_ld(&bar[XB_XCNT(j)]); sum += c; cnt += (c > 0u) ? 1u : 0u; mine = (j == x) ? c : mine; }
        if (sum == G) break;
        __builtin_amdgcn_s_sleep(1);
        if ((++sp & 255u) == 0u) { if (xb_ld(&bar[XB_TMO])) break; if (sp > XB_SPIN_CAP) { atomicAdd(&bar[XB_TMO], 1u); break; } }
    }
    nloc = mine > 0u ? mine : 1u; nx = cnt > 0u ? cnt : 1u;
}

__device__ __forceinline__ void xcd_barrier(const XcdBarrier& b) {
    asm volatile("s_waitcnt vmcnt(0)" ::: "memory");
    __syncthreads();
    if (threadIdx.x == 0) {
        unsigned* bar = b.bar;
        __builtin_amdgcn_s_waitcnt(0);
        unsigned nloc = b.st[0], nx = b.st[1];
        if (nloc == 0u) { xcd_barrier_complete(bar, b.x, nloc, nx); b.st[0] = nloc; b.st[1] = nx; }
        const unsigned old = xb_add(&bar[XB_XSUB(b.x)], 1u);
        const unsigned gen = old / nloc;
        if (old + 1u == (gen + 1u) * nloc) {
            __builtin_amdgcn_fence(__ATOMIC_RELEASE, "agent");
            asm volatile("s_waitcnt vmcnt(0)" ::: "memory");
            const unsigned og = xb_add(&bar[XB_TOP], 1u);
            const unsigned tg = og / nx;
            if (og + 1u == (tg + 1u) * nx) xb_add(&bar[XB_TOPGEN], 1u);
            else XB_SPIN(xb_ld(&bar[XB_TOPGEN]) == tg, bar);
            __builtin_amdgcn_fence(__ATOMIC_ACQUIRE, "agent");
            xb_add(&bar[XB_XGEN(b.x)], 1u);
            asm volatile("s_waitcnt vmcnt(0)" ::: "memory");
        } else {
            XB_SPIN(xb_ld(&bar[XB_XGEN(b.x)]) == gen, bar);
            __builtin_amdgcn_fence(__ATOMIC_ACQUIRE, "agent");
            asm volatile("s_waitcnt vmcnt(0)" ::: "memory");
        }
    }
    __syncthreads();
}

constexpr int NWAVES = 8;
constexpr int T = 16384, D = 1024, SEQ = 2048, FF = 4096, DIN = 5632, NQKV = 2560, NGATE = 3072, NMEMROWS = 2048;
constexpr size_t MiB = 1u << 20;
constexpr size_t WS_CTL = 0, CTL_ZERO_BYTES = 1 * MiB;
constexpr size_t WS_KSUM = 256 * 1024;
constexpr size_t WS_ROPE = 1 * MiB;
constexpr size_t WS_SSQ = 2 * MiB;
constexpr size_t WS_MKV = 4 * MiB;
constexpr size_t WS_MEMN = 6 * MiB;
constexpr size_t WS_W = 10 * MiB;
constexpr size_t W_IN = 0, W_UP = 11 * MiB, W_DN = 19 * MiB, W_O = 27 * MiB, W_P = 29 * MiB, W_MKV = 31 * MiB, W_LAYER = 32 * MiB;
constexpr size_t WS_XB = 74 * MiB;
constexpr size_t WS_ZQ = 106 * MiB;
constexpr size_t WS_ZKV = 138 * MiB;
constexpr size_t WS_ZG = 138 * MiB;
constexpr size_t WS_U = 106 * MiB;
constexpr size_t WS_END = 234 * MiB;
constexpr int CW_BAR = 4096;
constexpr int RING_OFF = 0, RING_BYTES = 131072, LDSCTL_OFF = RING_BYTES, MISC_OFF = LDSCTL_OFF + 320, LDS_BYTES = 147456;

__device__ __forceinline__ float wave_sum(float v) {
#pragma unroll
    for (int o = 1; o < 64; o <<= 1) v += __shfl_xor(v, o);
    return v;
}
__device__ __forceinline__ float bf2f(bf16 h) { return __uint_as_float((unsigned)h << 16); }

__device__ __forceinline__ void tr_item(const float* W, int N, const float* gain, bf16* WT, int ldt, int k0, int n0, int drow, int dcol, LAS float* scr, int lane) {
#pragma unroll 8
    for (int i = 0; i < 32; ++i) { const int kk = 2 * i + (lane >> 5); float w = W[(size_t)(k0 + kk) * N + n0 + (lane & 31)]; if (gain) w *= gain[k0 + kk]; scr[kk * 33 + (lane & 31)] = w; }
    LDS_WAIT(); asm volatile("" ::: "memory");
    const int c = lane & 7;
#pragma unroll
    for (int j = 0; j < 4; ++j) { const int n = (lane >> 3) + 8 * j; const LAS float* s = scr + (8 * c) * 33 + n;
        v4u o; o.x = pk2(s[0 * 33], s[1 * 33]); o.y = pk2(s[2 * 33], s[3 * 33]); o.z = pk2(s[4 * 33], s[5 * 33]); o.w = pk2(s[6 * 33], s[7 * 33]);
        *(GAS v4u*)(WT + (size_t)(drow + n) * ldt + dcol + k0 + 8 * c) = o; }
    LDS_WAIT(); asm volatile("" ::: "memory");
}
__device__ __forceinline__ int win_dest_row(int n) {
    if (n < 384) return n;
    if (n < 768) return 1024 + (n - 384);
    if (n < 1152) return 1024 + 384 + (n - 768);
    if (n < 1536) return 384 + (n - 1152);
    if (n < 1920) return 1024 + 768 + (n - 1536);
    if (n < 2304) return 1024 + 1152 + (n - 1920);
    if (n < 2560) return 768 + (n - 2304);
    return n;
}

struct Args { const float* in[14]; float* out; unsigned char* ws; int ph_lo, ph_hi, li, pad; };

__device__ __forceinline__ void ld64(const bf16* p, float (&f)[64]) {
    const v4u* q = (const v4u*)p;
#pragma unroll
    for (int i = 0; i < 8; ++i) { const v4u w = q[i];
        f[8 * i + 0] = __uint_as_float(w.x << 16); f[8 * i + 1] = __uint_as_float(w.x & 0xffff0000u); f[8 * i + 2] = __uint_as_float(w.y << 16); f[8 * i + 3] = __uint_as_float(w.y & 0xffff0000u);
        f[8 * i + 4] = __uint_as_float(w.z << 16); f[8 * i + 5] = __uint_as_float(w.z & 0xffff0000u); f[8 * i + 6] = __uint_as_float(w.w << 16); f[8 * i + 7] = __uint_as_float(w.w & 0xffff0000u); }
}
__device__ __forceinline__ void st64(bf16* p, const float (&f)[64], float sc) {
    v4u* q = (v4u*)p;
#pragma unroll
    for (int i = 0; i < 8; ++i) { v4u w; w.x = pk2(f[8 * i] * sc, f[8 * i + 1] * sc); w.y = pk2(f[8 * i + 2] * sc, f[8 * i + 3] * sc); w.z = pk2(f[8 * i + 4] * sc, f[8 * i + 5] * sc); w.w = pk2(f[8 * i + 6] * sc, f[8 * i + 7] * sc); q[i] = w; }
}
__device__ __forceinline__ void attend(const float (&q)[64], const bf16* kp, const bf16* vp, bool valid, float& m, float& l, float (&o)[64]) {
    float k[64]; ld64(kp, k);
    float s0 = 0.f, s1 = 0.f, s2 = 0.f, s3 = 0.f;
#pragma unroll
    for (int d = 0; d < 64; d += 4) { s0 += q[d] * k[d]; s1 += q[d + 1] * k[d + 1]; s2 += q[d + 2] * k[d + 2]; s3 += q[d + 3] * k[d + 3]; }
    const float s = (s0 + s1) + (s2 + s3);
    if (valid) {
        float v[64]; ld64(vp, v);
        const float mn = fmaxf(m, s), a = __expf(m - mn), p = __expf(s - mn);
        l = l * a + p; m = mn;
#pragma unroll
        for (int d = 0; d < 64; ++d) o[d] = o[d] * a + p * v[d];
    }
}
__global__ void __launch_bounds__(256) naive_dilated(bf16* ZQ, const bf16* ZKV) {
    const int gid = blockIdx.x * 256 + threadIdx.x;
    const int h = gid / T, tg = gid % T, t = tg & (SEQ - 1);
    float m = -1e30f, l = 0.f, o[64];
#pragma unroll
    for (int d = 0; d < 64; ++d) o[d] = 0.f;
#pragma unroll 1
    for (int g = 0; g < 3; ++g) {
        const int dil = (g == 0) ? 1 : (g == 1) ? 4 : 16;
        const int hc = (2 * g + h) * 64;
        float q[64]; ld64(ZQ + (size_t)tg * 1024 + hc, q);
#pragma unroll 1
        for (int j = 0; j <= 128; ++j) {
            const int kt = t - j * dil; const bool valid = kt >= 0; const int kr = valid ? (tg - j * dil) : tg;
            attend(q, ZKV + (size_t)kr * 1536 + hc, ZKV + (size_t)kr * 1536 + 384 + hc, valid, m, l, o);
        }
    }
    __syncthreads();
    st64(ZQ + (size_t)tg * 1024 + h * 64, o, 1.0f / l);
#pragma unroll
    for (int d = 0; d < 64; ++d) o[d] = 0.f;
    st64(ZQ + (size_t)tg * 1024 + 128 + h * 64, o, 0.f);
}
__global__ void __launch_bounds__(256) naive_moba(bf16* ZQ, const bf16* ZKV, const float* ksum) {
    const int gid = blockIdx.x * 256 + threadIdx.x;
    const int h = gid / T, tg = gid % T, t = tg & (SEQ - 1), b = tg / SEQ, qb = t >> 8;
    float q[64]; ld64(ZQ + (size_t)tg * 1024 + 384 + h * 64, q);
    float gsc[8];
#pragma unroll
    for (int n = 0; n < 8; ++n) { const float* kp = ksum + (size_t)((b * 8 + n) * 6 + h) * 64; float s = 0.f;
#pragma unroll
        for (int d = 0; d < 64; ++d) s += q[d] * (kp[d] * (1.0f / 256.0f));
        gsc[n] = s; }
    unsigned sel = 0;
#pragma unroll
    for (int r = 0; r < 3; ++r) { int best = -1; float bv = -INFINITY;
#pragma unroll
        for (int n = 0; n < 8; ++n) if (n < qb && !((sel >> n) & 1u) && gsc[n] > bv) { bv = gsc[n]; best = n; }
        if (best >= 0) sel |= 1u << best; }
    sel |= 1u << qb;
    float m = -1e30f, l = 0.f, o[64];
#pragma unroll
    for (int d = 0; d < 64; ++d) o[d] = 0.f;
#pragma unroll 1
    for (int n = 0; n <= qb; ++n) {
        const bool act = (sel >> n) & 1u;
        if (!__any(act)) continue;
#pragma unroll 1
        for (int kk = 0; kk < 256; ++kk) { const int kpos = n * 256 + kk; const bool valid = act && (kpos <= t); const size_t kr = (size_t)(b * SEQ + kpos);
            attend(q, ZKV + kr * 1536 + 768 + h * 64, ZKV + kr * 1536 + 1152 + h * 64, valid, m, l, o); }
    }
    st64(ZQ + (size_t)tg * 1024 + 384 + h * 64, o, 1.0f / l);
}
__global__ void __launch_bounds__(256) naive_mem(bf16* ZQ, const bf16* MKV) {
    const int gid = blockIdx.x * 256 + threadIdx.x;
    const int h = gid / T, tg = gid % T, b = tg / SEQ;
    float q[64]; ld64(ZQ + (size_t)tg * 1024 + 768 + h * 64, q);
    float m = -1e30f, l = 0.f, o[64];
#pragma unroll
    for (int d = 0; d < 64; ++d) o[d] = 0.f;
#pragma unroll 1
    for (int kk = 0; kk < 256; ++kk) { const size_t kr = (size_t)(b * 256 + kk);
        attend(q, MKV + kr * 512 + h * 64, MKV + kr * 512 + 256 + h * 64, true, m, l, o); }
    st64(ZQ + (size_t)tg * 1024 + 768 + h * 64, o, 1.0f / l);
}

constexpr int N_PHASES = 16;
#ifndef MK_ONE_LAUNCH
#define MK_ONE_LAUNCH 0
#endif
__global__ void __launch_bounds__(NWAVES * 64, 2) mega(Args args) {
    extern __shared__ __attribute__((aligned(16))) unsigned char lds_raw[];
    LAS unsigned char* lds = (LAS unsigned char*)lds_raw;
    volatile LAS unsigned* MISC = (volatile LAS unsigned*)(lds + MISC_OFF);
    const int tid = threadIdx.x, lane = tid & 63, wave = __builtin_amdgcn_readfirstlane(tid >> 6);
    const int G = gridDim.x; const int bx = blockIdx.x; const int vcu = (G % 8 == 0) ? (bx % 8) * (G / 8) + bx / 8 : bx;
    unsigned char* ws = args.ws;
    gu32* ctl = (gu32*)(ws + WS_CTL);
    for (int u = tid; u < (LDS_BYTES - LDSCTL_OFF) / 4; u += NWAVES * 64) ((LAS unsigned*)(lds + LDSCTL_OFF))[u] = 0u;
    __syncthreads();
    XcdBarrier bar; bar.bar = (unsigned*)(ctl + CW_BAR); bar.x = 0; bar.st = nullptr;
    if (MK_ONE_LAUNCH) bar = xcd_barrier_post((unsigned*)(ctl + CW_BAR), MISC + 8);
    const int lo = args.ph_lo, hi = args.ph_hi;
#define IN(k) (lo <= (k) && (k) < hi)
#define SEAM(k) do { if (IN(k) && IN((k) + 1)) xcd_barrier(bar); } while (0)
    const float* x_in = args.in[0]; const float* mem = args.in[1];
    float* out = args.out;
    float* ROPE = (float*)(ws + WS_ROPE); float* SSQ = (float*)(ws + WS_SSQ);
    bf16* MKV = (bf16*)(ws + WS_MKV); bf16* MEMN = (bf16*)(ws + WS_MEMN); bf16* XB = (bf16*)(ws + WS_XB);
    bf16* ZQ = (bf16*)(ws + WS_ZQ); bf16* ZKV = (bf16*)(ws + WS_ZKV); bf16* ZG = (bf16*)(ws + WS_ZG); bf16* U = (bf16*)(ws + WS_U);
    const int gw = vcu * NWAVES + wave, NGW = G * NWAVES;

    if (IN(0)) {
        LAS float* scr = (LAS float*)(lds + RING_OFF + wave * 16384);
        constexpr int I_IN = 16 * 176, I_PA = 2 * 32, I_PB = 6 * 32, I_PM = 4 * 32, I_O = 16 * 32, I_MKV = 16 * 16, I_UP = 16 * 128, I_DN = 64 * 32;
        constexpr int I_LAYER = I_IN + I_PA + I_PB + I_PM + I_O + I_MKV + I_UP + I_DN;
        for (int it = gw; it < 2 * I_LAYER; it += NGW) {
            const int l = it / I_LAYER; int r = it % I_LAYER;
            unsigned char* wl = ws + WS_W + (size_t)l * W_LAYER;
            if (r < I_IN) { const int kb = r / 176, nb = r % 176; tr_item(args.in[3] + (size_t)l * D * DIN, DIN, args.in[2] + l * D, (bf16*)(wl + W_IN), 1024, 64 * kb, 32 * nb, win_dest_row(32 * nb), 0, scr, lane); continue; } r -= I_IN;
            if (r < I_PA) { const int kb = r / 32, nb = r % 32; tr_item(args.in[4] + (size_t)l * 128 * D, D, nullptr, (bf16*)(wl + W_P), 1024, 64 * kb, 32 * nb, 32 * nb, 0, scr, lane); continue; } r -= I_PA;
            if (r < I_PB) { const int kb = r / 32, nb = r % 32; tr_item(args.in[5] + (size_t)l * 384 * D, D, nullptr, (bf16*)(wl + W_P), 1024, 64 * kb, 32 * nb, 32 * nb, 384, scr, lane); continue; } r -= I_PB;
            if (r < I_PM) { const int kb = r / 32, nb = r % 32; tr_item(args.in[6] + (size_t)l * 256 * D, D, nullptr, (bf16*)(wl + W_P), 1024, 64 * kb, 32 * nb, 32 * nb, 768, scr, lane); continue; } r -= I_PM;
            if (r < I_O) { const int kb = r / 32, nb = r % 32; tr_item(args.in[7] + (size_t)l * D * D, D, nullptr, (bf16*)(wl + W_O), 1024, 64 * kb, 32 * nb, 32 * nb, 0, scr, lane); continue; } r -= I_O;
            if (r < I_MKV) { const int kb = r / 16, nb = r % 16; tr_item(args.in[9] + (size_t)l * D * 512, 512, args.in[8] + l * D, (bf16*)(wl + W_MKV), 1024, 64 * kb, 32 * nb, 32 * nb, 0, scr, lane); continue; } r -= I_MKV;
            if (r < I_UP) { const int kb = r / 128, nb = r % 128; tr_item(args.in[11] + (size_t)l * D * FF, FF, args.in[10] + l * D, (bf16*)(wl + W_UP), 1024, 64 * kb, 32 * nb, 32 * nb, 0, scr, lane); continue; } r -= I_UP;
            { const int kb = r / 32, nb = r % 32; tr_item(args.in[12] + (size_t)l * FF * D, D, nullptr, (bf16*)(wl + W_DN), 4096, 64 * kb, 32 * nb, 32 * nb, 0, scr, lane); }
        }
        for (int it = gw; it < 2 * 1024; it += NGW) { const int l = it >> 10, n = it & 1023; bf16* p = (bf16*)(ws + WS_W + (size_t)l * W_LAYER + W_P) + (size_t)n * 1024 + 128;
            if (lane < 32) ((GAS v4u*)p)[lane] = (v4u){0u, 0u, 0u, 0u}; }
        for (int e = bx * (NWAVES * 64) + tid; e < SEQ * 8; e += G * NWAVES * 64) { const int pos = e >> 3, i = e & 7;
            const float invf = (float)(1.0 / pow(500000.0, (double)i / 8.0)); const float ang = (float)pos * invf;
            const double rev = (double)ang * 0.15915494309189535; const float fr_ = (float)(rev - floor(rev));
            ROPE[pos * 16 + i] = __builtin_amdgcn_cosf(fr_); ROPE[pos * 16 + 8 + i] = __builtin_amdgcn_sinf(fr_); }
        for (int m = gw; m < T; m += NGW) { const GAS f32x4* xr = (const GAS f32x4*)(x_in + (size_t)m * D) + lane; f32x4 v[4]; float s = 0.f;
#pragma unroll
            for (int j = 0; j < 4; ++j) { v[j] = xr[64 * j]; s += (v[j].x * v[j].x + v[j].y * v[j].y) + (v[j].z * v[j].z + v[j].w * v[j].w); }
            s = wave_sum(s);
            GAS unsigned long long* o8 = (GAS unsigned long long*)(XB + (size_t)m * D) + lane;
#pragma unroll
            for (int j = 0; j < 4; ++j) o8[64 * j] = (unsigned long long)pk2(v[j].x, v[j].y) | ((unsigned long long)pk2(v[j].z, v[j].w) << 32);
            if (lane < 16) SSQ[(size_t)m * 16 + lane] = (lane == 0) ? s : 0.f; }
        for (int m = gw; m < NMEMROWS; m += NGW) { const GAS f32x4* xr = (const GAS f32x4*)(mem + (size_t)m * D) + lane; f32x4 v[4]; float s = 0.f;
#pragma unroll
            for (int j = 0; j < 4; ++j) { v[j] = xr[64 * j]; s += (v[j].x * v[j].x + v[j].y * v[j].y) + (v[j].z * v[j].z + v[j].w * v[j].w); }
            const float rstd = 1.0f / sqrtf(wave_sum(s) * (1.0f / 1024.0f) + 1e-6f);
            GAS unsigned long long* o8 = (GAS unsigned long long*)(MEMN + (size_t)m * D) + lane;
#pragma unroll
            for (int j = 0; j < 4; ++j) o8[64 * j] = (unsigned long long)pk2(v[j].x * rstd, v[j].y * rstd) | ((unsigned long long)pk2(v[j].z * rstd, v[j].w * rstd) << 32); }
    }
    SEAM(0);

    for (int l = 0; l < 2; ++l) {
        const int pb = 1 + 7 * l;
        unsigned char* wl = ws + WS_W + (size_t)l * W_LAYER;
        const bf16* WIN_t = (const bf16*)(wl + W_IN); const bf16* WUP_t = (const bf16*)(wl + W_UP); const bf16* WDN_t = (const bf16*)(wl + W_DN);
        const bf16* WO_t = (const bf16*)(wl + W_O); const bf16* WP_t = (const bf16*)(wl + W_P); const bf16* WMKV_t = (const bf16*)(wl + W_MKV);
        float* KSUM = (float*)(ws + WS_KSUM) + (size_t)l * 64 * 6 * 64;
        if (IN(pb + 0)) {
            { pg8::Gemm g{XB, WIN_t, 1024, 1024, 1024}; pg8::StaticOrder S; S.init(T, NQKV, G, bx);
              pg8::EpiQKV E{ZQ, ZKV, SSQ, ROPE, KSUM};
              pg8::gemm_phase<pg8::EpiQKV, pg8::StaticOrder, true, true>(lds + RING_OFF, g, S, E); }
            { pg8::Gemm g{MEMN, WMKV_t, 1024, 1024, 1024}; pg8::StaticOrder S; S.init(NMEMROWS, 512, G, (bx + 128) % G);
              pg8::EpiPlain E{MKV, 512};
              pg8::gemm_phase<pg8::EpiPlain, pg8::StaticOrder, true, true>(lds + RING_OFF, g, S, E); }
        }
        SEAM(pb + 0);
        SEAM(pb + 1);
        if (IN(pb + 2)) {
            pg8::Gemm g{XB, WIN_t + (size_t)NQKV * 1024, 1024, 1024, 1024}; pg8::StaticOrder S; S.init(T, NGATE, G, bx);
            pg8::EpiGate E{ZG, SSQ};
            pg8::gemm_phase<pg8::EpiGate, pg8::StaticOrder, true, true>(lds + RING_OFF, g, S, E);
        }
        SEAM(pb + 2);
        if (IN(pb + 3)) {
            pg8::StaticOrder S; S.init(T, D, G, bx);
            { pg8::Gemm g{ZQ, WP_t, 1024, 1024, 256}; pg8::EpiProj<0> E{ZG}; pg8::gemm_phase<pg8::EpiProj<0>, pg8::StaticOrder, false, true>(lds + RING_OFF, g, S, E); }
            { pg8::Gemm g{ZQ + 384, WP_t + 384, 1024, 1024, 384}; pg8::EpiProj<1> E{ZG}; pg8::gemm_phase<pg8::EpiProj<1>, pg8::StaticOrder, false, true>(lds + RING_OFF, g, S, E); }
            { pg8::Gemm g{ZQ + 768, WP_t + 768, 1024, 1024, 256}; pg8::EpiProj<2> E{ZG}; pg8::gemm_phase<pg8::EpiProj<2>, pg8::StaticOrder, false, true>(lds + RING_OFF, g, S, E); }
        }
        SEAM(pb + 3);
        if (IN(pb + 4)) {
            pg8::Gemm g{ZG, WO_t, 3072, 1024, 1024}; pg8::StaticOrder S; S.init(T, D, G, bx);
            pg8::EpiRes E{l == 0 ? x_in : (const float*)out, out, XB, SSQ};
            pg8::gemm_phase<pg8::EpiRes, pg8::StaticOrder, false, true>(lds + RING_OFF, g, S, E);
        }
        SEAM(pb + 4);
        if (IN(pb + 5)) {
            pg8::Gemm g{XB, WUP_t, 1024, 1024, 1024}; pg8::StaticOrder S; S.init(T, FF, G, bx);
            pg8::EpiUp E{U, SSQ};
            pg8::gemm_phase<pg8::EpiUp, pg8::StaticOrder, true, true>(lds + RING_OFF, g, S, E);
        }
        SEAM(pb + 5);
        if (IN(pb + 6)) {
            pg8::Gemm g{U, WDN_t, 4096, 4096, 4096}; pg8::StaticOrder S; S.init(T, D, G, bx);
            pg8::EpiRes E{(const float*)out, out, XB, SSQ};
            pg8::gemm_phase<pg8::EpiRes, pg8::StaticOrder, false, true>(lds + RING_OFF, g, S, E);
        }
        SEAM(pb + 6);
    }
    if (IN(15)) {
        const float* gf = args.in[13];
        int tl_ = threadIdx.x; asm volatile("" : "+v"(tl_)); const int lane = tl_ & 63;
        for (int m = gw; m < T; m += NGW) { const float rstd = pg8::row_rstd(SSQ, m);
            GAS f32x4* xr = (GAS f32x4*)(out + (size_t)m * D) + lane; const GAS f32x4* gr = (const GAS f32x4*)gf + lane;
#pragma unroll
            for (int j = 0; j < 4; ++j) { f32x4 v = xr[64 * j]; const f32x4 gg = gr[64 * j]; v = v * rstd * gg; xr[64 * j] = v; } }
    }
#undef IN
#undef SEAM
}

extern "C" void kernel_launch(void* const* d_in, const int* in_sizes, int n_in, void* d_out, int out_size, void* d_ws, size_t ws_size, hipStream_t stream) {
    static int grid = 0;
    if (grid == 0) {
        if (n_in != 14 || in_sizes[0] != T * D || out_size != T * D || ws_size < WS_END) { fprintf(stderr, "kernel_launch: unexpected shapes (n_in %d, in0 %d, out %d, ws %zu)\n", n_in, n_in > 0 ? in_sizes[0] : -1, out_size, ws_size); grid = -1; return; }
        int dev = 0, cus = 0;
        if (hipGetDevice(&dev) != hipSuccess || hipDeviceGetAttribute(&cus, hipDeviceAttributeMultiprocessorCount, dev) != hipSuccess) { grid = -1; return; }
        if (hipFuncSetAttribute((const void*)mega, hipFuncAttributeMaxDynamicSharedMemorySize, LDS_BYTES) != hipSuccess) { fprintf(stderr, "kernel_launch: hipFuncSetAttribute failed\n"); grid = -1; return; }
        int per_cu = 0;
        (void)hipOccupancyMaxActiveBlocksPerMultiprocessor(&per_cu, (const void*)mega, NWAVES * 64, LDS_BYTES);
        (void)hipGetLastError();
        grid = cus;
    }
    if (grid < 0) return;
    (void)hipMemsetAsync((char*)d_ws + WS_CTL, 0, CTL_ZERO_BYTES, stream);
    Args a{};
    for (int i = 0; i < 14; ++i) a.in[i] = (const float*)d_in[i];
    a.out = (float*)d_out; a.ws = (unsigned char*)d_ws; a.li = 0; a.pad = 0;
    unsigned char* ws = (unsigned char*)d_ws;
#if MK_ONE_LAUNCH
    a.ph_lo = 0; a.ph_hi = N_PHASES;
    hipLaunchKernelGGL(mega, dim3(grid), dim3(NWAVES * 64), LDS_BYTES, stream, a);
#else
    for (int ph = 0; ph < N_PHASES; ++ph) {
        const int rel = (ph >= 1 && ph <= 14) ? (ph - 1) % 7 : -1, l = (ph >= 1 && ph <= 14) ? (ph - 1) / 7 : 0;
        if (rel == 1) {
            bf16* ZQ = (bf16*)(ws + WS_ZQ); const bf16* ZKV = (const bf16*)(ws + WS_ZKV);
            hipLaunchKernelGGL(naive_moba, dim3(T * 6 / 256), dim3(256), 0, stream, ZQ, ZKV, (const float*)(ws + WS_KSUM) + (size_t)l * 64 * 6 * 64);
            hipLaunchKernelGGL(naive_dilated, dim3(T * 2 / 256), dim3(256), 0, stream, ZQ, ZKV);
            hipLaunchKernelGGL(naive_mem, dim3(T * 4 / 256), dim3(256), 0, stream, ZQ, (const bf16*)(ws + WS_MKV));
            continue;
        }
        a.ph_lo = ph; a.ph_hi = ph + 1;
        hipLaunchKernelGGL(mega, dim3(grid), dim3(NWAVES * 64), LDS_BYTES, stream, a);
    }
#endif
}
```

```cpp
#include <hip/hip_runtime.h>
#include <cstdio>
#include <cstdint>
namespace pg8 {
#define PG8_LAS __attribute__((address_space(3)))
typedef unsigned short bf16_t;
typedef short bf16x8 __attribute__((ext_vector_type(8)));
typedef float f32x4 __attribute__((ext_vector_type(4)));
typedef unsigned u32x4 __attribute__((ext_vector_type(4)));
constexpr int BM = 256, BK = 64, HALF = 128, HTB = HALF * BK * 2  , STAGE_BYTES = 8 * HTB, NXCD = 8, WGM = 4;

__host__ __device__ __forceinline__ int lds_byte(int r, int c) { const int st = (r >> 4) * 2 + (c >> 5), rr = r & 15, cc = c & 31, ob = rr * 64 + cc * 2; return st * 1024 + (ob ^ (((ob >> 9) & 1) << 5)); }
__host__ __device__ __forceinline__ void stage_rc(int b, int& R, int& C) { const int st = b / 1024, sb = b % 1024, swz = sb ^ (((sb >> 9) & 1) << 5); R = (st >> 1) * 16 + swz / 64; C = (st & 1) * 32 + (swz % 64) / 2; }
__host__ __device__ __forceinline__ int perm32(int rho) { const int n = rho >> 4, i = rho & 15; return 8 * (i >> 2) + 4 * n + (i & 3); }

struct Unit { int pm, pn, k0, nt, br, pb, sel; };
struct Gemm { const bf16_t* A; const bf16_t* Bt; int lda, ldb, K; const bf16_t* A2; const bf16_t* Bt2; };

struct StaticOrder {
    static constexpr bool KSEG = false;
    __host__ __device__ static bool carry(const Unit&) { return false; }
    int nM, nN, nwg, G, c;
    __host__ __device__ void init(int M, int N, int G_, int c_) { nM = M / BM; nN = N / BM; nwg = nM * nN; G = G_; c = c_; }
    __host__ __device__ bool next(int i, Unit& u) const {
        const long L = (long)i * G + c; if (L >= nwg) return false;
        int wgid = (int)L; { const int q = nwg / NXCD, r = nwg % NXCD, xcd = wgid % NXCD, off = wgid / NXCD; wgid = (xcd < r ? xcd * (q + 1) : r * (q + 1) + (xcd - r) * q) + off; }
        const int nig = WGM * nN, gid = wgid / nig, fm = gid * WGM, gsz = (nM - fm) < WGM ? (nM - fm) : WGM;
        u.pm = fm + ((wgid % nig) % gsz); u.pn = (wgid % nig) / gsz; u.k0 = 0; u.nt = 0; u.br = 0; u.pb = u.pn; u.sel = 0; return true;
    }
    __device__ __forceinline__ void a_ready(const Unit&) const {}
    __device__ __forceinline__ void done(const Unit&) const {}
};

typedef float f32x2c_t __attribute__((ext_vector_type(2))); typedef __bf16 bf16x2c_t __attribute__((ext_vector_type(2)));
__device__ __forceinline__ unsigned cvt_pk_bf16(float lo, float hi) { const f32x2c_t v = {lo, hi}; const bf16x2c_t b = __builtin_convertvector(v, bf16x2c_t); return __builtin_bit_cast(unsigned, b); }
typedef float f32x2 __attribute__((ext_vector_type(2)));
template <class Epi, class Sched, bool ALIGN_EPI = false, bool SP2 = false>
__device__ __forceinline__ void gemm_phase(PG8_LAS unsigned char* lds, const Gemm g, const Sched& S, const Epi& E) {
    int tid_ = threadIdx.x; asm volatile("" : "+v"(tid_));
    const int tid = tid_, wid = __builtin_amdgcn_readfirstlane(tid >> 6), lane = tid & 63, wr = wid >> 2, wc = wid & 3, fr = lane & 15, fq = lane >> 4;
    const int K = g.K; int nt = K / BK;
    unsigned voffA[2], voffB[2];
#pragma unroll
    for (int i = 0; i < 2; ++i) { int R, C; stage_rc(tid * 16 + i * 8192, R, C); const int Rb = Epi::PERM ? ((R & ~31) + perm32(R & 31)) : R;
        voffA[i] = (unsigned)(R * g.lda + C) * 2u; voffB[i] = (unsigned)(Rb * g.ldb + C) * 2u; }
    const size_t kstep = (size_t)(BK * 2);
    const size_t hstepA = (size_t)HALF * g.lda * 2, hstepB = (size_t)HALF * g.ldb * 2;
    const size_t tstepA = 2 * hstepA, tstepB = 2 * hstepB;
    const unsigned ldsw = (unsigned)wid * 1024u;
    const int aoff = lds_byte(wr * 64 + fr, fq * 8), boff = lds_byte(wc * 32 + fr, fq * 8);
#define PG8_SA(b, h) (((b) * 2 + (h)) * HTB)
#define PG8_SB(b, h) ((4 + (b) * 2 + (h)) * HTB)
#define PG8_STAGE(bufoff, gbase, voff) do { _Pragma("unroll") for (int _i = 0; _i < 2; ++_i) \
        __builtin_amdgcn_global_load_lds((const unsigned*)((const char*)(gbase) + (voff)[_i]), (PG8_LAS unsigned*)(lds + (bufoff) + ldsw + _i * 8192), 16, 0, 0); } while (0)
#define PG8_LDA(dst, b, h) do { _Pragma("unroll") for (int m = 0; m < 4; ++m) _Pragma("unroll") for (int k = 0; k < 2; ++k) dst[m][k] = *(const PG8_LAS bf16x8*)(lds + PG8_SA(b, h) + aoff + m * 2048 + k * 1024); } while (0)
#define PG8_LDB(dst, b, h) do { _Pragma("unroll") for (int n = 0; n < 2; ++n) _Pragma("unroll") for (int k = 0; k < 2; ++k) dst[n][k] = *(const PG8_LAS bf16x8*)(lds + PG8_SB(b, h) + boff + n * 2048 + k * 1024); } while (0)
#define PG8_MMA(ai, bj, At, Bt) do { __builtin_amdgcn_s_setprio(1); _Pragma("unroll") for (int m = 0; m < 4; ++m) _Pragma("unroll") for (int n = 0; n < 2; ++n) _Pragma("unroll") for (int k = 0; k < 2; ++k) \
        acc[ai][bj][m][n] = __builtin_amdgcn_mfma_f32_16x16x32_bf16(Bt[n][k], At[m][k], acc[ai][bj][m][n], 0, 0, 0); __builtin_amdgcn_s_setprio(0); } while (0)
#define PG8_WAIT_V(n) asm volatile("s_waitcnt vmcnt(" #n ")" ::: "memory")
#define PG8_WAIT_L(n) asm volatile("s_waitcnt lgkmcnt(" #n ")" ::: "memory")
#define PG8_BAR __builtin_amdgcn_s_barrier()
#define PG8_SCHED __builtin_amdgcn_sched_barrier(0)
    Unit cur, nxt; int ui = 0;
    if (!S.next(0, cur)) return;
    f32x4 acc[2][2][4][2];
#pragma unroll
    for (int a = 0; a < 2; ++a)
#pragma unroll
        for (int b = 0; b < 2; ++b)
#pragma unroll
            for (int m = 0; m < 4; ++m)
#pragma unroll
                for (int n = 0; n < 2; ++n) acc[a][b][m][n] = (f32x4){0.f, 0.f, 0.f, 0.f};
    bf16x8 At[4][2], B0[2][2], B1[2][2];
    if constexpr (Sched::KSEG) nt = cur.nt;
    const char* cA = (const char*)((Sched::KSEG && cur.sel) ? g.A2 : g.A) + (size_t)cur.pm * tstepA + (Sched::KSEG ? (size_t)cur.k0 * 2 : 0); const char* cB = (const char*)((Sched::KSEG && cur.sel) ? g.Bt2 : g.Bt) + (size_t)cur.pb * tstepB + (Sched::KSEG ? (size_t)cur.k0 * 2 : 0);
    S.a_ready(cur);
    u32x4 pre[2][4][2];
    static_assert(SP2 || !Epi::PRELOAD, "PRELOAD is wired into the SP2 prologue only");
    if constexpr (Epi::PRELOAD) E.preload(pre, cur, wr, wc, fr, fq);
    if constexpr (SP2) {
        PG8_STAGE(PG8_SB(0, 0), cB, voffB); PG8_STAGE(PG8_SB(0, 1), cB + hstepB, voffB); PG8_STAGE(PG8_SA(0, 0), cA, voffA); PG8_STAGE(PG8_SA(0, 1), cA + hstepA, voffA);
        if (wr == 1) PG8_BAR;
        PG8_WAIT_V(2); PG8_BAR;
        PG8_STAGE(PG8_SB(1, 0), cB + kstep, voffB); PG8_STAGE(PG8_SA(1, 0), cA + kstep, voffA); PG8_STAGE(PG8_SB(1, 1), cB + hstepB + kstep, voffB);
        if constexpr (Epi::PRELOAD) {
#pragma unroll
            for (int a = 0; a < 2; ++a)
#pragma unroll
                for (int m = 0; m < 4; ++m)
#pragma unroll
                    for (int b = 0; b < 2; ++b) { const u32x4 w = pre[a][m][b];
                        acc[a][b][m][0] = (f32x4){__uint_as_float(w.x << 16), __uint_as_float(w.x & 0xffff0000u), __uint_as_float(w.y << 16), __uint_as_float(w.y & 0xffff0000u)};
                        acc[a][b][m][1] = (f32x4){__uint_as_float(w.z << 16), __uint_as_float(w.z & 0xffff0000u), __uint_as_float(w.w << 16), __uint_as_float(w.w & 0xffff0000u)}; } }
        PG8_WAIT_V(6); PG8_BAR;
    } else {
        PG8_STAGE(PG8_SB(0, 0), cB, voffB); PG8_STAGE(PG8_SA(0, 0), cA, voffA); PG8_STAGE(PG8_SB(0, 1), cB + hstepB, voffB); PG8_STAGE(PG8_SA(0, 1), cA + hstepA, voffA);
        if (wr == 1) PG8_BAR;
        PG8_WAIT_V(4); PG8_BAR;
        PG8_STAGE(PG8_SB(1, 0), cB + kstep, voffB); PG8_STAGE(PG8_SA(1, 0), cA + kstep, voffA); PG8_STAGE(PG8_SB(1, 1), cB + hstepB + kstep, voffB);
        PG8_WAIT_V(6); PG8_BAR;
    }
    for (;;) {
        const bool has_next = S.next(ui + 1, nxt);
        const char* nA = has_next ? (const char*)((Sched::KSEG && nxt.sel) ? g.A2 : g.A) + (size_t)nxt.pm * tstepA + (Sched::KSEG ? (size_t)nxt.k0 * 2 : 0) : cA; const char* nB = has_next ? (const char*)((Sched::KSEG && nxt.sel) ? g.Bt2 : g.Bt) + (size_t)nxt.pb * tstepB + (Sched::KSEG ? (size_t)nxt.k0 * 2 : 0) : cB;
        for (int t = 0; t < nt; t += 2) {
            const bool last = (t == nt - 2);
            const char* a1 = cA + (size_t)(t + 1) * kstep;
            const char* a2 = last ? nA : cA + (size_t)(t + 2) * kstep; const char* b2 = last ? nB : cB + (size_t)(t + 2) * kstep;
            const char* a3 = a2 + kstep; const char* b3 = b2 + kstep;
            if (last && has_next) S.a_ready(nxt);
            if constexpr (SP2) {
            PG8_LDB(B0, 0, 0); PG8_LDB(B1, 0, 1); PG8_SCHED; PG8_LDA(At, 0, 0); PG8_STAGE(PG8_SA(1, 1), a1 + hstepA, voffA);
            PG8_WAIT_V(8); PG8_WAIT_L(0); PG8_BAR; PG8_MMA(0, 0, At, B0); PG8_MMA(0, 1, At, B1); PG8_BAR; PG8_SCHED;
            PG8_LDA(At, 0, 1); PG8_STAGE(PG8_SB(0, 0), b2, voffB); PG8_STAGE(PG8_SB(0, 1), b2 + hstepB, voffB); PG8_STAGE(PG8_SA(0, 0), a2, voffA);
            PG8_WAIT_V(8); PG8_WAIT_L(0); PG8_BAR; PG8_MMA(1, 0, At, B0); PG8_MMA(1, 1, At, B1); PG8_BAR; PG8_SCHED;
            PG8_LDB(B0, 1, 0); PG8_LDB(B1, 1, 1); PG8_SCHED; PG8_LDA(At, 1, 0); PG8_STAGE(PG8_SA(0, 1), a2 + hstepA, voffA);
            PG8_WAIT_V(8); PG8_WAIT_L(0); PG8_BAR; PG8_MMA(0, 0, At, B0); PG8_MMA(0, 1, At, B1); PG8_BAR; PG8_SCHED;
            PG8_LDA(At, 1, 1); PG8_STAGE(PG8_SB(1, 0), b3, voffB); PG8_STAGE(PG8_SB(1, 1), b3 + hstepB, voffB); PG8_STAGE(PG8_SA(1, 0), a3, voffA);
            PG8_WAIT_V(8); PG8_WAIT_L(0); PG8_BAR; PG8_MMA(1, 0, At, B0); PG8_MMA(1, 1, At, B1); PG8_BAR; PG8_SCHED;
            } else {
            PG8_LDB(B0, 0, 0); PG8_SCHED; PG8_LDA(At, 0, 0); PG8_STAGE(PG8_SA(1, 1), a1 + hstepA, voffA);
            PG8_WAIT_L(8); PG8_BAR; PG8_WAIT_L(0); PG8_MMA(0, 0, At, B0); PG8_BAR; PG8_SCHED;
            PG8_LDB(B1, 0, 1); PG8_STAGE(PG8_SB(0, 0), b2, voffB);
            PG8_BAR; PG8_WAIT_L(0); PG8_MMA(0, 1, At, B1); PG8_BAR;
            PG8_LDA(At, 0, 1); PG8_STAGE(PG8_SA(0, 0), a2, voffA);
            PG8_BAR; PG8_WAIT_L(0); PG8_MMA(1, 0, At, B0); PG8_BAR; PG8_SCHED;
            PG8_STAGE(PG8_SB(0, 1), b2 + hstepB, voffB);
            PG8_WAIT_V(6); PG8_BAR; PG8_MMA(1, 1, At, B1); PG8_BAR;
            PG8_LDB(B0, 1, 0); PG8_SCHED; PG8_LDA(At, 1, 0); PG8_STAGE(PG8_SA(0, 1), a2 + hstepA, voffA);
            PG8_WAIT_L(8); PG8_BAR; PG8_WAIT_L(0); PG8_MMA(0, 0, At, B0); PG8_BAR; PG8_SCHED;
            PG8_LDB(B1, 1, 1); PG8_STAGE(PG8_SB(1, 0), b3, voffB);
            PG8_BAR; PG8_WAIT_L(0); PG8_MMA(0, 1, At, B1); PG8_BAR;
            PG8_LDA(At, 1, 1); PG8_STAGE(PG8_SA(1, 0), a3, voffA);
            PG8_BAR; PG8_WAIT_L(0); PG8_MMA(1, 0, At, B0); PG8_BAR; PG8_SCHED;
            PG8_STAGE(PG8_SB(1, 1), b3 + hstepB, voffB);
            PG8_WAIT_V(6); PG8_BAR; PG8_MMA(1, 1, At, B1); PG8_BAR;
            }
        }
        if constexpr (ALIGN_EPI) { if (wr == 0) PG8_BAR; }
        if constexpr (!Epi::AFTER_DRAIN) { int te_ = threadIdx.x; asm volatile("" : "+v"(te_) :: "memory");     E(acc, cur, wr, wc, te_ & 15, (te_ & 63) >> 4); S.done(cur); }
        if (!has_next) break;
        if (!Sched::carry(cur)) {
#pragma unroll
        for (int a = 0; a < 2; ++a)
#pragma unroll
            for (int b = 0; b < 2; ++b)
#pragma unroll
                for (int m = 0; m < 4; ++m)
#pragma unroll
                    for (int n = 0; n < 2; ++n) acc[a][b][m][n] = (f32x4){0.f, 0.f, 0.f, 0.f};
        }
        cur = nxt; cA = nA; cB = nB; ++ui; if constexpr (Sched::KSEG) nt = cur.nt;
        if constexpr (ALIGN_EPI) { if (wr == 1) PG8_BAR; }
    }
    PG8_WAIT_V(0);
    if constexpr (!ALIGN_EPI) { if (wr == 0) PG8_BAR; }
    PG8_BAR;
    if constexpr (Epi::AFTER_DRAIN) { E.fused(acc, cur, wr, wc, fr, fq, lds, wid, lane); S.done(cur); }
#undef PG8_SA
#undef PG8_SB
#undef PG8_STAGE
#undef PG8_LDA
#undef PG8_LDB
#undef PG8_MMA
#undef PG8_WAIT_V
#undef PG8_WAIT_L
#undef PG8_BAR
#undef PG8_SCHED
}
}
namespace pg8 {
__device__ __forceinline__ float row_rstd(const float* ssq, int row) {
    const f32x4 a = *(const f32x4*)(ssq + (size_t)row * 4);
    return 1.0f / sqrtf(((a[0] + a[1]) + (a[2] + a[3])) * (1.0f / 1024.0f) + 1e-6f);
}
__device__ __forceinline__ void rstd8(const float* ssq, int row0, int, float (&rs)[8]) {
    f32x4 q[8];
#pragma unroll
    for (int i = 0; i < 8; ++i) q[i] = *(const f32x4*)(ssq + (size_t)(row0 + (i >> 2) * HALF + (i & 3) * 16) * 4);
#pragma unroll
    for (int i = 0; i < 8; ++i) { const float t = (q[i][0] + q[i][1]) + (q[i][2] + q[i][3]); rs[i] = __builtin_amdgcn_rsqf(t * (1.0f / 1024.0f) + 1e-6f); }
}
__device__ __forceinline__ float xsum32(float v) { const auto r = __builtin_amdgcn_permlane32_swap(__float_as_uint(v), __float_as_uint(v), false, false); return __uint_as_float(r[0]) + __uint_as_float(r[1]); }
__device__ __forceinline__ float xsum16(float v) { const auto r = __builtin_amdgcn_permlane16_swap(__float_as_uint(v), __float_as_uint(v), false, false); return __uint_as_float(r[0]) + __uint_as_float(r[1]); }
__device__ __forceinline__ float xmax32(float v) { const auto r = __builtin_amdgcn_permlane32_swap(__float_as_uint(v), __float_as_uint(v), false, false); return __builtin_fmaxf(__uint_as_float(r[0]), __uint_as_float(r[1])); }
__device__ __forceinline__ float partner16(float v, bool odd16) { const auto r = __builtin_amdgcn_permlane16_swap(__float_as_uint(v), __float_as_uint(v), false, false); return __uint_as_float(odd16 ? r[0] : r[1]); }
__device__ __forceinline__ void store_wt(void* p, u32x4 v) { asm volatile("global_store_dwordx4 %0, %1, off sc1\n\ts_nop 1" :: "v"(p), "v"(v) : "memory"); }
__device__ __forceinline__ u32x4 pack8(const float (&v)[8]) { u32x4 w; w.x = cvt_pk_bf16(v[0], v[1]); w.y = cvt_pk_bf16(v[2], v[3]); w.z = cvt_pk_bf16(v[4], v[5]); w.w = cvt_pk_bf16(v[6], v[7]); return w; }
__device__ __forceinline__ void unpack8(const u32x4 w, float (&v)[8]) {
    v[0] = __uint_as_float(w.x << 16); v[1] = __uint_as_float(w.x & 0xffff0000u); v[2] = __uint_as_float(w.y << 16); v[3] = __uint_as_float(w.y & 0xffff0000u);
    v[4] = __uint_as_float(w.z << 16); v[5] = __uint_as_float(w.z & 0xffff0000u); v[6] = __uint_as_float(w.w << 16); v[7] = __uint_as_float(w.w & 0xffff0000u);
}
#define PG8_V8(v, a, b, sc) do { v[0] = a[0] * (sc); v[1] = a[1] * (sc); v[2] = a[2] * (sc); v[3] = a[3] * (sc); v[4] = b[0] * (sc); v[5] = b[1] * (sc); v[6] = b[2] * (sc); v[7] = b[3] * (sc); } while (0)

struct EpiQKV {
    static constexpr bool PERM = true, AFTER_DRAIN = false, PRELOAD = false;
    bf16_t* ZQ; bf16_t* ZKV; const float* ssq; const unsigned* rope; float* ksum;
    template <int NB, bool KSUM> __device__ __forceinline__ void body(const f32x4 (&acc)[2][2][4][2], const Unit& u, int wr, int wc, int fr, int fq) const {
        const int row0 = u.pm * BM + wr * 64 + fr, colt = u.pn * BM;
        bf16_t* base; int ldc, cb;
        if (colt < 1024) { base = ZQ; ldc = 1024; cb = colt; } else { base = ZKV; ldc = 1536; cb = colt - 1024; }
        const int hg0 = (colt + wc * 32) >> 6;
        const bool half0 = (wc & 1) == 0;
        const bool rope0 = (hg0 < 12) || (hg0 >= 16 && hg0 < 22) || (hg0 >= 28 && hg0 < 34), rope1 = (hg0 + 2 < 12) || (hg0 + 2 >= 16 && hg0 + 2 < 22) || (hg0 + 2 >= 28 && hg0 + 2 < 34);
        const bool anyrope = half0 && (rope0 || rope1);
        float rs[8]; rstd8(ssq, row0, fq, rs);
        asm volatile("" ::: "memory");
        float ks[2][8];
        if (KSUM) {
#pragma unroll
            for (int bj = 0; bj < 2; ++bj)
#pragma unroll
                for (int j = 0; j < 8; ++j) ks[bj][j] = 0.f; }
#pragma unroll
        for (int rb = 0; rb < 8; rb += NB) {
            u32x4 rt[NB][2];
            if (anyrope) {
#pragma unroll
                for (int i = 0; i < NB; ++i) { const int ri = rb + i; const u32x4* rp = (const u32x4*)(rope + (size_t)((row0 + (ri >> 2) * HALF + (ri & 3) * 16) & 2047) * 8);
                    rt[i][0] = rp[0]; rt[i][1] = rp[1]; } }
#pragma unroll
            for (int i = 0; i < NB; ++i) {
                const int ri = rb + i, ai = ri >> 2, m = ri & 3;
                const int row = row0 + ai * HALF + m * 16;
                const float rstd = rs[ri];
#pragma unroll
                for (int bj = 0; bj < 2; ++bj) {
                    const int hg = hg0 + 2 * bj;
                    const bool isrope = bj == 0 ? rope0 : rope1;
                    float v[8]; PG8_V8(v, acc[ai][bj][m][0], acc[ai][bj][m][1], rstd);
                    if (isrope && half0) {
                        float p[8];
#pragma unroll
                        for (int j = 0; j < 8; ++j) p[j] = partner16(v[j], (fq & 1) != 0);
                        if (fq < 2) { const float sg = (fq == 0) ? -1.f : 1.f;
#pragma unroll
                            for (int j = 0; j < 8; ++j) { const unsigned w = rt[i][j >> 2][j & 3]; const float cs = (float)__builtin_bit_cast(_Float16, (unsigned short)(w & 0xffffu)), sn = (float)__builtin_bit_cast(_Float16, (unsigned short)(w >> 16));
                                v[j] = v[j] * cs + sg * (p[j] * sn); } }
                    }
                    if (hg < 16) {
#pragma unroll
                        for (int j = 0; j < 8; ++j) v[j] *= 0.18033688011112042f; }
                    *(u32x4*)(base + ((unsigned)row * (unsigned)ldc + (unsigned)(cb + bj * HALF + wc * 32 + 8 * fq))) = pack8(v);
                    if (KSUM) { if (hg >= 28 && hg < 34) {
#pragma unroll
                        for (int j = 0; j < 8; ++j) ks[bj][j] += v[j]; } }
                }
            }
        }
        if (KSUM) {
#pragma unroll
            for (int bj = 0; bj < 2; ++bj) { const int hg = hg0 + 2 * bj;
                if (hg >= 28 && hg < 34) {
                    float* kp = ksum + (size_t)(u.pm * 6 + (hg - 28)) * 64 + (wc & 1) * 32 + 8 * fq;
#pragma unroll
                    for (int j = 0; j < 8; ++j) { float s = ks[bj][j]; s += __shfl_xor(s, 1); s += __shfl_xor(s, 2); s += __shfl_xor(s, 4); s += __shfl_xor(s, 8);
                        if (fr == 0) atomicAdd(kp + j, s); }
                } }
        }
    }
    __device__ __forceinline__ void operator()(const f32x4 (&acc)[2][2][4][2], const Unit& u, int wr, int wc, int fr, int fq) const {
        if (u.pn == 7 || u.pn == 8) body<4, true>(acc, u, wr, wc, fr, fq); else body<4, false>(acc, u, wr, wc, fr, fq);
    }
};
struct EpiGate {
    static constexpr bool PERM = true, AFTER_DRAIN = false, PRELOAD = false;
    bf16_t* ZG; const float* ssq;
    __device__ __forceinline__ void operator()(const f32x4 (&acc)[2][2][4][2], const Unit& u, int wr, int wc, int fr, int fq) const {
        const int row0 = u.pm * BM + wr * 64 + fr, col0 = u.pn * BM + wc * 32 + 8 * fq;
        float rs[8]; rstd8(ssq, row0, fq, rs);
#pragma unroll
        for (int ai = 0; ai < 2; ++ai)
#pragma unroll
            for (int m = 0; m < 4; ++m) { const int row = row0 + ai * HALF + m * 16; const float rstd = rs[ai * 4 + m];
#pragma unroll
                for (int bj = 0; bj < 2; ++bj) { float v[8]; PG8_V8(v, acc[ai][bj][m][0], acc[ai][bj][m][1], rstd);
#pragma unroll
                    for (int j = 0; j < 8; ++j) v[j] = __builtin_amdgcn_rcpf(1.0f + __builtin_amdgcn_exp2f(v[j] * -1.4426950408889634f));
                    *(u32x4*)(ZG + (size_t)row * 3072 + col0 + bj * HALF) = pack8(v); } }
    }
};
struct EpiPlain {
    static constexpr bool PERM = true, AFTER_DRAIN = false, PRELOAD = false;
    bf16_t* O; int ldc;
    __device__ __forceinline__ void operator()(const f32x4 (&acc)[2][2][4][2], const Unit& u, int wr, int wc, int fr, int fq) const {
        const int row0 = u.pm * BM + wr * 64 + fr, col0 = u.pn * BM + wc * 32 + 8 * fq;
#pragma unroll
        for (int ai = 0; ai < 2; ++ai)
#pragma unroll
            for (int m = 0; m < 4; ++m) { const int row = row0 + ai * HALF + m * 16;
#pragma unroll
                for (int bj = 0; bj < 2; ++bj) { float v[8]; PG8_V8(v, acc[ai][bj][m][0], acc[ai][bj][m][1], 1.0f);
                    *(u32x4*)(O + (size_t)row * ldc + col0 + bj * HALF) = pack8(v); } }
    }
};
template <int BR> struct EpiProj {
    static constexpr bool PERM = true, AFTER_DRAIN = false, PRELOAD = false;
    bf16_t* ZG;
    __device__ __forceinline__ void operator()(const f32x4 (&acc)[2][2][4][2], const Unit& u, int wr, int wc, int fr, int fq) const {
        const int row0 = u.pm * BM + wr * 64 + fr, col0 = u.pn * BM + wc * 32 + 8 * fq;
#pragma unroll
        for (int ai = 0; ai < 2; ++ai)
#pragma unroll
            for (int m = 0; m < 4; ++m) { const int row = row0 + ai * HALF + m * 16;
#pragma unroll
                for (int bj = 0; bj < 2; ++bj) { bf16_t* yp = ZG + (size_t)row * 3072 + col0 + bj * HALF;
                    float g[8], v[8]; unpack8(*(const u32x4*)(yp + BR * 1024), g); PG8_V8(v, acc[ai][bj][m][0], acc[ai][bj][m][1], 1.0f);
                    if (BR > 0) { float y[8]; unpack8(*(const u32x4*)yp, y);
#pragma unroll
                        for (int j = 0; j < 8; ++j) v[j] = y[j] + g[j] * v[j]; }
                    else {
#pragma unroll
                        for (int j = 0; j < 8; ++j) v[j] = g[j] * v[j]; }
                    *(u32x4*)yp = pack8(v); } }
    }
};
struct GateProjOrder : StaticOrder {
    static constexpr bool KSEG = true;
    __host__ __device__ static bool carry(const Unit& u) { return u.br == 3 || u.br == 4; }
    __host__ __device__ bool next(int i, Unit& u) const {
        if (!StaticOrder::next(i / 6, u)) return false;
        const int sg = i % 6; u.br = sg;
        if (sg < 3) { u.sel = 0; u.pb = 4 * sg + u.pn; u.k0 = 0; u.nt = 16; }
        else { u.sel = 1; u.pb = u.pn; u.k0 = (sg == 3) ? 0 : (sg == 4) ? 384 : 768; u.nt = (sg == 3) ? 2 : (sg == 4) ? 6 : 4; }
        return true;
    }
};
struct EpiGateProj {
    static constexpr bool PERM = true, AFTER_DRAIN = false, PRELOAD = false;
    bf16_t* ZG; const float* ssq;
    __device__ __forceinline__ void operator()(f32x4 (&acc)[2][2][4][2], const Unit& u, int wr, int wc, int fr, int fq) const {
        const int row0 = u.pm * BM + wr * 64 + fr, col0 = u.pn * BM + wc * 32 + 8 * fq;
        const unsigned o0 = (unsigned)row0 * 3072u + (unsigned)col0;
        if (u.br < 3) {
            float rs[8]; rstd8(ssq, row0, fq, rs);
            const unsigned og = o0 + (unsigned)u.br * 1024u;
#pragma unroll
            for (int ai = 0; ai < 2; ++ai)
#pragma unroll
                for (int m = 0; m < 4; ++m) { const float rstd = rs[ai * 4 + m];
#pragma unroll
                    for (int bj = 0; bj < 2; ++bj) { float v[8]; PG8_V8(v, acc[ai][bj][m][0], acc[ai][bj][m][1], rstd);
#pragma unroll
                        for (int j = 0; j < 8; ++j) v[j] = __builtin_amdgcn_rcpf(1.0f + __builtin_amdgcn_exp2f(v[j] * -1.4426950408889634f));
                        *(u32x4*)(ZG + (og + (unsigned)((ai * HALF + m * 16) * 3072 + bj * HALF))) = pack8(v); } }
        } else if (u.br == 5) {
#pragma unroll
            for (int ai = 0; ai < 2; ++ai) {
                u32x4 g2[4][2];
#pragma unroll
                for (int m = 0; m < 4; ++m)
#pragma unroll
                    for (int bj = 0; bj < 2; ++bj) g2[m][bj] = *(const u32x4*)(ZG + (o0 + 2048u + (unsigned)((ai * HALF + m * 16) * 3072 + bj * HALF)));
#pragma unroll
                for (int m = 0; m < 4; ++m)
#pragma unroll
                    for (int bj = 0; bj < 2; ++bj) { float gn[8], v[8]; unpack8(g2[m][bj], gn); PG8_V8(v, acc[ai][bj][m][0], acc[ai][bj][m][1], 1.0f);
#pragma unroll
                        for (int j = 0; j < 8; ++j) v[j] = gn[j] * v[j];
                        store_wt(ZG + (o0 + (unsigned)((ai * HALF + m * 16) * 3072 + bj * HALF)), pack8(v)); }
            }
        }
        if (u.br == 3 || u.br == 4) {
            const unsigned on = o0 + (unsigned)(u.br - 3) * 1024u;
#pragma unroll
            for (int ai = 0; ai < 2; ++ai)
#pragma unroll
                for (int mp = 0; mp < 4; mp += 2) {
                    u32x4 gn_[2][2], gd_[2][2];
#pragma unroll
                    for (int mm = 0; mm < 2; ++mm)
#pragma unroll
                        for (int bj = 0; bj < 2; ++bj) { const unsigned o = on + (unsigned)((ai * HALF + (mp + mm) * 16) * 3072 + bj * HALF); gn_[mm][bj] = *(const u32x4*)(ZG + o); gd_[mm][bj] = *(const u32x4*)(ZG + (o + 1024u)); }
#pragma unroll
                    for (int mm = 0; mm < 2; ++mm)
#pragma unroll
                        for (int bj = 0; bj < 2; ++bj) { const int m = mp + mm; float gn[8], gd[8]; unpack8(gn_[mm][bj], gn); unpack8(gd_[mm][bj], gd);
#pragma unroll
                            for (int j = 0; j < 8; ++j) gn[j] = gn[j] * __builtin_amdgcn_rcpf(fmaxf(gd[j], 1e-30f));
                            acc[ai][bj][m][0] = acc[ai][bj][m][0] * (f32x4){gn[0], gn[1], gn[2], gn[3]}; acc[ai][bj][m][1] = acc[ai][bj][m][1] * (f32x4){gn[4], gn[5], gn[6], gn[7]};
                            asm volatile("" : "+v"(acc[ai][bj][m][0]), "+v"(acc[ai][bj][m][1])); }
                }
        }
    }
};
struct EpiRes {
    static constexpr bool PERM = true, AFTER_DRAIN = true, PRELOAD = true;
    __device__ static bool stores16(const Unit&) { return true; }
    bf16_t* xb; float* ssq;
    __device__ __forceinline__ void preload(u32x4 (&pre)[2][4][2], const Unit& u, int wr, int wc, int fr, int fq) const {
        const unsigned o0 = (unsigned)(u.pm * BM + wr * 64 + fr) * 1024u + (unsigned)(u.pn * BM + wc * 32 + 8 * fq);
#pragma unroll
        for (int ai = 0; ai < 2; ++ai)
#pragma unroll
            for (int m = 0; m < 4; ++m)
#pragma unroll
                for (int bj = 0; bj < 2; ++bj) pre[ai][m][bj] = *(const u32x4*)(xb + (o0 + (unsigned)((ai * HALF + m * 16) * 1024 + bj * HALF)));
    }
    __device__ __forceinline__ void fused(const f32x4 (&acc)[2][2][4][2], const Unit& u, int wr, int wc, int, int, PG8_LAS unsigned char* lds, int, int) const {
        int te_ = threadIdx.x; asm volatile("" : "+v"(te_) :: "memory"); const int fr = te_ & 15, fq = (te_ & 63) >> 4;
        const int row0 = u.pm * BM + wr * 64 + fr, col0 = u.pn * BM + wc * 32 + 8 * fq;
        const unsigned o0 = (unsigned)row0 * 1024u + (unsigned)col0;
        PG8_LAS float* P = (PG8_LAS float*)lds;
#pragma unroll
        for (int ai = 0; ai < 2; ++ai) {
#pragma unroll
            for (int m = 0; m < 4; ++m) { float sq = 0.f;
#pragma unroll
                for (int bj = 0; bj < 2; ++bj) {
                    float v[8]; PG8_V8(v, acc[ai][bj][m][0], acc[ai][bj][m][1], 1.0f);
#pragma unroll
                    for (int j = 0; j < 8; ++j) sq += v[j] * v[j];
                    store_wt(xb + (o0 + (unsigned)((ai * HALF + m * 16) * 1024 + bj * HALF)), pack8(v)); }
                sq = xsum16(sq); sq = xsum32(sq);
                if (fq == 0) P[(ai * HALF + wr * 64 + m * 16 + fr) * 4 + wc] = sq; }
        }
        asm volatile("s_waitcnt lgkmcnt(0)" ::: "memory"); __builtin_amdgcn_s_barrier(); asm volatile("" ::: "memory");
        if (te_ < 256) { const f32x4 p = *(PG8_LAS const f32x4*)(P + te_ * 4); ssq[(unsigned)(u.pm * BM + te_) * 4u + (unsigned)u.pn] = (p[0] + p[1]) + (p[2] + p[3]); }
    }
};
struct EpiUp {
    static constexpr bool PERM = true, AFTER_DRAIN = false, PRELOAD = false;
    bf16_t* U; const float* ssq;
    __device__ __forceinline__ void operator()(const f32x4 (&acc)[2][2][4][2], const Unit& u, int wr, int wc, int fr, int fq) const {
        const int row0 = u.pm * BM + wr * 64 + fr, col0 = u.pn * BM + wc * 32 + 8 * fq;
        float rs[8]; rstd8(ssq, row0, fq, rs);
#pragma unroll
        for (int ai = 0; ai < 2; ++ai)
#pragma unroll
            for (int m = 0; m < 4; ++m) { const int row = row0 + ai * HALF + m * 16; const float rstd = rs[ai * 4 + m];
#pragma unroll
                for (int bj = 0; bj < 2; ++bj) { float v[8]; PG8_V8(v, acc[ai][bj][m][0], acc[ai][bj][m][1], rstd);
#pragma unroll
                    for (int j = 0; j < 8; ++j) { const float r = fmaxf(v[j], 0.f); v[j] = r * r; }
                    store_wt(U + (size_t)row * 4096 + col0 + bj * HALF, pack8(v)); } }
    }
};
}
#define GAS __attribute__((address_space(1)))
#define LAS __attribute__((address_space(3)))
typedef unsigned short bf16;
typedef unsigned v4u __attribute__((ext_vector_type(4)));
typedef float f32x4 __attribute__((ext_vector_type(4)));
typedef short bf16x8 __attribute__((ext_vector_type(8)));
typedef GAS unsigned gu32;
typedef GAS unsigned long long gu64;
#define RLX_AGENT __ATOMIC_RELAXED, __HIP_MEMORY_SCOPE_AGENT
#define LDS_WAIT() asm volatile("s_waitcnt lgkmcnt(0)" ::: "memory")
#define VM_WAIT() asm volatile("s_waitcnt vmcnt(0)" ::: "memory")
__device__ __forceinline__ unsigned long long rt() { return __builtin_amdgcn_s_memrealtime(); }
__device__ __forceinline__ unsigned f2bf(float f) { unsigned u = __builtin_bit_cast(unsigned, f); return (u + 0x7fffu + ((u >> 16) & 1u)) >> 16; }
__device__ __forceinline__ unsigned pk2(float lo, float hi) { return f2bf(lo) | (f2bf(hi) << 16); }

#define XB_TMO      128
#define XB_XCNT(j)  (256  + 64 * (j))
#define XB_XSUB(j)  (1280 + 64 * (j))
#define XB_XGEN(j)  (2304 + 64 * (j))
#define XB_TOP      3328
#define XB_TOPGEN   3392
#define XCD_BAR_WORDS 3456
#define XB_SPIN_CAP (1u << 18)

__device__ __forceinline__ unsigned xb_ld(unsigned* p)              { return __hip_atomic_load(p, __ATOMIC_RELAXED, __HIP_MEMORY_SCOPE_AGENT); }
__device__ __forceinline__ unsigned xb_add(unsigned* p, unsigned v) { return __hip_atomic_fetch_add(p, v, __ATOMIC_RELAXED, __HIP_MEMORY_SCOPE_AGENT); }
__device__ __forceinline__ unsigned xb_xcc_id() { return (unsigned)__builtin_amdgcn_s_getreg((3 << 11) | 20) & 0xFu; }
#define XB_SPIN(cond, bar) do { unsigned _sp = 0; while (cond) { __builtin_amdgcn_s_sleep(1); \
    if ((++_sp & 255u) == 0u) { if (xb_ld(&(bar)[XB_TMO])) break; if (_sp > XB_SPIN_CAP) { atomicAdd(&(bar)[XB_TMO], 1u); break; } } } } while (0)

struct XcdBarrier {
    unsigned* bar; unsigned x;
    volatile LAS unsigned* st;
};

__device__ __forceinline__ XcdBarrier xcd_barrier_post(unsigned* bar, volatile LAS unsigned* st) {
    XcdBarrier b; b.bar = bar; b.x = xb_xcc_id(); b.st = st;
    if (threadIdx.x == 0) (void)xb_add(&bar[XB_XCNT(b.x)], 1u);
    return b;
}
__device__ __forceinline__ void xcd_barrier_complete(unsigned* bar, unsigned x, unsigned& nloc, unsigned& nx) {
    const unsigned G = gridDim.x * gridDim.y * gridDim.z;
    unsigned sum, cnt, mine, sp = 0u;
    for (;;) {
        sum = 0u; cnt = 0u; mine = 0u;
#pragma unroll
        for (unsigned j = 0; j < 16; ++j) { const unsigned c = xb_ld(&bar[XB_XCNT(j)]); sum += c; cnt += (c > 0u) ? 1u : 0u; mine = (j == x) ? c : mine; }
        if (sum == G) break;
        __builtin_amdgcn_s_sleep(1);
        if ((++sp & 255u) == 0u) { if (xb_ld(&bar[XB_TMO])) break; if (sp > XB_SPIN_CAP) { atomicAdd(&bar[XB_TMO], 1u); break; } }
    }
    nloc = mine > 0u ? mine : 1u; nx = cnt > 0u ? cnt : 1u;
}

__device__ __forceinline__ void xcd_barrier(const XcdBarrier& b) {
    asm volatile("s_waitcnt vmcnt(0)" ::: "memory");
    __syncthreads();
    if (threadIdx.x == 0) {
        unsigned* bar = b.bar;
        __builtin_amdgcn_s_waitcnt(0);
        unsigned nloc = b.st[0], nx = b.st[1];
        if (nloc == 0u) { xcd_barrier_complete(bar, b.x, nloc, nx); b.st[0] = nloc; b.st[1] = nx; }
        const unsigned old = xb_add(&bar[XB_XSUB(b.x)], 1u);
        const unsigned gen = old / nloc;
        if (old + 1u == (gen + 1u) * nloc) {
            __builtin_amdgcn_fence(__ATOMIC_RELEASE, "agent");
            asm volatile("s_waitcnt vmcnt(0)" ::: "memory");
            const unsigned og = xb_add(&bar[XB_TOP], 1u);
            const unsigned tg = og / nx;
            if (og + 1u == (tg + 1u) * nx) xb_add(&bar[XB_TOPGEN], 1u);
            else XB_SPIN(xb_ld(&bar[XB_TOPGEN]) == tg, bar);
            __builtin_amdgcn_fence(__ATOMIC_ACQUIRE, "agent");
            xb_add(&bar[XB_XGEN(b.x)], 1u);
            asm volatile("s_waitcnt vmcnt(0)" ::: "memory");
        } else {
            XB_SPIN(xb_ld(&bar[XB_XGEN(b.x)]) == gen, bar);
            __builtin_amdgcn_fence(__ATOMIC_ACQUIRE, "agent");
            asm volatile("s_waitcnt vmcnt(0)" ::: "memory");
        }
    }
    __syncthreads();
}

constexpr int NWAVES = 8;
constexpr int T = 16384, D = 1024, SEQ = 2048, FF = 4096, DIN = 5632, NQKV = 2560, NGATE = 3072, NMEMROWS = 2048;
constexpr size_t MiB = 1u << 20;
constexpr size_t WS_CTL = 0, CTL_ZERO_BYTES = 1 * MiB;
constexpr size_t WS_KSUM = 256 * 1024;
constexpr size_t WS_ROPE = 1 * MiB;
constexpr size_t WS_SSQ = 2 * MiB;
constexpr size_t WS_PTRS = 768 * 1024;
constexpr size_t WS_LSE = 3 * MiB;
constexpr size_t WS_MKV = 4 * MiB;
constexpr size_t WS_MEMN = 6 * MiB;
constexpr size_t WS_W = 10 * MiB;
constexpr size_t W_IN = 0, W_UP = 11 * MiB, W_DN = 19 * MiB, W_O = 27 * MiB, W_P = 29 * MiB, W_MKV = 31 * MiB, W_LAYER = 32 * MiB;
constexpr size_t WS_XB = 74 * MiB;
constexpr size_t WS_ZQ = 106 * MiB;
constexpr size_t WS_ZKV = 138 * MiB;
constexpr size_t WS_ZG = 138 * MiB;
constexpr size_t WS_U = 106 * MiB;
constexpr size_t WS_END = 234 * MiB;
constexpr int CW_QUEUE = 2048;
constexpr int CW_BAR = 4096;
constexpr int RING_OFF = 0, RING_BYTES = 131072, LDSCTL_OFF = RING_BYTES, MISC_OFF = LDSCTL_OFF + 320, LDS_BYTES = 147456;

__device__ __forceinline__ float wave_sum(float v) {
#pragma unroll
    for (int o = 1; o < 64; o <<= 1) v += __shfl_xor(v, o);
    return v;
}
__device__ __forceinline__ float bf2f(bf16 h) { return __uint_as_float((unsigned)h << 16); }

struct TrD { const float* W; const float* gain; bf16* WT; int N, ldt, k0, n0, drow, dcol; };
__device__ __forceinline__ void tr_load(const TrD& d, f32x4 (&v)[8], float (&gn)[8], int lane) {
    const int lr = lane >> 3, n4 = lane & 7;
#pragma unroll
    for (int i = 0; i < 8; ++i) { const int kk = 8 * i + lr; v[i] = *(const GAS f32x4*)(d.W + (size_t)(d.k0 + kk) * d.N + d.n0 + 4 * n4); gn[i] = d.gain ? d.gain[d.k0 + kk] : 1.0f; }
}
__device__ __forceinline__ void tr_fin(const TrD& d, const f32x4 (&v)[8], const float (&gn)[8], LAS float* scr, int lane) {
    const int lr = lane >> 3, n4 = lane & 7;
#pragma unroll
    for (int i = 0; i < 8; ++i) { const int kk = 8 * i + lr; LAS float* q = scr + kk * 33 + 4 * n4; q[0] = v[i].x * gn[i]; q[1] = v[i].y * gn[i]; q[2] = v[i].z * gn[i]; q[3] = v[i].w * gn[i]; }
    LDS_WAIT(); asm volatile("" ::: "memory");
    const int c = lane & 7;
#pragma unroll
    for (int j = 0; j < 4; ++j) { const int n = (lane >> 3) + 8 * j; const LAS float* s = scr + (8 * c) * 33 + n;
        v4u o; o.x = pk2(s[0 * 33], s[1 * 33]); o.y = pk2(s[2 * 33], s[3 * 33]); o.z = pk2(s[4 * 33], s[5 * 33]); o.w = pk2(s[6 * 33], s[7 * 33]);
        *(GAS v4u*)(d.WT + (size_t)(d.drow + n) * d.ldt + d.dcol + d.k0 + 8 * c) = o; }
    LDS_WAIT(); asm volatile("" ::: "memory");
}
__device__ __forceinline__ int win_dest_row(int n) {
    if (n < 384) return n;
    if (n < 768) return 1024 + (n - 384);
    if (n < 1152) return 1024 + 384 + (n - 768);
    if (n < 1536) return 384 + (n - 1152);
    if (n < 1920) return 1024 + 768 + (n - 1536);
    if (n < 2304) return 1024 + 1152 + (n - 1920);
    if (n < 2560) return 768 + (n - 2304);
    return n;
}

typedef unsigned u32x4p __attribute__((ext_vector_type(4)));

namespace att {
typedef short bf16x8 __attribute__((ext_vector_type(8)));
typedef short s16x4 __attribute__((ext_vector_type(4)));
typedef float f32x16 __attribute__((ext_vector_type(16)));
constexpr int KP = 144, VP = 192;
constexpr int KBUF = 64 * KP, VBUF = 64 * VP, BUF = KBUF + VBUF;
constexpr float LOG2E = 1.4426950408889634f;
__device__ __forceinline__ int crow(int r, int hi) { return (r & 3) + 8 * (r >> 2) + 4 * hi; }
__device__ __forceinline__ float xsum(float v) { return pg8::xsum32(v); }
__device__ __forceinline__ float xmax(float v) { return pg8::xmax32(v); }
__device__ __forceinline__ s16x4 vtr(LAS const unsigned char* p) { typedef short v4i16_t __attribute__((ext_vector_type(4))); return __builtin_bit_cast(s16x4, __builtin_amdgcn_ds_read_tr16_b64_v4i16((LAS v4i16_t*)p)); }

struct Unit {
    int kind;
    const bf16* Q; bf16* O;
    int qrow0, qstride, nq;
    const bf16* K; const bf16* V; int kvpitch;
    int krow0, kstride;
    int t_lo, t_hi;
    int qidx0;
    int qb;
    const float* ksum;
    float* lse; int lse_stride;
};

template <int KIND> __device__ __forceinline__ void att_tile(LAS const unsigned char* kb, const Unit& u, int t, int wid, int qi, int hi, unsigned koff, unsigned voff, unsigned sel,
                                                             const bf16x8 (&qf)[4], float& m, f32x16& o0, f32x16& o1, f32x16& o2) {
    bf16x8 ka[4], kc[4];
#pragma unroll
    for (int ks = 0; ks < 4; ++ks) { ka[ks] = *(LAS const bf16x8*)(kb + koff + 32 * ks); kc[ks] = *(LAS const bf16x8*)(kb + koff + 32 * KP + 32 * ks); }
    bf16x8 va[2][2], vc[2][2];
#pragma unroll
    for (int sub_ = 0; sub_ < 2; ++sub_)
#pragma unroll
        for (int s = 0; s < 2; ++s) {
            LAS const unsigned char* vb = kb + voff + (32 * sub_ + 16 * s) * VP;
            const s16x4 a_lo = vtr(vb), a_hi = vtr(vb + 8 * VP), b_lo = vtr(vb + 64), b_hi = vtr(vb + 8 * VP + 64);
            va[sub_][s] = (bf16x8){a_lo[0], a_lo[1], a_lo[2], a_lo[3], a_hi[0], a_hi[1], a_hi[2], a_hi[3]};
            vc[sub_][s] = (bf16x8){b_lo[0], b_lo[1], b_lo[2], b_lo[3], b_hi[0], b_hi[1], b_hi[2], b_hi[3]};
        }
    const int qlo = u.qidx0 + 32 * wid;
    bool bs = true, needmask = false;
    if (KIND == 0) { const int blk = t >> 2; if (blk < u.qb) bs = (sel >> blk) & 1u; else needmask = (64 * t + 63 > qlo); }
    if (KIND == 2) needmask = !((64 * t + 63 <= qlo) && (64 * t >= qlo + 31 - 128));
    const bool unset = (m == -INFINITY);
    const float mref = unset ? 0.f : m;
    const float nv = bs ? -mref : -1e30f;
    f32x16 negt;
#pragma unroll
    for (int r = 0; r < 16; ++r) negt[r] = nv;
    f32x16 p0 = __builtin_amdgcn_mfma_f32_32x32x16_bf16(ka[0], qf[0], negt, 0, 0, 0);
    f32x16 p1 = __builtin_amdgcn_mfma_f32_32x32x16_bf16(kc[0], qf[0], negt, 0, 0, 0);
#pragma unroll
    for (int ks = 1; ks < 4; ++ks) {
        p0 = __builtin_amdgcn_mfma_f32_32x32x16_bf16(ka[ks], qf[ks], p0, 0, 0, 0);
        p1 = __builtin_amdgcn_mfma_f32_32x32x16_bf16(kc[ks], qf[ks], p1, 0, 0, 0);
    }
    if (needmask) {
#pragma unroll
        for (int r = 0; r < 16; ++r) {
            const int j0 = 64 * t + crow(r, hi), j1 = j0 + 32;
            bool v0 = j0 <= qi, v1 = j1 <= qi;
            if (KIND == 2) { v0 = v0 && (j0 >= qi - 128); v1 = v1 && (j1 >= qi - 128); }
            p0[r] = v0 ? p0[r] : -INFINITY; p1[r] = v1 ? p1[r] : -INFINITY;
        }
    }
    float rm = __builtin_fmaxf(p0[0], p1[0]);
#pragma unroll
    for (int r = 1; r < 16; ++r) rm = __builtin_fmaxf(__builtin_fmaxf(rm, p0[r]), p1[r]);
    rm = xmax(rm);
    const bool trig = bs && (rm > 8.0f || (unset && rm > -1e29f));
    if (__any(trig)) {
        const float dl = trig ? rm : 0.f;
        const float alpha = (trig && !unset) ? __builtin_amdgcn_exp2f(-dl) : 1.0f;
        m = trig ? (mref + dl) : m;
#pragma unroll
        for (int r = 0; r < 16; ++r) { p0[r] -= dl; p1[r] -= dl; o0[r] *= alpha; o1[r] *= alpha; o2[r] *= alpha; }
    }
#pragma unroll
    for (int r = 0; r < 16; ++r) { p0[r] = __builtin_amdgcn_exp2f(p0[r]); p1[r] = __builtin_amdgcn_exp2f(p1[r]); }
    bf16x8 pf[2][2];
#pragma unroll
    for (int s = 0; s < 2; ++s) {
        u32x4p w0, w1;
        w0.x = pg8::cvt_pk_bf16(p0[8 * s + 0], p0[8 * s + 1]); w0.y = pg8::cvt_pk_bf16(p0[8 * s + 2], p0[8 * s + 3]); w0.z = pg8::cvt_pk_bf16(p0[8 * s + 4], p0[8 * s + 5]); w0.w = pg8::cvt_pk_bf16(p0[8 * s + 6], p0[8 * s + 7]);
        w1.x = pg8::cvt_pk_bf16(p1[8 * s + 0], p1[8 * s + 1]); w1.y = pg8::cvt_pk_bf16(p1[8 * s + 2], p1[8 * s + 3]); w1.z = pg8::cvt_pk_bf16(p1[8 * s + 4], p1[8 * s + 5]); w1.w = pg8::cvt_pk_bf16(p1[8 * s + 6], p1[8 * s + 7]);
        pf[0][s] = __builtin_bit_cast(bf16x8, w0); pf[1][s] = __builtin_bit_cast(bf16x8, w1);
    }
    const bf16x8 ones = (bf16x8){0x3F80, 0x3F80, 0x3F80, 0x3F80, 0x3F80, 0x3F80, 0x3F80, 0x3F80};
#pragma unroll
    for (int sub_ = 0; sub_ < 2; ++sub_)
#pragma unroll
        for (int s = 0; s < 2; ++s) {
            o0 = __builtin_amdgcn_mfma_f32_32x32x16_bf16(va[sub_][s], pf[sub_][s], o0, 0, 0, 0);
            o1 = __builtin_amdgcn_mfma_f32_32x32x16_bf16(vc[sub_][s], pf[sub_][s], o1, 0, 0, 0);
            o2 = __builtin_amdgcn_mfma_f32_32x32x16_bf16(ones, pf[sub_][s], o2, 0, 0, 0);
        }
}

template <int KIND> __device__ __forceinline__ void run_unit(LAS unsigned char* lds, const Unit& u) {
    int tid_ = threadIdx.x; asm volatile("" : "+v"(tid_));
    const int tid = tid_, lane = tid & 63, wid = __builtin_amdgcn_readfirstlane(tid >> 6), ql = lane & 31, hi = lane >> 5;
    const bool wactive = (32 * wid) < u.nq;
    const int srow = tid >> 3, sch = tid & 7;
    const unsigned kdst = (unsigned)(srow * KP + sch * 16), vdst = (unsigned)(KBUF + srow * VP + sch * 16);
    v4u kA, vA, kB, vB;
#define ATT_LOAD(KR, VR, t) do { const size_t r_ = (size_t)(u.krow0 + (64 * (t) + srow) * u.kstride) * u.kvpitch + sch * 8; KR = *(const GAS v4u*)(u.K + r_); VR = *(const GAS v4u*)(u.V + r_); } while (0)
#define ATT_WRITE(KR, VR, b) do { *(LAS v4u*)(lds + (b) * BUF + kdst) = KR; *(LAS v4u*)(lds + (b) * BUF + vdst) = VR; } while (0)
    ATT_LOAD(kA, vA, u.t_lo);
    if (u.t_lo + 1 < u.t_hi) ATT_LOAD(kB, vB, u.t_lo + 1);
    const int qi = u.qidx0 + 32 * wid + ql;
    const size_t qrow = (size_t)(u.qrow0 + (32 * wid + ql) * u.qstride);
    bf16x8 qf[4];
#pragma unroll
    for (int ks = 0; ks < 4; ++ks) qf[ks] = wactive ? *(const bf16x8*)(u.Q + qrow * 1024 + 16 * ks + 8 * hi) : (bf16x8){0, 0, 0, 0, 0, 0, 0, 0};
    unsigned sel = 0xffu;
    if (KIND == 0) {
        float gsc[7];
#pragma unroll
        for (int n = 0; n < 7; ++n) { gsc[n] = -INFINITY;
            if (n < u.qb) { const float* kp = u.ksum + n * 384 + 8 * hi; float s = 0.f;
#pragma unroll
                for (int ks = 0; ks < 4; ++ks) { const f32x4 k0 = *(const f32x4*)(kp + 16 * ks), k1 = *(const f32x4*)(kp + 16 * ks + 4);
#pragma unroll
                    for (int j = 0; j < 4; ++j) { s += bf2f((bf16)qf[ks][j]) * k0[j]; s += bf2f((bf16)qf[ks][4 + j]) * k1[j]; } }
                s = xsum(s); gsc[n] = s; } }
        sel = 0u;
#pragma unroll
        for (int r = 0; r < 3; ++r) { int best = -1; float bv = -INFINITY;
#pragma unroll
            for (int n = 0; n < 7; ++n) if (n < u.qb && !((sel >> n) & 1u) && gsc[n] > bv) { bv = gsc[n]; best = n; }
            if (best >= 0) sel |= 1u << best; }
    }
    float m = -INFINITY; f32x16 o0 = {}, o1 = {}, o2 = {};
    ATT_WRITE(kA, vA, 0); if (u.t_lo + 1 < u.t_hi) ATT_WRITE(kB, vB, 1);
    __syncthreads();
    const unsigned koff = (unsigned)(ql * KP + 16 * hi);
    const unsigned voff = (unsigned)(KBUF + (4 * hi + ((lane & 15) >> 2)) * VP + ((lane >> 4) & 1) * 32 + (lane & 3) * 8);
#define ATT_NEED(t) (wactive && !(KIND == 0 && ((t) >> 2) == u.qb && 64 * (t) > u.qidx0 + 32 * wid + 31) && !(KIND == 2 && (64 * (t) > u.qidx0 + 32 * wid + 31 || 64 * (t) + 63 < u.qidx0 + 32 * wid - 128)))
    for (int t = u.t_lo; t < u.t_hi; t += 2) {
        const bool more = (t + 2 < u.t_hi), more2 = (t + 3 < u.t_hi);
        if (more) ATT_LOAD(kA, vA, t + 2);
        if (more2) ATT_LOAD(kB, vB, t + 3);
        if (ATT_NEED(t)) att_tile<KIND>(lds, u, t, wid, qi, hi, koff, voff, sel, qf, m, o0, o1, o2);
        if (t + 1 < u.t_hi) { if (ATT_NEED(t + 1)) att_tile<KIND>(lds + BUF, u, t + 1, wid, qi, hi, koff, voff, sel, qf, m, o0, o1, o2); }
        __syncthreads();
        if (more) { ATT_WRITE(kA, vA, 0); if (more2) ATT_WRITE(kB, vB, 1); __syncthreads(); }
    }
    if (wactive) {
        const float lt = o2[0]; const float inv = 1.0f / lt;
        bf16* orow = u.O + qrow * 1024;
#pragma unroll
        for (int g = 0; g < 4; ++g) {
            unsigned long long w0 = (unsigned long long)pg8::cvt_pk_bf16(o0[4 * g] * inv, o0[4 * g + 1] * inv) | ((unsigned long long)pg8::cvt_pk_bf16(o0[4 * g + 2] * inv, o0[4 * g + 3] * inv) << 32);
            unsigned long long w1 = (unsigned long long)pg8::cvt_pk_bf16(o1[4 * g] * inv, o1[4 * g + 1] * inv) | ((unsigned long long)pg8::cvt_pk_bf16(o1[4 * g + 2] * inv, o1[4 * g + 3] * inv) << 32);
            *(unsigned long long*)(orow + 8 * g + 4 * hi) = w0; *(unsigned long long*)(orow + 32 + 8 * g + 4 * hi) = w1;
        }
        if (KIND == 2) { if (hi == 0) u.lse[(size_t)(32 * wid + ql) * u.lse_stride] = m + __builtin_log2f(lt); }
    }
#undef ATT_LOAD
#undef ATT_WRITE
#undef ATT_NEED
}

constexpr int N_UNITS = 1152;
__device__ __forceinline__ void make_unit(int idx, Unit& u, bf16* ZQ, const bf16* ZKV, const bf16* MKV, const float* KSUM, float* LSE) {
    u.qstride = 1; u.nq = 256; u.kstride = 1; u.qb = 0; u.ksum = nullptr; u.lse = nullptr; u.lse_stride = 0; u.qidx0 = 0;
    int mb = -1, mqb = 0;
    if (idx < 288) { mqb = 7 - idx / 48; mb = idx % 48; }
    else if (idx < 336) { mqb = 1; mb = idx - 288; }
    else if (idx >= 592 && idx < 640) { mqb = 0; mb = idx - 592; }
    if (mb >= 0) {
        const int b = mb / 6, h = mb % 6;
        u.kind = 0; u.Q = ZQ + 384 + h * 64; u.O = ZQ + 384 + h * 64; u.qrow0 = b * SEQ + 256 * mqb;
        u.K = ZKV + 768 + h * 64; u.V = ZKV + 1152 + h * 64; u.kvpitch = 1536; u.krow0 = b * SEQ;
        u.t_lo = 0; u.t_hi = 4 * (mqb + 1); u.qidx0 = 256 * mqb; u.qb = mqb; u.ksum = KSUM + (size_t)(b * 8) * 384 + h * 64;
        return;
    }
    if (idx >= 640 && idx < 896) {
        const int i = idx - 640, bh = i >> 3, blk = i & 7, b = bh >> 2, h = bh & 3;
        u.kind = 1; u.Q = ZQ + 768 + h * 64; u.O = ZQ + 768 + h * 64; u.qrow0 = b * SEQ + 256 * blk;
        u.K = MKV + h * 64; u.V = MKV + 256 + h * 64; u.kvpitch = 512; u.krow0 = b * 256; u.t_lo = 0; u.t_hi = 4;
        return;
    }
    u.kind = 2; u.kvpitch = 1536; u.lse_stride = 6;
    int g, b, h, r, m0, nq;
    if (idx < 464) { const int i = idx - 336; g = 0; b = i >> 4; h = (i >> 3) & 1; r = 0; m0 = 256 * (i & 7); nq = 256; }
    else if (idx < 592) { const int i = idx - 464; g = 1; b = i >> 4; h = (i >> 3) & 1; r = (i >> 1) & 3; m0 = 256 * (i & 1); nq = 256; }
    else { const int i = idx - 896; g = 2; b = i >> 5; h = (i >> 4) & 1; r = i & 15; m0 = 0; nq = 128; }
    const int dil = (g == 0) ? 1 : (g == 1) ? 4 : 16, hc = (2 * g + h) * 64;
    u.Q = ZQ + hc; u.O = ZQ + hc; u.qstride = dil; u.nq = nq; u.qrow0 = b * SEQ + m0 * dil + r;
    u.K = ZKV + hc; u.V = ZKV + 384 + hc; u.krow0 = b * SEQ + r; u.kstride = dil;
    u.t_lo = (m0 >= 128) ? (m0 - 128) / 64 : 0; u.t_hi = (m0 + nq) / 64; u.qidx0 = m0;
    u.lse = LSE + (size_t)u.qrow0 * 6 + (2 * g + h); u.lse_stride = 6 * dil;
}
}
struct Args { const float* in[14]; float* out; unsigned char* ws; int ph_lo, ph_hi, li, pad; };
constexpr int I_INQ = 16 * 80, I_ING = 16 * 96, I_PA = 2 * 32, I_PB = 6 * 32, I_PM = 4 * 32, I_O = 16 * 32, I_MKV = 16 * 16, I_UP = 16 * 128, I_DN = 64 * 32;
constexpr int I_LAYER = I_INQ + I_MKV + I_ING + I_PA + I_PB + I_PM + I_O + I_UP + I_DN, I_EARLY = I_INQ + I_MKV;
__device__ __forceinline__ TrD tr_desc(const float* const* in, unsigned char* ws, int it) {
    const int l = it / I_LAYER; int r = it % I_LAYER;
    unsigned char* wl = ws + WS_W + (size_t)l * W_LAYER; TrD d;
    if (r < I_INQ) { const int kb = r / 80, nb = r % 80; d = TrD{in[3] + (size_t)l * D * DIN, in[2] + l * D, (bf16*)(wl + W_IN), DIN, 1024, 64 * kb, 32 * nb, win_dest_row(32 * nb), 0}; return d; } r -= I_INQ;
    if (r < I_MKV) { const int kb = r / 16, nb = r % 16; d = TrD{in[9] + (size_t)l * D * 512, in[8] + l * D, (bf16*)(wl + W_MKV), 512, 1024, 64 * kb, 32 * nb, 32 * nb, 0}; return d; } r -= I_MKV;
    if (r < I_ING) { const int kb = r / 96, nb = 80 + r % 96; d = TrD{in[3] + (size_t)l * D * DIN, in[2] + l * D, (bf16*)(wl + W_IN), DIN, 1024, 64 * kb, 32 * nb, win_dest_row(32 * nb), 0}; return d; } r -= I_ING;
    if (r < I_PA) { const int kb = r / 32, nb = r % 32; d = TrD{in[4] + (size_t)l * 128 * D, nullptr, (bf16*)(wl + W_P), D, 1024, 64 * kb, 32 * nb, 32 * nb, 0}; return d; } r -= I_PA;
    if (r < I_PB) { const int kb = r / 32, nb = r % 32; d = TrD{in[5] + (size_t)l * 384 * D, nullptr, (bf16*)(wl + W_P), D, 1024, 64 * kb, 32 * nb, 32 * nb, 384}; return d; } r -= I_PB;
    if (r < I_PM) { const int kb = r / 32, nb = r % 32; d = TrD{in[6] + (size_t)l * 256 * D, nullptr, (bf16*)(wl + W_P), D, 1024, 64 * kb, 32 * nb, 32 * nb, 768}; return d; } r -= I_PM;
    if (r < I_O) { const int kb = r / 32, nb = r % 32; d = TrD{in[7] + (size_t)l * D * D, nullptr, (bf16*)(wl + W_O), D, 1024, 64 * kb, 32 * nb, 32 * nb, 0}; return d; } r -= I_O;
    if (r < I_UP) { const int kb = r / 128, nb = r % 128; d = TrD{in[11] + (size_t)l * D * FF, in[10] + l * D, (bf16*)(wl + W_UP), FF, 1024, 64 * kb, 32 * nb, 32 * nb, 0}; return d; } r -= I_UP;
    { const int kb = r / 32, nb = r % 32; d = TrD{in[12] + (size_t)l * FF * D, nullptr, (bf16*)(wl + W_DN), D, 4096, 64 * kb, 32 * nb, 32 * nb, 0}; return d; }
}

namespace pg8 {
struct EpiFinal {
    static constexpr bool PERM = true, AFTER_DRAIN = true, PRELOAD = true;
    __device__ static bool stores16(const Unit&) { return true; }
    const bf16_t* xb; float* ssq; float* out; const float* gain; const XcdBarrier* bar;
    __device__ __forceinline__ void preload(u32x4 (&pre)[2][4][2], const Unit& u, int wr, int wc, int fr, int fq) const {
        const unsigned o0 = (unsigned)(u.pm * BM + wr * 64 + fr) * 1024u + (unsigned)(u.pn * BM + wc * 32 + 8 * fq);
#pragma unroll
        for (int ai = 0; ai < 2; ++ai)
#pragma unroll
            for (int m = 0; m < 4; ++m)
#pragma unroll
                for (int bj = 0; bj < 2; ++bj) pre[ai][m][bj] = *(const u32x4*)(xb + (o0 + (unsigned)((ai * HALF + m * 16) * 1024 + bj * HALF)));
    }
    __device__ __forceinline__ void fused(f32x4 (&acc)[2][2][4][2], const Unit& u, int wr, int wc, int, int, PG8_LAS unsigned char* lds, int, int) const {
        int te_ = threadIdx.x; asm volatile("" : "+v"(te_) :: "memory"); const int fr = te_ & 15, fq = (te_ & 63) >> 4;
        PG8_LAS float* P = (PG8_LAS float*)lds;
        const int row0 = u.pm * BM + wr * 64 + fr, col0 = u.pn * BM + wc * 32 + 8 * fq;
        const unsigned o0 = (unsigned)row0 * 1024u + (unsigned)col0;
#pragma unroll
        for (int ai = 0; ai < 2; ++ai) {
#pragma unroll
            for (int m = 0; m < 4; ++m) { float sq = 0.f;
#pragma unroll
                for (int bj = 0; bj < 2; ++bj) {
                    const f32x4 x0 = acc[ai][bj][m][0], x1 = acc[ai][bj][m][1];
                    sq += (x0[0] * x0[0] + x0[1] * x0[1]) + (x0[2] * x0[2] + x0[3] * x0[3]) + (x1[0] * x1[0] + x1[1] * x1[1]) + (x1[2] * x1[2] + x1[3] * x1[3]); }
                sq = xsum16(sq); sq = xsum32(sq);
                if (fq == 0) P[(ai * HALF + wr * 64 + m * 16 + fr) * 4 + wc] = sq; }
        }
        asm volatile("s_waitcnt lgkmcnt(0)" ::: "memory"); __builtin_amdgcn_s_barrier(); asm volatile("" ::: "memory");
        if (te_ < 256) { const f32x4 p = *(PG8_LAS const f32x4*)(P + te_ * 4); ssq[(unsigned)(u.pm * BM + te_) * 4u + (unsigned)u.pn] = (p[0] + p[1]) + (p[2] + p[3]); }
        xcd_barrier(*bar);
        float rs[8]; rstd8(ssq, row0, fq, rs);
#pragma unroll
        for (int bj = 0; bj < 2; ++bj) { const f32x4 g0 = *(const f32x4*)(gain + col0 + bj * HALF), g1 = *(const f32x4*)(gain + col0 + bj * HALF + 4);
#pragma unroll
            for (int ai = 0; ai < 2; ++ai)
#pragma unroll
                for (int m = 0; m < 4; ++m) { const float r = rs[ai * 4 + m]; float* op = out + (o0 + (unsigned)((ai * HALF + m * 16) * 1024 + bj * HALF));
                    *(f32x4*)op = acc[ai][bj][m][0] * r * g0; *(f32x4*)(op + 4) = acc[ai][bj][m][1] * r * g1; } }
    }
};
}
constexpr int N_PHASES = 16;
#ifndef MK_ONE_LAUNCH
#define MK_ONE_LAUNCH 1
#endif
__global__ void __launch_bounds__(NWAVES * 64, 2) mega(Args args) {
    extern __shared__ __attribute__((aligned(16))) unsigned char lds_raw[];
    LAS unsigned char* lds = (LAS unsigned char*)lds_raw;
    volatile LAS unsigned* MISC = (volatile LAS unsigned*)(lds + MISC_OFF);
    const int tid = threadIdx.x, lane = tid & 63, wave = __builtin_amdgcn_readfirstlane(tid >> 6);
    const int G = gridDim.x; const int bx = blockIdx.x; const int vcu = (G % 8 == 0) ? (bx % 8) * (G / 8) + bx / 8 : bx;
    unsigned char* ws = args.ws;
    gu32* ctl = (gu32*)(ws + WS_CTL);
    for (int u = tid; u < (LDS_BYTES - LDSCTL_OFF) / 4; u += NWAVES * 64) ((LAS unsigned*)(lds + LDSCTL_OFF))[u] = 0u;
    __syncthreads();
    XcdBarrier bar; bar.bar = (unsigned*)(ctl + CW_BAR); bar.x = 0; bar.st = nullptr;
    if (MK_ONE_LAUNCH) bar = xcd_barrier_post((unsigned*)(ctl + CW_BAR), MISC + 8);
    const int lo = args.ph_lo, hi = args.ph_hi;
#define IN(k) (lo <= (k) && (k) < hi)
#ifndef MK_PROBE
#define MK_PROBE 0
#endif
#if MK_PROBE
    unsigned long long* const TS = (unsigned long long*)(ws + 512 * 1024);
#define STAMP(k) do { if (blockIdx.x == 0) { __hip_atomic_store(TS + (k), rt(), __ATOMIC_RELAXED, __HIP_MEMORY_SCOPE_AGENT); } } while (0)
#else
#define STAMP(k) do { } while (0)
#endif
#define SEAM(k) do { if (IN(k) && IN((k) + 1)) xcd_barrier(bar); STAMP((k) + 1); } while (0)
    STAMP(0);
    const float* x_in = args.in[0]; const float* mem = args.in[1];
    float* out = args.out;
    float* ROPE = (float*)(ws + WS_ROPE); float* SSQ = (float*)(ws + WS_SSQ); float* LSE = (float*)(ws + WS_LSE);
    bf16* MKV = (bf16*)(ws + WS_MKV); bf16* MEMN = (bf16*)(ws + WS_MEMN); bf16* XB = (bf16*)(ws + WS_XB);
    bf16* ZQ = (bf16*)(ws + WS_ZQ); bf16* ZKV = (bf16*)(ws + WS_ZKV); bf16* ZG = (bf16*)(ws + WS_ZG); bf16* U = (bf16*)(ws + WS_U);
    const int gw = vcu * NWAVES + wave, NGW = G * NWAVES;

    if (IN(0)) {
        LAS float* scr = (LAS float*)(lds + RING_OFF + wave * 16384);
        const float* const* intab = (const float* const*)(ws + WS_PTRS);
        if (tid == 0) { const float** tb = (const float**)(ws + WS_PTRS);
            tb[0] = args.in[0]; tb[1] = args.in[1]; tb[2] = args.in[2]; tb[3] = args.in[3]; tb[4] = args.in[4]; tb[5] = args.in[5]; tb[6] = args.in[6];
            tb[7] = args.in[7]; tb[8] = args.in[8]; tb[9] = args.in[9]; tb[10] = args.in[10]; tb[11] = args.in[11]; tb[12] = args.in[12]; tb[13] = args.in[13]; }
        asm volatile("s_waitcnt vmcnt(0)" ::: "memory"); __syncthreads();
        for (int it = gw; it < I_EARLY; it += 2 * NGW) {
            const bool two = (it + NGW) < I_EARLY;
            const TrD d0 = tr_desc(intab, ws, it), d1 = tr_desc(intab, ws, two ? it + NGW : it);
            f32x4 v0[8], v1[8]; float g0[8], g1[8];
            tr_load(d0, v0, g0, lane); if (two) tr_load(d1, v1, g1, lane);
            tr_fin(d0, v0, g0, scr, lane); if (two) tr_fin(d1, v1, g1, scr, lane);
        }
        for (int it = gw; it < 2 * 1024; it += NGW) { const int l = it >> 10, n = it & 1023; bf16* p = (bf16*)(ws + WS_W + (size_t)l * W_LAYER + W_P) + (size_t)n * 1024 + 128;
            if (lane < 32) ((GAS v4u*)p)[lane] = (v4u){0u, 0u, 0u, 0u}; }
        for (int e = bx * (NWAVES * 64) + tid; e < SEQ * 8; e += G * NWAVES * 64) { const int pos = e >> 3, i = e & 7;
            const float invf = (float)(1.0 / pow(500000.0, (double)i / 8.0)); const float ang = (float)pos * invf;
            const double rev = (double)ang * 0.15915494309189535; const float fr_ = (float)(rev - floor(rev));
            const _Float16 ch = (_Float16)__builtin_amdgcn_cosf(fr_), sh = (_Float16)__builtin_amdgcn_sinf(fr_);
            ((unsigned*)ROPE)[pos * 8 + i] = (unsigned)__builtin_bit_cast(unsigned short, ch) | ((unsigned)__builtin_bit_cast(unsigned short, sh) << 16); }
        for (int m = gw; m < T; m += 2 * NGW) { const int m1 = m + NGW;
            const GAS f32x4* xr = (const GAS f32x4*)(x_in + (size_t)m * D) + lane; const GAS f32x4* xr1 = (const GAS f32x4*)(x_in + (size_t)m1 * D) + lane; f32x4 v[4], w[4]; float s = 0.f, s1 = 0.f;
#pragma unroll
            for (int j = 0; j < 4; ++j) { v[j] = xr[64 * j]; w[j] = xr1[64 * j]; }
#pragma unroll
            for (int j = 0; j < 4; ++j) { s += (v[j].x * v[j].x + v[j].y * v[j].y) + (v[j].z * v[j].z + v[j].w * v[j].w); s1 += (w[j].x * w[j].x + w[j].y * w[j].y) + (w[j].z * w[j].z + w[j].w * w[j].w); }
            s = wave_sum(s); s1 = wave_sum(s1);
            GAS unsigned long long* o8 = (GAS unsigned long long*)(XB + (size_t)m * D) + lane; GAS unsigned long long* o81 = (GAS unsigned long long*)(XB + (size_t)m1 * D) + lane;
#pragma unroll
            for (int j = 0; j < 4; ++j) { o8[64 * j] = (unsigned long long)pk2(v[j].x, v[j].y) | ((unsigned long long)pk2(v[j].z, v[j].w) << 32); o81[64 * j] = (unsigned long long)pk2(w[j].x, w[j].y) | ((unsigned long long)pk2(w[j].z, w[j].w) << 32); }
            if (lane < 4) { SSQ[(size_t)m * 4 + lane] = (lane == 0) ? s : 0.f; SSQ[(size_t)m1 * 4 + lane] = (lane == 0) ? s1 : 0.f; } }
        for (int m = gw; m < NMEMROWS; m += NGW) { const GAS f32x4* xr = (const GAS f32x4*)(mem + (size_t)m * D) + lane; f32x4 v[4]; float s = 0.f;
#pragma unroll
            for (int j = 0; j < 4; ++j) { v[j] = xr[64 * j]; s += (v[j].x * v[j].x + v[j].y * v[j].y) + (v[j].z * v[j].z + v[j].w * v[j].w); }
            const float rstd = 1.0f / sqrtf(wave_sum(s) * (1.0f / 1024.0f) + 1e-6f);
            GAS unsigned long long* o8 = (GAS unsigned long long*)(MEMN + (size_t)m * D) + lane;
#pragma unroll
            for (int j = 0; j < 4; ++j) o8[64 * j] = (unsigned long long)pk2(v[j].x * rstd, v[j].y * rstd) | ((unsigned long long)pk2(v[j].z * rstd, v[j].w * rstd) << 32); }
    }
    SEAM(0);

    for (int l = 0; l < 2; ++l) {
        const int pb = 1 + 7 * l;
        unsigned char* wl = ws + WS_W + (size_t)l * W_LAYER;
        const bf16* WIN_t = (const bf16*)(wl + W_IN); const bf16* WUP_t = (const bf16*)(wl + W_UP); const bf16* WDN_t = (const bf16*)(wl + W_DN);
        const bf16* WO_t = (const bf16*)(wl + W_O); const bf16* WP_t = (const bf16*)(wl + W_P); const bf16* WMKV_t = (const bf16*)(wl + W_MKV);
        float* KSUM = (float*)(ws + WS_KSUM) + (size_t)l * 64 * 6 * 64;
        if (IN(pb + 0)) {
            { pg8::Gemm g{XB, WIN_t, 1024, 1024, 1024, nullptr, nullptr}; pg8::StaticOrder S; S.init(T, NQKV, G, bx);
              pg8::EpiQKV E{ZQ, ZKV, SSQ, (const unsigned*)ROPE, KSUM};
              pg8::gemm_phase<pg8::EpiQKV, pg8::StaticOrder, true, true>(lds + RING_OFF, g, S, E); }
            { pg8::Gemm g{MEMN, WMKV_t, 1024, 1024, 1024, nullptr, nullptr}; pg8::StaticOrder S; S.init(NMEMROWS, 512, G, (bx + 128) % G);
              pg8::EpiPlain E{MKV, 512};
              pg8::gemm_phase<pg8::EpiPlain, pg8::StaticOrder, true, true>(lds + RING_OFF, g, S, E); }
        }
        const int conv0 = (G > 160) ? 144 : 0;
        if (IN(pb + 0) && bx >= conv0) {
            LAS float* scr = (LAS float*)(lds + RING_OFF + wave * 16384);
            int tl_ = threadIdx.x; asm volatile("" : "+v"(tl_)); const int ln = tl_ & 63;
            const int rank = (bx - conv0) * NWAVES + wave, nrank = (G - conv0) * NWAVES; const float* const* intab2 = (const float* const*)(ws + WS_PTRS);
            const int it_lo = (l == 0) ? I_EARLY : I_LAYER + I_EARLY, it_hi = (l == 0) ? I_LAYER + I_EARLY : 2 * I_LAYER;
            for (int it = it_lo + rank; it < it_hi; it += 2 * nrank) {
                const bool two = (it + nrank) < it_hi;
                const TrD d0 = tr_desc(intab2, ws, it), d1 = tr_desc(intab2, ws, two ? it + nrank : it);
                f32x4 v0[8], v1[8]; float g0[8], g1[8];
                tr_load(d0, v0, g0, ln); tr_load(d1, v1, g1, ln);
                tr_fin(d0, v0, g0, scr, ln); if (two) tr_fin(d1, v1, g1, scr, ln);
            }
        }
        SEAM(pb + 0);
        if (IN(pb + 1)) {
            unsigned* qcnt = (unsigned*)(ctl + CW_QUEUE + 64 * l);
            for (;;) {
                if (threadIdx.x == 0) MISC[16] = __hip_atomic_fetch_add(qcnt, 1u, __ATOMIC_RELAXED, __HIP_MEMORY_SCOPE_AGENT);
                __syncthreads();
                const int idx = (int)MISC[16];
                if (idx >= att::N_UNITS) break;
                att::Unit au; att::make_unit(idx, au, ZQ, ZKV, MKV, KSUM, LSE);
                if (au.kind == 0) att::run_unit<0>(lds + RING_OFF, au); else if (au.kind == 1) att::run_unit<1>(lds + RING_OFF, au); else att::run_unit<2>(lds + RING_OFF, au);
            }
        }
        SEAM(pb + 1);
        if (IN(pb + 2)) {
            { int tl_ = threadIdx.x; asm volatile("" : "+v"(tl_)); const int ln = tl_ & 63, h = ln >> 5, c = 2 * (ln & 31);
              for (int row = gw; row < T; row += NGW) {
                const float l0 = LSE[(size_t)row * 6 + h], l1 = LSE[(size_t)row * 6 + 2 + h], l2 = LSE[(size_t)row * 6 + 4 + h];
                bf16* zr = ZQ + (size_t)row * 1024;
                const unsigned a0 = *(const GAS unsigned*)(zr + h * 64 + c), a1 = *(const GAS unsigned*)(zr + (2 + h) * 64 + c), a2 = *(const GAS unsigned*)(zr + (4 + h) * 64 + c);
                const float mx = fmaxf(l0, fmaxf(l1, l2));
                float w0 = __builtin_amdgcn_exp2f(l0 - mx), w1 = __builtin_amdgcn_exp2f(l1 - mx), w2 = __builtin_amdgcn_exp2f(l2 - mx);
                const float inv = 1.0f / (w0 + w1 + w2); w0 *= inv; w1 *= inv; w2 *= inv;
                const float lo = w0 * __uint_as_float(a0 << 16) + w1 * __uint_as_float(a1 << 16) + w2 * __uint_as_float(a2 << 16);
                const float hi_ = w0 * __uint_as_float(a0 & 0xffff0000u) + w1 * __uint_as_float(a1 & 0xffff0000u) + w2 * __uint_as_float(a2 & 0xffff0000u);
                const unsigned res = pk2(lo, hi_);
                asm volatile("s_waitcnt vmcnt(0)" ::: "memory");
                *(GAS unsigned*)(zr + h * 64 + c) = res; *(GAS unsigned*)(zr + 128 + 2 * ln) = 0u;
              } }
        }
        SEAM(pb + 2);
        if (IN(pb + 3)) {
            pg8::GateProjOrder S; S.init(T, D, G, bx);
            pg8::Gemm g{XB, WIN_t + (size_t)NQKV * 1024, 1024, 1024, 1024, ZQ, WP_t}; pg8::EpiGateProj E{ZG, SSQ};
            pg8::gemm_phase<pg8::EpiGateProj, pg8::GateProjOrder, true, true>(lds + RING_OFF, g, S, E);
        }
        SEAM(pb + 3);
        if (IN(pb + 4)) {
            pg8::Gemm g{ZG, WO_t, 3072, 1024, 1024, nullptr, nullptr}; pg8::StaticOrder S; S.init(T, D, G, bx);
            pg8::EpiRes E{XB, SSQ};
            pg8::gemm_phase<pg8::EpiRes, pg8::StaticOrder, false, true>(lds + RING_OFF, g, S, E);
        }
        SEAM(pb + 4);
        if (IN(pb + 5)) {
            pg8::Gemm g{XB, WUP_t, 1024, 1024, 1024, nullptr, nullptr}; pg8::StaticOrder S; S.init(T, FF, G, bx);
            pg8::EpiUp E{U, SSQ};
            pg8::gemm_phase<pg8::EpiUp, pg8::StaticOrder, true, true>(lds + RING_OFF, g, S, E);
        }
        SEAM(pb + 5);
        if (IN(pb + 6)) {
            pg8::Gemm g{U, WDN_t, 4096, 4096, 4096, nullptr, nullptr}; pg8::StaticOrder S; S.init(T, D, G, bx);
            if (l == 0) { pg8::EpiRes E{XB, SSQ}; pg8::gemm_phase<pg8::EpiRes, pg8::StaticOrder, false, true>(lds + RING_OFF, g, S, E); }
            else { pg8::EpiFinal E{XB, SSQ, out, args.in[13], &bar}; pg8::gemm_phase<pg8::EpiFinal, pg8::StaticOrder, false, true>(lds + RING_OFF, g, S, E); }
        }
#if MK_PROBE
        SEAM(pb + 6);
#else
        if (l == 0) SEAM(pb + 6);
#endif
    }
#if MK_PROBE
    if (IN(15)) {
        int tl_ = threadIdx.x; asm volatile("" : "+v"(tl_)); const int lane = tl_ & 63;
        const float pbv = (float)(__hip_atomic_load(TS + PROBE_B_HI, __ATOMIC_RELAXED, __HIP_MEMORY_SCOPE_AGENT) - __hip_atomic_load(TS + PROBE_B_LO, __ATOMIC_RELAXED, __HIP_MEMORY_SCOPE_AGENT)) * (PROBE_SCALE * 0.1f);
        for (int m = gw; m < T; m += NGW) { GAS f32x4* xr = (GAS f32x4*)(out + (size_t)m * D) + lane;
#pragma unroll
            for (int j = 0; j < 4; ++j) { f32x4 v = xr[64 * j]; v = v + pbv; xr[64 * j] = v; } }
        if (blockIdx.x == 0) { asm volatile("s_waitcnt vmcnt(0)" ::: "memory"); __syncthreads();
            const float pa = (float)(__hip_atomic_load(TS + PROBE_A_HI, __ATOMIC_RELAXED, __HIP_MEMORY_SCOPE_AGENT) - __hip_atomic_load(TS + PROBE_A_LO, __ATOMIC_RELAXED, __HIP_MEMORY_SCOPE_AGENT)) * PROBE_SCALE;
            if (threadIdx.x == 0) out[0] += pa; }
    }
#endif
#undef IN
#undef SEAM
}

extern "C" void kernel_launch(void* const* d_in, const int* in_sizes, int n_in, void* d_out, int out_size, void* d_ws, size_t ws_size, hipStream_t stream) {
    static int grid = 0;
    if (grid == 0) {
        if (n_in != 14 || in_sizes[0] != T * D || out_size != T * D || ws_size < WS_END) { fprintf(stderr, "kernel_launch: unexpected shapes (n_in %d, in0 %d, out %d, ws %zu)\n", n_in, n_in > 0 ? in_sizes[0] : -1, out_size, ws_size); grid = -1; return; }
        int dev = 0, cus = 0;
        if (hipGetDevice(&dev) != hipSuccess || hipDeviceGetAttribute(&cus, hipDeviceAttributeMultiprocessorCount, dev) != hipSuccess) { grid = -1; return; }
        if (hipFuncSetAttribute((const void*)mega, hipFuncAttributeMaxDynamicSharedMemorySize, LDS_BYTES) != hipSuccess) { fprintf(stderr, "kernel_launch: hipFuncSetAttribute failed\n"); grid = -1; return; }
        int per_cu = 0;
        (void)hipOccupancyMaxActiveBlocksPerMultiprocessor(&per_cu, (const void*)mega, NWAVES * 64, LDS_BYTES);
        (void)hipGetLastError();
        grid = cus;
    }
    if (grid < 0) return;
    (void)hipMemsetAsync((char*)d_ws + WS_CTL, 0, CTL_ZERO_BYTES, stream);
    Args a{};
    for (int i = 0; i < 14; ++i) a.in[i] = (const float*)d_in[i];
    a.out = (float*)d_out; a.ws = (unsigned char*)d_ws; a.li = 0; a.pad = 0;
#if MK_ONE_LAUNCH
    a.ph_lo = 0; a.ph_hi = N_PHASES;
    hipLaunchKernelGGL(mega, dim3(grid), dim3(NWAVES * 64), LDS_BYTES, stream, a);
#else
    for (int ph = 0; ph < N_PHASES; ++ph) {
        a.ph_lo = ph; a.ph_hi = ph + 1;
        hipLaunchKernelGGL(mega, dim3(grid), dim3(NWAVES * 64), LDS_BYTES, stream, a);
    }
#endif
}
```

```cpp
#include <hip/hip_runtime.h>
#include <cstdio>
#include <cstdint>
namespace pg8 {
#define PG8_LAS __attribute__((address_space(3)))
typedef unsigned short bf16_t;
typedef short bf16x8 __attribute__((ext_vector_type(8)));
typedef float f32x4 __attribute__((ext_vector_type(4)));
typedef unsigned u32x4 __attribute__((ext_vector_type(4)));
constexpr int BM = 256, BK = 64, HALF = 128, HTB = HALF * BK * 2  , STAGE_BYTES = 8 * HTB, NXCD = 8, WGM = 4;

__host__ __device__ __forceinline__ int lds_byte(int r, int c) { const int st = (r >> 4) * 2 + (c >> 5), rr = r & 15, cc = c & 31, ob = rr * 64 + cc * 2; return st * 1024 + (ob ^ (((ob >> 9) & 1) << 5)); }
__host__ __device__ __forceinline__ void stage_rc(int b, int& R, int& C) { const int st = b / 1024, sb = b % 1024, swz = sb ^ (((sb >> 9) & 1) << 5); R = (st >> 1) * 16 + swz / 64; C = (st & 1) * 32 + (swz % 64) / 2; }
__host__ __device__ __forceinline__ int perm32(int rho) { const int n = rho >> 4, i = rho & 15; return 8 * (i >> 2) + 4 * n + (i & 3); }

struct Unit { int pm, pn, k0, nt, br, pb, sel; };
struct Gemm { const bf16_t* A; const bf16_t* Bt; int lda, ldb, K; const bf16_t* A2; const bf16_t* Bt2; };

struct StaticOrder {
    static constexpr bool KSEG = false;
    __host__ __device__ static bool carry(const Unit&) { return false; }
    int nM, nN, nwg, G, c;
    __host__ __device__ void init(int M, int N, int G_, int c_) { nM = M / BM; nN = N / BM; nwg = nM * nN; G = G_; c = c_; }
    __host__ __device__ bool next(int i, Unit& u) const {
        const long L = (long)i * G + c; if (L >= nwg) return false;
        int wgid = (int)L; { const int q = nwg / NXCD, r = nwg % NXCD, xcd = wgid % NXCD, off = wgid / NXCD; wgid = (xcd < r ? xcd * (q + 1) : r * (q + 1) + (xcd - r) * q) + off; }
        const int nig = WGM * nN, gid = wgid / nig, fm = gid * WGM, gsz = (nM - fm) < WGM ? (nM - fm) : WGM;
        u.pm = fm + ((wgid % nig) % gsz); u.pn = (wgid % nig) / gsz; u.k0 = 0; u.nt = 0; u.br = 0; u.pb = u.pn; u.sel = 0; return true;
    }
    __device__ __forceinline__ void a_ready(const Unit&) const {}
    __device__ __forceinline__ void done(const Unit&) const {}
};

typedef float f32x2c_t __attribute__((ext_vector_type(2))); typedef __bf16 bf16x2c_t __attribute__((ext_vector_type(2)));
__device__ __forceinline__ unsigned cvt_pk_bf16(float lo, float hi) { const f32x2c_t v = {lo, hi}; const bf16x2c_t b = __builtin_convertvector(v, bf16x2c_t); return __builtin_bit_cast(unsigned, b); }
typedef float f32x2 __attribute__((ext_vector_type(2)));
template <class Epi, class Sched, bool ALIGN_EPI = false, bool SP2 = false>
__device__ __forceinline__ void gemm_phase(PG8_LAS unsigned char* lds, const Gemm g, const Sched& S, const Epi& E) {
    int tid_ = threadIdx.x; asm volatile("" : "+v"(tid_));
    const int tid = tid_, wid = __builtin_amdgcn_readfirstlane(tid >> 6), lane = tid & 63, wr = wid >> 2, wc = wid & 3, fr = lane & 15, fq = lane >> 4;
    const int K = g.K; int nt = K / BK;
    unsigned voffA[2], voffB[2];
#pragma unroll
    for (int i = 0; i < 2; ++i) { int R, C; stage_rc(tid * 16 + i * 8192, R, C); const int Rb = Epi::PERM ? ((R & ~31) + perm32(R & 31)) : R;
        voffA[i] = (unsigned)(R * g.lda + C) * 2u; voffB[i] = (unsigned)(Rb * g.ldb + C) * 2u; }
    const size_t kstep = (size_t)(BK * 2);
    const size_t hstepA = (size_t)HALF * g.lda * 2, hstepB = (size_t)HALF * g.ldb * 2;
    const size_t tstepA = 2 * hstepA, tstepB = 2 * hstepB;
    const unsigned ldsw = (unsigned)wid * 1024u;
    const int aoff = lds_byte(wr * 64 + fr, fq * 8), boff = lds_byte(wc * 32 + fr, fq * 8);
#define PG8_SA(b, h) (((b) * 2 + (h)) * HTB)
#define PG8_SB(b, h) ((4 + (b) * 2 + (h)) * HTB)
#define PG8_STAGE(bufoff, gbase, voff) do { _Pragma("unroll") for (int _i = 0; _i < 2; ++_i) \
        __builtin_amdgcn_global_load_lds((const unsigned*)((const char*)(gbase) + (voff)[_i]), (PG8_LAS unsigned*)(lds + (bufoff) + ldsw + _i * 8192), 16, 0, 0); } while (0)
#define PG8_LDA(dst, b, h) do { _Pragma("unroll") for (int m = 0; m < 4; ++m) _Pragma("unroll") for (int k = 0; k < 2; ++k) dst[m][k] = *(const PG8_LAS bf16x8*)(lds + PG8_SA(b, h) + aoff + m * 2048 + k * 1024); } while (0)
#define PG8_LDB(dst, b, h) do { _Pragma("unroll") for (int n = 0; n < 2; ++n) _Pragma("unroll") for (int k = 0; k < 2; ++k) dst[n][k] = *(const PG8_LAS bf16x8*)(lds + PG8_SB(b, h) + boff + n * 2048 + k * 1024); } while (0)
#define PG8_MMA(ai, bj, At, Bt) do { __builtin_amdgcn_s_setprio(1); _Pragma("unroll") for (int m = 0; m < 4; ++m) _Pragma("unroll") for (int n = 0; n < 2; ++n) _Pragma("unroll") for (int k = 0; k < 2; ++k) \
        acc[ai][bj][m][n] = __builtin_amdgcn_mfma_f32_16x16x32_bf16(Bt[n][k], At[m][k], acc[ai][bj][m][n], 0, 0, 0); __builtin_amdgcn_s_setprio(0); } while (0)
#define PG8_WAIT_V(n) asm volatile("s_waitcnt vmcnt(" #n ")" ::: "memory")
#define PG8_WAIT_L(n) asm volatile("s_waitcnt lgkmcnt(" #n ")" ::: "memory")
#define PG8_BAR __builtin_amdgcn_s_barrier()
#define PG8_SCHED __builtin_amdgcn_sched_barrier(0)
    Unit cur, nxt; int ui = 0;
    if (!S.next(0, cur)) return;
    f32x4 acc[2][2][4][2];
#pragma unroll
    for (int a = 0; a < 2; ++a)
#pragma unroll
        for (int b = 0; b < 2; ++b)
#pragma unroll
            for (int m = 0; m < 4; ++m)
#pragma unroll
                for (int n = 0; n < 2; ++n) acc[a][b][m][n] = (f32x4){0.f, 0.f, 0.f, 0.f};
    bf16x8 At[4][2], B0[2][2], B1[2][2];
    if constexpr (Sched::KSEG) nt = cur.nt;
    const char* cA = (const char*)((Sched::KSEG && cur.sel) ? g.A2 : g.A) + (size_t)cur.pm * tstepA + (Sched::KSEG ? (size_t)cur.k0 * 2 : 0); const char* cB = (const char*)((Sched::KSEG && cur.sel) ? g.Bt2 : g.Bt) + (size_t)cur.pb * tstepB + (Sched::KSEG ? (size_t)cur.k0 * 2 : 0);
    S.a_ready(cur);
    if constexpr (SP2) {
        PG8_STAGE(PG8_SB(0, 0), cB, voffB); PG8_STAGE(PG8_SB(0, 1), cB + hstepB, voffB); PG8_STAGE(PG8_SA(0, 0), cA, voffA); PG8_STAGE(PG8_SA(0, 1), cA + hstepA, voffA);
        if (wr == 1) PG8_BAR;
        PG8_WAIT_V(2); PG8_BAR;
        PG8_STAGE(PG8_SB(1, 0), cB + kstep, voffB); PG8_STAGE(PG8_SA(1, 0), cA + kstep, voffA); PG8_STAGE(PG8_SB(1, 1), cB + hstepB + kstep, voffB);
        PG8_WAIT_V(6); PG8_BAR;
    } else {
        PG8_STAGE(PG8_SB(0, 0), cB, voffB); PG8_STAGE(PG8_SA(0, 0), cA, voffA); PG8_STAGE(PG8_SB(0, 1), cB + hstepB, voffB); PG8_STAGE(PG8_SA(0, 1), cA + hstepA, voffA);
        if (wr == 1) PG8_BAR;
        PG8_WAIT_V(4); PG8_BAR;
        PG8_STAGE(PG8_SB(1, 0), cB + kstep, voffB); PG8_STAGE(PG8_SA(1, 0), cA + kstep, voffA); PG8_STAGE(PG8_SB(1, 1), cB + hstepB + kstep, voffB);
        PG8_WAIT_V(6); PG8_BAR;
    }
    for (;;) {
        const bool has_next = S.next(ui + 1, nxt);
        const char* nA = has_next ? (const char*)((Sched::KSEG && nxt.sel) ? g.A2 : g.A) + (size_t)nxt.pm * tstepA + (Sched::KSEG ? (size_t)nxt.k0 * 2 : 0) : cA; const char* nB = has_next ? (const char*)((Sched::KSEG && nxt.sel) ? g.Bt2 : g.Bt) + (size_t)nxt.pb * tstepB + (Sched::KSEG ? (size_t)nxt.k0 * 2 : 0) : cB;
        for (int t = 0; t < nt; t += 2) {
            const bool last = (t == nt - 2);
            const char* a1 = cA + (size_t)(t + 1) * kstep;
            const char* a2 = last ? nA : cA + (size_t)(t + 2) * kstep; const char* b2 = last ? nB : cB + (size_t)(t + 2) * kstep;
            const char* a3 = a2 + kstep; const char* b3 = b2 + kstep;
            if (last && has_next) S.a_ready(nxt);
            if constexpr (SP2) {
            PG8_LDB(B0, 0, 0); PG8_LDB(B1, 0, 1); PG8_SCHED; PG8_LDA(At, 0, 0); PG8_STAGE(PG8_SA(1, 1), a1 + hstepA, voffA);
            PG8_WAIT_V(8); PG8_WAIT_L(0); PG8_BAR; PG8_MMA(0, 0, At, B0); PG8_MMA(0, 1, At, B1); PG8_BAR; PG8_SCHED;
            PG8_LDA(At, 0, 1); PG8_STAGE(PG8_SB(0, 0), b2, voffB); PG8_STAGE(PG8_SB(0, 1), b2 + hstepB, voffB); PG8_STAGE(PG8_SA(0, 0), a2, voffA);
            PG8_WAIT_V(8); PG8_WAIT_L(0); PG8_BAR; PG8_MMA(1, 0, At, B0); PG8_MMA(1, 1, At, B1); PG8_BAR; PG8_SCHED;
            PG8_LDB(B0, 1, 0); PG8_LDB(B1, 1, 1); PG8_SCHED; PG8_LDA(At, 1, 0); PG8_STAGE(PG8_SA(0, 1), a2 + hstepA, voffA);
            PG8_WAIT_V(8); PG8_WAIT_L(0); PG8_BAR; PG8_MMA(0, 0, At, B0); PG8_MMA(0, 1, At, B1); PG8_BAR; PG8_SCHED;
            PG8_LDA(At, 1, 1); PG8_STAGE(PG8_SB(1, 0), b3, voffB); PG8_STAGE(PG8_SB(1, 1), b3 + hstepB, voffB); PG8_STAGE(PG8_SA(1, 0), a3, voffA);
            PG8_WAIT_V(8); PG8_WAIT_L(0); PG8_BAR; PG8_MMA(1, 0, At, B0); PG8_MMA(1, 1, At, B1); PG8_BAR; PG8_SCHED;
            } else {
            PG8_LDB(B0, 0, 0); PG8_SCHED; PG8_LDA(At, 0, 0); PG8_STAGE(PG8_SA(1, 1), a1 + hstepA, voffA);
            PG8_WAIT_L(8); PG8_BAR; PG8_WAIT_L(0); PG8_MMA(0, 0, At, B0); PG8_BAR; PG8_SCHED;
            PG8_LDB(B1, 0, 1); PG8_STAGE(PG8_SB(0, 0), b2, voffB);
            PG8_BAR; PG8_WAIT_L(0); PG8_MMA(0, 1, At, B1); PG8_BAR;
            PG8_LDA(At, 0, 1); PG8_STAGE(PG8_SA(0, 0), a2, voffA);
            PG8_BAR; PG8_WAIT_L(0); PG8_MMA(1, 0, At, B0); PG8_BAR; PG8_SCHED;
            PG8_STAGE(PG8_SB(0, 1), b2 + hstepB, voffB);
            PG8_WAIT_V(6); PG8_BAR; PG8_MMA(1, 1, At, B1); PG8_BAR;
            PG8_LDB(B0, 1, 0); PG8_SCHED; PG8_LDA(At, 1, 0); PG8_STAGE(PG8_SA(0, 1), a2 + hstepA, voffA);
            PG8_WAIT_L(8); PG8_BAR; PG8_WAIT_L(0); PG8_MMA(0, 0, At, B0); PG8_BAR; PG8_SCHED;
            PG8_LDB(B1, 1, 1); PG8_STAGE(PG8_SB(1, 0), b3, voffB);
            PG8_BAR; PG8_WAIT_L(0); PG8_MMA(0, 1, At, B1); PG8_BAR;
            PG8_LDA(At, 1, 1); PG8_STAGE(PG8_SA(1, 0), a3, voffA);
            PG8_BAR; PG8_WAIT_L(0); PG8_MMA(1, 0, At, B0); PG8_BAR; PG8_SCHED;
            PG8_STAGE(PG8_SB(1, 1), b3 + hstepB, voffB);
            PG8_WAIT_V(6); PG8_BAR; PG8_MMA(1, 1, At, B1); PG8_BAR;
            }
        }
        if constexpr (ALIGN_EPI) { if (wr == 0) PG8_BAR; }
        if constexpr (!Epi::AFTER_DRAIN) { int te_ = threadIdx.x; asm volatile("" : "+v"(te_) :: "memory");     E(acc, cur, wr, wc, te_ & 15, (te_ & 63) >> 4); S.done(cur); }
        if (!has_next) break;
        if (!Sched::carry(cur)) {
#pragma unroll
        for (int a = 0; a < 2; ++a)
#pragma unroll
            for (int b = 0; b < 2; ++b)
#pragma unroll
                for (int m = 0; m < 4; ++m)
#pragma unroll
                    for (int n = 0; n < 2; ++n) acc[a][b][m][n] = (f32x4){0.f, 0.f, 0.f, 0.f};
        }
        cur = nxt; cA = nA; cB = nB; ++ui; if constexpr (Sched::KSEG) nt = cur.nt;
        if constexpr (ALIGN_EPI) { if (wr == 1) PG8_BAR; }
    }
    PG8_WAIT_V(0);
    if constexpr (!ALIGN_EPI) { if (wr == 0) PG8_BAR; }
    PG8_BAR;
    if constexpr (Epi::AFTER_DRAIN) { E.fused(acc, cur, wr, wc, fr, fq, lds, wid, lane); S.done(cur); }
#undef PG8_SA
#undef PG8_SB
#undef PG8_STAGE
#undef PG8_LDA
#undef PG8_LDB
#undef PG8_MMA
#undef PG8_WAIT_V
#undef PG8_WAIT_L
#undef PG8_BAR
#undef PG8_SCHED
}
}
namespace pg8 {
__device__ __forceinline__ float row_rstd(const float* ssq, int row) {
    const f32x4 a = *(const f32x4*)(ssq + (size_t)row * 4);
    return 1.0f / sqrtf(((a[0] + a[1]) + (a[2] + a[3])) * (1.0f / 1024.0f) + 1e-6f);
}
__device__ __forceinline__ void rstd8(const float* ssq, int row0, int, float (&rs)[8]) {
    f32x4 q[8];
#pragma unroll
    for (int i = 0; i < 8; ++i) q[i] = *(const f32x4*)(ssq + (size_t)(row0 + (i >> 2) * HALF + (i & 3) * 16) * 4);
#pragma unroll
    for (int i = 0; i < 8; ++i) { const float t = (q[i][0] + q[i][1]) + (q[i][2] + q[i][3]); rs[i] = __builtin_amdgcn_rsqf(t * (1.0f / 1024.0f) + 1e-6f); }
}
__device__ __forceinline__ float xsum32(float v) { const auto r = __builtin_amdgcn_permlane32_swap(__float_as_uint(v), __float_as_uint(v), false, false); return __uint_as_float(r[0]) + __uint_as_float(r[1]); }
__device__ __forceinline__ float xsum16(float v) { const auto r = __builtin_amdgcn_permlane16_swap(__float_as_uint(v), __float_as_uint(v), false, false); return __uint_as_float(r[0]) + __uint_as_float(r[1]); }
__device__ __forceinline__ float xmax32(float v) { const auto r = __builtin_amdgcn_permlane32_swap(__float_as_uint(v), __float_as_uint(v), false, false); return __builtin_fmaxf(__uint_as_float(r[0]), __uint_as_float(r[1])); }
__device__ __forceinline__ float partner16(float v, bool odd16) { const auto r = __builtin_amdgcn_permlane16_swap(__float_as_uint(v), __float_as_uint(v), false, false); return __uint_as_float(odd16 ? r[0] : r[1]); }
__device__ __forceinline__ void store_wt(void* p, u32x4 v) { asm volatile("global_store_dwordx4 %0, %1, off sc1\n\ts_nop 1" :: "v"(p), "v"(v) : "memory"); }
__device__ __forceinline__ u32x4 pack8(const float (&v)[8]) { u32x4 w; w.x = cvt_pk_bf16(v[0], v[1]); w.y = cvt_pk_bf16(v[2], v[3]); w.z = cvt_pk_bf16(v[4], v[5]); w.w = cvt_pk_bf16(v[6], v[7]); return w; }
__device__ __forceinline__ void unpack8(const u32x4 w, float (&v)[8]) {
    v[0] = __uint_as_float(w.x << 16); v[1] = __uint_as_float(w.x & 0xffff0000u); v[2] = __uint_as_float(w.y << 16); v[3] = __uint_as_float(w.y & 0xffff0000u);
    v[4] = __uint_as_float(w.z << 16); v[5] = __uint_as_float(w.z & 0xffff0000u); v[6] = __uint_as_float(w.w << 16); v[7] = __uint_as_float(w.w & 0xffff0000u);
}
#define PG8_V8(v, a, b, sc) do { v[0] = a[0] * (sc); v[1] = a[1] * (sc); v[2] = a[2] * (sc); v[3] = a[3] * (sc); v[4] = b[0] * (sc); v[5] = b[1] * (sc); v[6] = b[2] * (sc); v[7] = b[3] * (sc); } while (0)

struct EpiQKV {
    static constexpr bool PERM = true, AFTER_DRAIN = false;
    bf16_t* ZQ; bf16_t* ZKV; const float* ssq; const unsigned* rope; float* ksum;
    template <int NB, bool KSUM> __device__ __forceinline__ void body(const f32x4 (&acc)[2][2][4][2], const Unit& u, int wr, int wc, int fr, int fq) const {
        const int row0 = u.pm * BM + wr * 64 + fr, colt = u.pn * BM;
        bf16_t* base; int ldc, cb;
        if (colt < 1024) { base = ZQ; ldc = 1024; cb = colt; } else { base = ZKV; ldc = 1536; cb = colt - 1024; }
        const int hg0 = (colt + wc * 32) >> 6;
        const bool half0 = (wc & 1) == 0;
        const bool rope0 = (hg0 < 12) || (hg0 >= 16 && hg0 < 22) || (hg0 >= 28 && hg0 < 34), rope1 = (hg0 + 2 < 12) || (hg0 + 2 >= 16 && hg0 + 2 < 22) || (hg0 + 2 >= 28 && hg0 + 2 < 34);
        const bool anyrope = half0 && (rope0 || rope1);
        float rs[8]; rstd8(ssq, row0, fq, rs);
        asm volatile("" ::: "memory");
        float ks[2][8];
        if (KSUM) {
#pragma unroll
            for (int bj = 0; bj < 2; ++bj)
#pragma unroll
                for (int j = 0; j < 8; ++j) ks[bj][j] = 0.f; }
#pragma unroll
        for (int rb = 0; rb < 8; rb += NB) {
            u32x4 rt[NB][2];
            if (anyrope) {
#pragma unroll
                for (int i = 0; i < NB; ++i) { const int ri = rb + i; const u32x4* rp = (const u32x4*)(rope + (size_t)((row0 + (ri >> 2) * HALF + (ri & 3) * 16) & 2047) * 8);
                    rt[i][0] = rp[0]; rt[i][1] = rp[1]; } }
#pragma unroll
            for (int i = 0; i < NB; ++i) {
                const int ri = rb + i, ai = ri >> 2, m = ri & 3;
                const int row = row0 + ai * HALF + m * 16;
                const float rstd = rs[ri];
#pragma unroll
                for (int bj = 0; bj < 2; ++bj) {
                    const int hg = hg0 + 2 * bj;
                    const bool isrope = bj == 0 ? rope0 : rope1;
                    float v[8]; PG8_V8(v, acc[ai][bj][m][0], acc[ai][bj][m][1], rstd);
                    if (isrope && half0) {
                        float p[8];
#pragma unroll
                        for (int j = 0; j < 8; ++j) p[j] = partner16(v[j], (fq & 1) != 0);
                        if (fq < 2) { const float sg = (fq == 0) ? -1.f : 1.f;
#pragma unroll
                            for (int j = 0; j < 8; ++j) { const unsigned w = rt[i][j >> 2][j & 3]; const float cs = (float)__builtin_bit_cast(_Float16, (unsigned short)(w & 0xffffu)), sn = (float)__builtin_bit_cast(_Float16, (unsigned short)(w >> 16));
                                v[j] = v[j] * cs + sg * (p[j] * sn); } }
                    }
                    if (hg < 16) {
#pragma unroll
                        for (int j = 0; j < 8; ++j) v[j] *= 0.18033688011112042f; }
                    *(u32x4*)(base + ((unsigned)row * (unsigned)ldc + (unsigned)(cb + bj * HALF + wc * 32 + 8 * fq))) = pack8(v);
                    if (KSUM) { if (hg >= 28 && hg < 34) {
#pragma unroll
                        for (int j = 0; j < 8; ++j) ks[bj][j] += v[j]; } }
                }
            }
        }
        if (KSUM) {
#pragma unroll
            for (int bj = 0; bj < 2; ++bj) { const int hg = hg0 + 2 * bj;
                if (hg >= 28 && hg < 34) {
                    float* kp = ksum + (size_t)(u.pm * 6 + (hg - 28)) * 64 + (wc & 1) * 32 + 8 * fq;
#pragma unroll
                    for (int j = 0; j < 8; ++j) { float s = ks[bj][j]; s += __shfl_xor(s, 1); s += __shfl_xor(s, 2); s += __shfl_xor(s, 4); s += __shfl_xor(s, 8);
                        if (fr == 0) atomicAdd(kp + j, s); }
                } }
        }
    }
    __device__ __forceinline__ void operator()(const f32x4 (&acc)[2][2][4][2], const Unit& u, int wr, int wc, int fr, int fq) const {
        if (u.pn == 7 || u.pn == 8) body<4, true>(acc, u, wr, wc, fr, fq); else body<4, false>(acc, u, wr, wc, fr, fq);
    }
};
struct EpiGate {
    static constexpr bool PERM = true, AFTER_DRAIN = false;
    bf16_t* ZG; const float* ssq;
    __device__ __forceinline__ void operator()(const f32x4 (&acc)[2][2][4][2], const Unit& u, int wr, int wc, int fr, int fq) const {
        const int row0 = u.pm * BM + wr * 64 + fr, col0 = u.pn * BM + wc * 32 + 8 * fq;
        float rs[8]; rstd8(ssq, row0, fq, rs);
#pragma unroll
        for (int ai = 0; ai < 2; ++ai)
#pragma unroll
            for (int m = 0; m < 4; ++m) { const int row = row0 + ai * HALF + m * 16; const float rstd = rs[ai * 4 + m];
#pragma unroll
                for (int bj = 0; bj < 2; ++bj) { float v[8]; PG8_V8(v, acc[ai][bj][m][0], acc[ai][bj][m][1], rstd);
#pragma unroll
                    for (int j = 0; j < 8; ++j) v[j] = __builtin_amdgcn_rcpf(1.0f + __builtin_amdgcn_exp2f(v[j] * -1.4426950408889634f));
                    *(u32x4*)(ZG + (size_t)row * 3072 + col0 + bj * HALF) = pack8(v); } }
    }
};
struct EpiPlain {
    static constexpr bool PERM = true, AFTER_DRAIN = false;
    bf16_t* O; int ldc;
    __device__ __forceinline__ void operator()(const f32x4 (&acc)[2][2][4][2], const Unit& u, int wr, int wc, int fr, int fq) const {
        const int row0 = u.pm * BM + wr * 64 + fr, col0 = u.pn * BM + wc * 32 + 8 * fq;
#pragma unroll
        for (int ai = 0; ai < 2; ++ai)
#pragma unroll
            for (int m = 0; m < 4; ++m) { const int row = row0 + ai * HALF + m * 16;
#pragma unroll
                for (int bj = 0; bj < 2; ++bj) { float v[8]; PG8_V8(v, acc[ai][bj][m][0], acc[ai][bj][m][1], 1.0f);
                    *(u32x4*)(O + (size_t)row * ldc + col0 + bj * HALF) = pack8(v); } }
    }
};
template <int BR> struct EpiProj {
    static constexpr bool PERM = true, AFTER_DRAIN = false;
    bf16_t* ZG;
    __device__ __forceinline__ void operator()(const f32x4 (&acc)[2][2][4][2], const Unit& u, int wr, int wc, int fr, int fq) const {
        const int row0 = u.pm * BM + wr * 64 + fr, col0 = u.pn * BM + wc * 32 + 8 * fq;
#pragma unroll
        for (int ai = 0; ai < 2; ++ai)
#pragma unroll
            for (int m = 0; m < 4; ++m) { const int row = row0 + ai * HALF + m * 16;
#pragma unroll
                for (int bj = 0; bj < 2; ++bj) { bf16_t* yp = ZG + (size_t)row * 3072 + col0 + bj * HALF;
                    float g[8], v[8]; unpack8(*(const u32x4*)(yp + BR * 1024), g); PG8_V8(v, acc[ai][bj][m][0], acc[ai][bj][m][1], 1.0f);
                    if (BR > 0) { float y[8]; unpack8(*(const u32x4*)yp, y);
#pragma unroll
                        for (int j = 0; j < 8; ++j) v[j] = y[j] + g[j] * v[j]; }
                    else {
#pragma unroll
                        for (int j = 0; j < 8; ++j) v[j] = g[j] * v[j]; }
                    *(u32x4*)yp = pack8(v); } }
    }
};
struct GateProjOrder : StaticOrder {
    static constexpr bool KSEG = true;
    __host__ __device__ static bool carry(const Unit& u) { return u.br == 3 || u.br == 4; }
    __host__ __device__ bool next(int i, Unit& u) const {
        if (!StaticOrder::next(i / 6, u)) return false;
        const int sg = i % 6; u.br = sg;
        if (sg < 3) { u.sel = 0; u.pb = 4 * sg + u.pn; u.k0 = 0; u.nt = 16; }
        else { u.sel = 1; u.pb = u.pn; u.k0 = (sg == 3) ? 0 : (sg == 4) ? 384 : 768; u.nt = (sg == 3) ? 2 : (sg == 4) ? 6 : 4; }
        return true;
    }
};
struct EpiGateProj {
    static constexpr bool PERM = true, AFTER_DRAIN = false;
    bf16_t* ZG; const float* ssq;
    __device__ __forceinline__ void operator()(f32x4 (&acc)[2][2][4][2], const Unit& u, int wr, int wc, int fr, int fq) const {
        const int row0 = u.pm * BM + wr * 64 + fr, col0 = u.pn * BM + wc * 32 + 8 * fq;
        const unsigned o0 = (unsigned)row0 * 3072u + (unsigned)col0;
        if (u.br < 3) {
            float rs[8]; rstd8(ssq, row0, fq, rs);
            const unsigned og = o0 + (unsigned)u.br * 1024u;
#pragma unroll
            for (int ai = 0; ai < 2; ++ai)
#pragma unroll
                for (int m = 0; m < 4; ++m) { const float rstd = rs[ai * 4 + m];
#pragma unroll
                    for (int bj = 0; bj < 2; ++bj) { float v[8]; PG8_V8(v, acc[ai][bj][m][0], acc[ai][bj][m][1], rstd);
#pragma unroll
                        for (int j = 0; j < 8; ++j) v[j] = __builtin_amdgcn_rcpf(1.0f + __builtin_amdgcn_exp2f(v[j] * -1.4426950408889634f));
                        *(u32x4*)(ZG + (og + (unsigned)((ai * HALF + m * 16) * 3072 + bj * HALF))) = pack8(v); } }
        } else if (u.br == 5) {
#pragma unroll
            for (int ai = 0; ai < 2; ++ai) {
                u32x4 g2[4][2];
#pragma unroll
                for (int m = 0; m < 4; ++m)
#pragma unroll
                    for (int bj = 0; bj < 2; ++bj) g2[m][bj] = *(const u32x4*)(ZG + (o0 + 2048u + (unsigned)((ai * HALF + m * 16) * 3072 + bj * HALF)));
#pragma unroll
                for (int m = 0; m < 4; ++m)
#pragma unroll
                    for (int bj = 0; bj < 2; ++bj) { float gn[8], v[8]; unpack8(g2[m][bj], gn); PG8_V8(v, acc[ai][bj][m][0], acc[ai][bj][m][1], 1.0f);
#pragma unroll
                        for (int j = 0; j < 8; ++j) v[j] = gn[j] * v[j];
                        store_wt(ZG + (o0 + (unsigned)((ai * HALF + m * 16) * 3072 + bj * HALF)), pack8(v)); }
            }
        }
        if (u.br == 3 || u.br == 4) {
            const unsigned on = o0 + (unsigned)(u.br - 3) * 1024u;
#pragma unroll
            for (int ai = 0; ai < 2; ++ai)
#pragma unroll
                for (int mp = 0; mp < 4; mp += 2) {
                    u32x4 gn_[2][2], gd_[2][2];
#pragma unroll
                    for (int mm = 0; mm < 2; ++mm)
#pragma unroll
                        for (int bj = 0; bj < 2; ++bj) { const unsigned o = on + (unsigned)((ai * HALF + (mp + mm) * 16) * 3072 + bj * HALF); gn_[mm][bj] = *(const u32x4*)(ZG + o); gd_[mm][bj] = *(const u32x4*)(ZG + (o + 1024u)); }
#pragma unroll
                    for (int mm = 0; mm < 2; ++mm)
#pragma unroll
                        for (int bj = 0; bj < 2; ++bj) { const int m = mp + mm; float gn[8], gd[8]; unpack8(gn_[mm][bj], gn); unpack8(gd_[mm][bj], gd);
#pragma unroll
                            for (int j = 0; j < 8; ++j) gn[j] = gn[j] * __builtin_amdgcn_rcpf(fmaxf(gd[j], 1e-30f));
                            acc[ai][bj][m][0] = acc[ai][bj][m][0] * (f32x4){gn[0], gn[1], gn[2], gn[3]}; acc[ai][bj][m][1] = acc[ai][bj][m][1] * (f32x4){gn[4], gn[5], gn[6], gn[7]};
                            asm volatile("" : "+v"(acc[ai][bj][m][0]), "+v"(acc[ai][bj][m][1])); }
                }
        }
    }
};
struct EpiRes {
    static constexpr bool PERM = true, AFTER_DRAIN = true;
    __device__ static bool stores16(const Unit&) { return true; }
    bf16_t* xb; float* ssq;
    __device__ __forceinline__ void fused(const f32x4 (&acc)[2][2][4][2], const Unit& u, int wr, int wc, int, int, PG8_LAS unsigned char* lds, int, int) const {
        int te_ = threadIdx.x; asm volatile("" : "+v"(te_) :: "memory"); const int fr = te_ & 15, fq = (te_ & 63) >> 4;
        const int row0 = u.pm * BM + wr * 64 + fr, col0 = u.pn * BM + wc * 32 + 8 * fq;
        const unsigned o0 = (unsigned)row0 * 1024u + (unsigned)col0;
        PG8_LAS float* P = (PG8_LAS float*)lds;
        u32x4 bs[2][4][2];
#pragma unroll
        for (int ai = 0; ai < 2; ++ai)
#pragma unroll
            for (int m = 0; m < 4; ++m)
#pragma unroll
                for (int bj = 0; bj < 2; ++bj) bs[ai][m][bj] = *(const u32x4*)(xb + (o0 + (unsigned)((ai * HALF + m * 16) * 1024 + bj * HALF)));
#pragma unroll
        for (int ai = 0; ai < 2; ++ai) {
#pragma unroll
            for (int m = 0; m < 4; ++m) { float sq = 0.f;
#pragma unroll
                for (int bj = 0; bj < 2; ++bj) {
                    float b[8], v[8]; unpack8(bs[ai][m][bj], b); PG8_V8(v, acc[ai][bj][m][0], acc[ai][bj][m][1], 1.0f);
#pragma unroll
                    for (int j = 0; j < 8; ++j) { v[j] += b[j]; sq += v[j] * v[j]; }
                    store_wt(xb + (o0 + (unsigned)((ai * HALF + m * 16) * 1024 + bj * HALF)), pack8(v)); }
                sq = xsum16(sq); sq = xsum32(sq);
                if (fq == 0) P[(ai * HALF + wr * 64 + m * 16 + fr) * 4 + wc] = sq; }
        }
        asm volatile("s_waitcnt lgkmcnt(0)" ::: "memory"); __builtin_amdgcn_s_barrier(); asm volatile("" ::: "memory");
        if (te_ < 256) { const f32x4 p = *(PG8_LAS const f32x4*)(P + te_ * 4); ssq[(unsigned)(u.pm * BM + te_) * 4u + (unsigned)u.pn] = (p[0] + p[1]) + (p[2] + p[3]); }
    }
};
struct EpiUp {
    static constexpr bool PERM = true, AFTER_DRAIN = false;
    bf16_t* U; const float* ssq;
    __device__ __forceinline__ void operator()(const f32x4 (&acc)[2][2][4][2], const Unit& u, int wr, int wc, int fr, int fq) const {
        const int row0 = u.pm * BM + wr * 64 + fr, col0 = u.pn * BM + wc * 32 + 8 * fq;
        float rs[8]; rstd8(ssq, row0, fq, rs);
#pragma unroll
        for (int ai = 0; ai < 2; ++ai)
#pragma unroll
            for (int m = 0; m < 4; ++m) { const int row = row0 + ai * HALF + m * 16; const float rstd = rs[ai * 4 + m];
#pragma unroll
                for (int bj = 0; bj < 2; ++bj) { float v[8]; PG8_V8(v, acc[ai][bj][m][0], acc[ai][bj][m][1], rstd);
#pragma unroll
                    for (int j = 0; j < 8; ++j) { const float r = fmaxf(v[j], 0.f); v[j] = r * r; }
                    store_wt(U + (size_t)row * 4096 + col0 + bj * HALF, pack8(v)); } }
    }
};
}
#define GAS __attribute__((address_space(1)))
#define LAS __attribute__((address_space(3)))
typedef unsigned short bf16;
typedef unsigned v4u __attribute__((ext_vector_type(4)));
typedef float f32x4 __attribute__((ext_vector_type(4)));
typedef short bf16x8 __attribute__((ext_vector_type(8)));
typedef GAS unsigned gu32;
typedef GAS unsigned long long gu64;
#define RLX_AGENT __ATOMIC_RELAXED, __HIP_MEMORY_SCOPE_AGENT
#define LDS_WAIT() asm volatile("s_waitcnt lgkmcnt(0)" ::: "memory")
#define VM_WAIT() asm volatile("s_waitcnt vmcnt(0)" ::: "memory")
__device__ __forceinline__ unsigned long long rt() { return __builtin_amdgcn_s_memrealtime(); }
__device__ __forceinline__ unsigned f2bf(float f) { unsigned u = __builtin_bit_cast(unsigned, f); return (u + 0x7fffu + ((u >> 16) & 1u)) >> 16; }
__device__ __forceinline__ unsigned pk2(float lo, float hi) { return f2bf(lo) | (f2bf(hi) << 16); }

#define XB_TMO      128
#define XB_XCNT(j)  (256  + 64 * (j))
#define XB_XSUB(j)  (1280 + 64 * (j))
#define XB_XGEN(j)  (2304 + 64 * (j))
#define XB_TOP      3328
#define XB_TOPGEN   3392
#define XCD_BAR_WORDS 3456
#define XB_SPIN_CAP (1u << 18)

__device__ __forceinline__ unsigned xb_ld(unsigned* p)              { return __hip_atomic_load(p, __ATOMIC_RELAXED, __HIP_MEMORY_SCOPE_AGENT); }
__device__ __forceinline__ unsigned xb_add(unsigned* p, unsigned v) { return __hip_atomic_fetch_add(p, v, __ATOMIC_RELAXED, __HIP_MEMORY_SCOPE_AGENT); }
__device__ __forceinline__ unsigned xb_xcc_id() { return (unsigned)__builtin_amdgcn_s_getreg((3 << 11) | 20) & 0xFu; }
#define XB_SPIN(cond, bar) do { unsigned _sp = 0; while (cond) { __builtin_amdgcn_s_sleep(1); \
    if ((++_sp & 255u) == 0u) { if (xb_ld(&(bar)[XB_TMO])) break; if (_sp > XB_SPIN_CAP) { atomicAdd(&(bar)[XB_TMO], 1u); break; } } } } while (0)

struct XcdBarrier {
    unsigned* bar; unsigned x;
    volatile LAS unsigned* st;
};

__device__ __forceinline__ XcdBarrier xcd_barrier_post(unsigned* bar, volatile LAS unsigned* st) {
    XcdBarrier b; b.bar = bar; b.x = xb_xcc_id(); b.st = st;
    if (threadIdx.x == 0) (void)xb_add(&bar[XB_XCNT(b.x)], 1u);
    return b;
}
__device__ __forceinline__ void xcd_barrier_complete(unsigned* bar, unsigned x, unsigned& nloc, unsigned& nx) {
    const unsigned G = gridDim.x * gridDim.y * gridDim.z;
    unsigned sum, cnt, mine, sp = 0u;
    for (;;) {
        sum = 0u; cnt = 0u; mine = 0u;
#pragma unroll
        for (unsigned j = 0; j < 16; ++j) { const unsigned c = xb_ld(&bar[XB_XCNT(j)]); sum += c; cnt += (c > 0u) ? 1u : 0u; mine = (j == x) ? c : mine; }
        if (sum == G) break;
        __builtin_amdgcn_s_sleep(1);
        if ((++sp & 255u) == 0u) { if (xb_ld(&bar[XB_TMO])) break; if (sp > XB_SPIN_CAP) { atomicAdd(&bar[XB_TMO], 1u); break; } }
    }
    nloc = mine > 0u ? mine : 1u; nx = cnt > 0u ? cnt : 1u;
}

__device__ __forceinline__ void xcd_barrier(const XcdBarrier& b) {
    asm volatile("s_waitcnt vmcnt(0)" ::: "memory");
    __syncthreads();
    if (threadIdx.x == 0) {
        unsigned* bar = b.bar;
        __builtin_amdgcn_s_waitcnt(0);
        unsigned nloc = b.st[0], nx = b.st[1];
        if (nloc == 0u) { xcd_barrier_complete(bar, b.x, nloc, nx); b.st[0] = nloc; b.st[1] = nx; }
        const unsigned old = xb_add(&bar[XB_XSUB(b.x)], 1u);
        const unsigned gen = old / nloc;
        if (old + 1u == (gen + 1u) * nloc) {
            __builtin_amdgcn_fence(__ATOMIC_RELEASE, "agent");
            asm volatile("s_waitcnt vmcnt(0)" ::: "memory");
            const unsigned og = xb_add(&bar[XB_TOP], 1u);
            const unsigned tg = og / nx;
            if (og + 1u == (tg + 1u) * nx) xb_add(&bar[XB_TOPGEN], 1u);
            else XB_SPIN(xb_ld(&bar[XB_TOPGEN]) == tg, bar);
            __builtin_amdgcn_fence(__ATOMIC_ACQUIRE, "agent");
            xb_add(&bar[XB_XGEN(b.x)], 1u);
            asm volatile("s_waitcnt vmcnt(0)" ::: "memory");
        } else {
            XB_SPIN(xb_ld(&bar[XB_XGEN(b.x)]) == gen, bar);
            __builtin_amdgcn_fence(__ATOMIC_ACQUIRE, "agent");
            asm volatile("s_waitcnt vmcnt(0)" ::: "memory");
        }
    }
    __syncthreads();
}

constexpr int NWAVES = 8;
constexpr int T = 16384, D = 1024, SEQ = 2048, FF = 4096, DIN = 5632, NQKV = 2560, NGATE = 3072, NMEMROWS = 2048;
constexpr size_t MiB = 1u << 20;
constexpr size_t WS_CTL = 0, CTL_ZERO_BYTES = 1 * MiB;
constexpr size_t WS_KSUM = 256 * 1024;
constexpr size_t WS_ROPE = 1 * MiB;
constexpr size_t WS_SSQ = 2 * MiB;
constexpr size_t WS_PTRS = 768 * 1024;
constexpr size_t WS_LSE = 3 * MiB;
constexpr size_t WS_MKV = 4 * MiB;
constexpr size_t WS_MEMN = 6 * MiB;
constexpr size_t WS_W = 10 * MiB;
constexpr size_t W_IN = 0, W_UP = 11 * MiB, W_DN = 19 * MiB, W_O = 27 * MiB, W_P = 29 * MiB, W_MKV = 31 * MiB, W_LAYER = 32 * MiB;
constexpr size_t WS_XB = 74 * MiB;
constexpr size_t WS_ZQ = 106 * MiB;
constexpr size_t WS_ZKV = 138 * MiB;
constexpr size_t WS_ZG = 138 * MiB;
constexpr size_t WS_U = 106 * MiB;
constexpr size_t WS_END = 234 * MiB;
constexpr int CW_QUEUE = 2048;
constexpr int CW_BAR = 4096;
constexpr int RING_OFF = 0, RING_BYTES = 131072, LDSCTL_OFF = RING_BYTES, MISC_OFF = LDSCTL_OFF + 320, LDS_BYTES = 147456;

__device__ __forceinline__ float wave_sum(float v) {
#pragma unroll
    for (int o = 1; o < 64; o <<= 1) v += __shfl_xor(v, o);
    return v;
}
__device__ __forceinline__ float bf2f(bf16 h) { return __uint_as_float((unsigned)h << 16); }

struct TrD { const float* W; const float* gain; bf16* WT; int N, ldt, k0, n0, drow, dcol; };
__device__ __forceinline__ void tr_load(const TrD& d, f32x4 (&v)[8], float (&gn)[8], int lane) {
    const int lr = lane >> 3, n4 = lane & 7;
#pragma unroll
    for (int i = 0; i < 8; ++i) { const int kk = 8 * i + lr; v[i] = __builtin_nontemporal_load((const GAS f32x4*)(d.W + (size_t)(d.k0 + kk) * d.N + d.n0 + 4 * n4)); gn[i] = d.gain ? d.gain[d.k0 + kk] : 1.0f; }
}
__device__ __forceinline__ void tr_fin(const TrD& d, const f32x4 (&v)[8], const float (&gn)[8], LAS float* scr, int lane) {
    const int lr = lane >> 3, n4 = lane & 7;
#pragma unroll
    for (int i = 0; i < 8; ++i) { const int kk = 8 * i + lr; LAS float* q = scr + kk * 33 + 4 * n4; q[0] = v[i].x * gn[i]; q[1] = v[i].y * gn[i]; q[2] = v[i].z * gn[i]; q[3] = v[i].w * gn[i]; }
    LDS_WAIT(); asm volatile("" ::: "memory");
    const int c = lane & 7;
#pragma unroll
    for (int j = 0; j < 4; ++j) { const int n = (lane >> 3) + 8 * j; const LAS float* s = scr + (8 * c) * 33 + n;
        v4u o; o.x = pk2(s[0 * 33], s[1 * 33]); o.y = pk2(s[2 * 33], s[3 * 33]); o.z = pk2(s[4 * 33], s[5 * 33]); o.w = pk2(s[6 * 33], s[7 * 33]);
        *(GAS v4u*)(d.WT + (size_t)(d.drow + n) * d.ldt + d.dcol + d.k0 + 8 * c) = o; }
    LDS_WAIT(); asm volatile("" ::: "memory");
}
__device__ __forceinline__ int win_dest_row(int n) {
    if (n < 384) return n;
    if (n < 768) return 1024 + (n - 384);
    if (n < 1152) return 1024 + 384 + (n - 768);
    if (n < 1536) return 384 + (n - 1152);
    if (n < 1920) return 1024 + 768 + (n - 1536);
    if (n < 2304) return 1024 + 1152 + (n - 1920);
    if (n < 2560) return 768 + (n - 2304);
    return n;
}

typedef unsigned u32x4p __attribute__((ext_vector_type(4)));

namespace att {
typedef short bf16x8 __attribute__((ext_vector_type(8)));
typedef short s16x4 __attribute__((ext_vector_type(4)));
typedef float f32x16 __attribute__((ext_vector_type(16)));
constexpr int KP = 144, VP = 192;
constexpr int KBUF = 64 * KP, VBUF = 64 * VP, BUF = KBUF + VBUF;
constexpr float LOG2E = 1.4426950408889634f;
__device__ __forceinline__ int crow(int r, int hi) { return (r & 3) + 8 * (r >> 2) + 4 * hi; }
__device__ __forceinline__ float xsum(float v) { return pg8::xsum32(v); }
__device__ __forceinline__ float xmax(float v) { return pg8::xmax32(v); }
__device__ __forceinline__ s16x4 vtr(LAS const unsigned char* p) { typedef short v4i16_t __attribute__((ext_vector_type(4))); return __builtin_bit_cast(s16x4, __builtin_amdgcn_ds_read_tr16_b64_v4i16((LAS v4i16_t*)p)); }

struct Unit {
    int kind;
    const bf16* Q; bf16* O;
    int qrow0, qstride, nq;
    const bf16* K; const bf16* V; int kvpitch;
    int krow0, kstride;
    int t_lo, t_hi;
    int qidx0;
    int qb;
    const float* ksum;
    float* lse; int lse_stride;
};

template <int KIND> __device__ __forceinline__ void att_tile(LAS const unsigned char* kb, const Unit& u, int t, int wid, int qi, int hi, unsigned koff, unsigned voff, unsigned sel,
                                                             const bf16x8 (&qf)[4], float& m, f32x16& o0, f32x16& o1, f32x16& o2) {
    bf16x8 ka[4], kc[4];
#pragma unroll
    for (int ks = 0; ks < 4; ++ks) { ka[ks] = *(LAS const bf16x8*)(kb + koff + 32 * ks); kc[ks] = *(LAS const bf16x8*)(kb + koff + 32 * KP + 32 * ks); }
    bf16x8 va[2][2], vc[2][2];
#pragma unroll
    for (int sub_ = 0; sub_ < 2; ++sub_)
#pragma unroll
        for (int s = 0; s < 2; ++s) {
            LAS const unsigned char* vb = kb + voff + (32 * sub_ + 16 * s) * VP;
            const s16x4 a_lo = vtr(vb), a_hi = vtr(vb + 8 * VP), b_lo = vtr(vb + 64), b_hi = vtr(vb + 8 * VP + 64);
            va[sub_][s] = (bf16x8){a_lo[0], a_lo[1], a_lo[2], a_lo[3], a_hi[0], a_hi[1], a_hi[2], a_hi[3]};
            vc[sub_][s] = (bf16x8){b_lo[0], b_lo[1], b_lo[2], b_lo[3], b_hi[0], b_hi[1], b_hi[2], b_hi[3]};
        }
    const int qlo = u.qidx0 + 32 * wid;
    bool bs = true, needmask = false;
    if (KIND == 0) { const int blk = t >> 2; if (blk < u.qb) bs = (sel >> blk) & 1u; else needmask = (64 * t + 63 > qlo); }
    if (KIND == 2) needmask = !((64 * t + 63 <= qlo) && (64 * t >= qlo + 31 - 128));
    const bool unset = (m == -INFINITY);
    const float mref = unset ? 0.f : m;
    const float nv = bs ? -mref : -1e30f;
    f32x16 negt;
#pragma unroll
    for (int r = 0; r < 16; ++r) negt[r] = nv;
    f32x16 p0 = __builtin_amdgcn_mfma_f32_32x32x16_bf16(ka[0], qf[0], negt, 0, 0, 0);
    f32x16 p1 = __builtin_amdgcn_mfma_f32_32x32x16_bf16(kc[0], qf[0], negt, 0, 0, 0);
#pragma unroll
    for (int ks = 1; ks < 4; ++ks) {
        p0 = __builtin_amdgcn_mfma_f32_32x32x16_bf16(ka[ks], qf[ks], p0, 0, 0, 0);
        p1 = __builtin_amdgcn_mfma_f32_32x32x16_bf16(kc[ks], qf[ks], p1, 0, 0, 0);
    }
    if (needmask) {
#pragma unroll
        for (int r = 0; r < 16; ++r) {
            const int j0 = 64 * t + crow(r, hi), j1 = j0 + 32;
            bool v0 = j0 <= qi, v1 = j1 <= qi;
            if (KIND == 2) { v0 = v0 && (j0 >= qi - 128); v1 = v1 && (j1 >= qi - 128); }
            p0[r] = v0 ? p0[r] : -INFINITY; p1[r] = v1 ? p1[r] : -INFINITY;
        }
    }
    float rm = __builtin_fmaxf(p0[0], p1[0]);
#pragma unroll
    for (int r = 1; r < 16; ++r) rm = __builtin_fmaxf(__builtin_fmaxf(rm, p0[r]), p1[r]);
    rm = xmax(rm);
    const bool trig = bs && (rm > 8.0f || (unset && rm > -1e29f));
    if (__any(trig)) {
        const float dl = trig ? rm : 0.f;
        const float alpha = (trig && !unset) ? __builtin_amdgcn_exp2f(-dl) : 1.0f;
        m = trig ? (mref + dl) : m;
#pragma unroll
        for (int r = 0; r < 16; ++r) { p0[r] -= dl; p1[r] -= dl; o0[r] *= alpha; o1[r] *= alpha; o2[r] *= alpha; }
    }
#pragma unroll
    for (int r = 0; r < 16; ++r) { p0[r] = __builtin_amdgcn_exp2f(p0[r]); p1[r] = __builtin_amdgcn_exp2f(p1[r]); }
    bf16x8 pf[2][2];
#pragma unroll
    for (int s = 0; s < 2; ++s) {
        u32x4p w0, w1;
        w0.x = pg8::cvt_pk_bf16(p0[8 * s + 0], p0[8 * s + 1]); w0.y = pg8::cvt_pk_bf16(p0[8 * s + 2], p0[8 * s + 3]); w0.z = pg8::cvt_pk_bf16(p0[8 * s + 4], p0[8 * s + 5]); w0.w = pg8::cvt_pk_bf16(p0[8 * s + 6], p0[8 * s + 7]);
        w1.x = pg8::cvt_pk_bf16(p1[8 * s + 0], p1[8 * s + 1]); w1.y = pg8::cvt_pk_bf16(p1[8 * s + 2], p1[8 * s + 3]); w1.z = pg8::cvt_pk_bf16(p1[8 * s + 4], p1[8 * s + 5]); w1.w = pg8::cvt_pk_bf16(p1[8 * s + 6], p1[8 * s + 7]);
        pf[0][s] = __builtin_bit_cast(bf16x8, w0); pf[1][s] = __builtin_bit_cast(bf16x8, w1);
    }
    const bf16x8 ones = (bf16x8){0x3F80, 0x3F80, 0x3F80, 0x3F80, 0x3F80, 0x3F80, 0x3F80, 0x3F80};
#pragma unroll
    for (int sub_ = 0; sub_ < 2; ++sub_)
#pragma unroll
        for (int s = 0; s < 2; ++s) {
            o0 = __builtin_amdgcn_mfma_f32_32x32x16_bf16(va[sub_][s], pf[sub_][s], o0, 0, 0, 0);
            o1 = __builtin_amdgcn_mfma_f32_32x32x16_bf16(vc[sub_][s], pf[sub_][s], o1, 0, 0, 0);
            o2 = __builtin_amdgcn_mfma_f32_32x32x16_bf16(ones, pf[sub_][s], o2, 0, 0, 0);
        }
}

template <int KIND> __device__ __forceinline__ void run_unit(LAS unsigned char* lds, const Unit& u) {
    int tid_ = threadIdx.x; asm volatile("" : "+v"(tid_));
    const int tid = tid_, lane = tid & 63, wid = __builtin_amdgcn_readfirstlane(tid >> 6), ql = lane & 31, hi = lane >> 5;
    const bool wactive = (32 * wid) < u.nq;
    const int srow = tid >> 3, sch = tid & 7;
    const unsigned kdst = (unsigned)(srow * KP + sch * 16), vdst = (unsigned)(KBUF + srow * VP + sch * 16);
    v4u kA, vA, kB, vB;
#define ATT_LOAD(KR, VR, t) do { const size_t r_ = (size_t)(u.krow0 + (64 * (t) + srow) * u.kstride) * u.kvpitch + sch * 8; KR = *(const GAS v4u*)(u.K + r_); VR = *(const GAS v4u*)(u.V + r_); } while (0)
#define ATT_WRITE(KR, VR, b) do { *(LAS v4u*)(lds + (b) * BUF + kdst) = KR; *(LAS v4u*)(lds + (b) * BUF + vdst) = VR; } while (0)
    ATT_LOAD(kA, vA, u.t_lo);
    if (u.t_lo + 1 < u.t_hi) ATT_LOAD(kB, vB, u.t_lo + 1);
    const int qi = u.qidx0 + 32 * wid + ql;
    const size_t qrow = (size_t)(u.qrow0 + (32 * wid + ql) * u.qstride);
    bf16x8 qf[4];
#pragma unroll
    for (int ks = 0; ks < 4; ++ks) qf[ks] = wactive ? *(const bf16x8*)(u.Q + qrow * 1024 + 16 * ks + 8 * hi) : (bf16x8){0, 0, 0, 0, 0, 0, 0, 0};
    unsigned sel = 0xffu;
    if (KIND == 0) {
        float gsc[7];
#pragma unroll
        for (int n = 0; n < 7; ++n) { gsc[n] = -INFINITY;
            if (n < u.qb) { const float* kp = u.ksum + n * 384 + 8 * hi; float s = 0.f;
#pragma unroll
                for (int ks = 0; ks < 4; ++ks) { const f32x4 k0 = *(const f32x4*)(kp + 16 * ks), k1 = *(const f32x4*)(kp + 16 * ks + 4);
#pragma unroll
                    for (int j = 0; j < 4; ++j) { s += bf2f((bf16)qf[ks][j]) * k0[j]; s += bf2f((bf16)qf[ks][4 + j]) * k1[j]; } }
                s = xsum(s); gsc[n] = s; } }
        sel = 0u;
#pragma unroll
        for (int r = 0; r < 3; ++r) { int best = -1; float bv = -INFINITY;
#pragma unroll
            for (int n = 0; n < 7; ++n) if (n < u.qb && !((sel >> n) & 1u) && gsc[n] > bv) { bv = gsc[n]; best = n; }
            if (best >= 0) sel |= 1u << best; }
    }
    float m = -INFINITY; f32x16 o0 = {}, o1 = {}, o2 = {};
    ATT_WRITE(kA, vA, 0); if (u.t_lo + 1 < u.t_hi) ATT_WRITE(kB, vB, 1);
    __syncthreads();
    const unsigned koff = (unsigned)(ql * KP + 16 * hi);
    const unsigned voff = (unsigned)(KBUF + (4 * hi + ((lane & 15) >> 2)) * VP + ((lane >> 4) & 1) * 32 + (lane & 3) * 8);
#define ATT_NEED(t) (wactive && !(KIND == 0 && ((t) >> 2) == u.qb && 64 * (t) > u.qidx0 + 32 * wid + 31) && !(KIND == 2 && (64 * (t) > u.qidx0 + 32 * wid + 31 || 64 * (t) + 63 < u.qidx0 + 32 * wid - 128)))
    for (int t = u.t_lo; t < u.t_hi; t += 2) {
        const bool more = (t + 2 < u.t_hi), more2 = (t + 3 < u.t_hi);
        if (more) ATT_LOAD(kA, vA, t + 2);
        if (more2) ATT_LOAD(kB, vB, t + 3);
        if (ATT_NEED(t)) att_tile<KIND>(lds, u, t, wid, qi, hi, koff, voff, sel, qf, m, o0, o1, o2);
        if (t + 1 < u.t_hi) { if (ATT_NEED(t + 1)) att_tile<KIND>(lds + BUF, u, t + 1, wid, qi, hi, koff, voff, sel, qf, m, o0, o1, o2); }
        __syncthreads();
        if (more) { ATT_WRITE(kA, vA, 0); if (more2) ATT_WRITE(kB, vB, 1); __syncthreads(); }
    }
    if (wactive) {
        const float lt = o2[0]; const float inv = 1.0f / lt;
        bf16* orow = u.O + qrow * 1024;
#pragma unroll
        for (int g = 0; g < 4; ++g) {
            unsigned long long w0 = (unsigned long long)pg8::cvt_pk_bf16(o0[4 * g] * inv, o0[4 * g + 1] * inv) | ((unsigned long long)pg8::cvt_pk_bf16(o0[4 * g + 2] * inv, o0[4 * g + 3] * inv) << 32);
            unsigned long long w1 = (unsigned long long)pg8::cvt_pk_bf16(o1[4 * g] * inv, o1[4 * g + 1] * inv) | ((unsigned long long)pg8::cvt_pk_bf16(o1[4 * g + 2] * inv, o1[4 * g + 3] * inv) << 32);
            *(unsigned long long*)(orow + 8 * g + 4 * hi) = w0; *(unsigned long long*)(orow + 32 + 8 * g + 4 * hi) = w1;
        }
        if (KIND == 2) { if (hi == 0) u.lse[(size_t)(32 * wid + ql) * u.lse_stride] = m + __builtin_log2f(lt); }
    }
#undef ATT_LOAD
#undef ATT_WRITE
#undef ATT_NEED
}

constexpr int N_UNITS = 1152;
__device__ __forceinline__ void make_unit(int idx, Unit& u, bf16* ZQ, const bf16* ZKV, const bf16* MKV, const float* KSUM, float* LSE) {
    u.qstride = 1; u.nq = 256; u.kstride = 1; u.qb = 0; u.ksum = nullptr; u.lse = nullptr; u.lse_stride = 0; u.qidx0 = 0;
    int mb = -1, mqb = 0;
    if (idx < 288) { mqb = 7 - idx / 48; mb = idx % 48; }
    else if (idx < 336) { mqb = 1; mb = idx - 288; }
    else if (idx >= 592 && idx < 640) { mqb = 0; mb = idx - 592; }
    if (mb >= 0) {
        const int b = mb / 6, h = mb % 6;
        u.kind = 0; u.Q = ZQ + 384 + h * 64; u.O = ZQ + 384 + h * 64; u.qrow0 = b * SEQ + 256 * mqb;
        u.K = ZKV + 768 + h * 64; u.V = ZKV + 1152 + h * 64; u.kvpitch = 1536; u.krow0 = b * SEQ;
        u.t_lo = 0; u.t_hi = 4 * (mqb + 1); u.qidx0 = 256 * mqb; u.qb = mqb; u.ksum = KSUM + (size_t)(b * 8) * 384 + h * 64;
        return;
    }
    if (idx >= 640 && idx < 896) {
        const int i = idx - 640, bh = i >> 3, blk = i & 7, b = bh >> 2, h = bh & 3;
        u.kind = 1; u.Q = ZQ + 768 + h * 64; u.O = ZQ + 768 + h * 64; u.qrow0 = b * SEQ + 256 * blk;
        u.K = MKV + h * 64; u.V = MKV + 256 + h * 64; u.kvpitch = 512; u.krow0 = b * 256; u.t_lo = 0; u.t_hi = 4;
        return;
    }
    u.kind = 2; u.kvpitch = 1536; u.lse_stride = 6;
    int g, b, h, r, m0, nq;
    if (idx < 464) { const int i = idx - 336; g = 0; b = i >> 4; h = (i >> 3) & 1; r = 0; m0 = 256 * (i & 7); nq = 256; }
    else if (idx < 592) { const int i = idx - 464; g = 1; b = i >> 4; h = (i >> 3) & 1; r = (i >> 1) & 3; m0 = 256 * (i & 1); nq = 256; }
    else { const int i = idx - 896; g = 2; b = i >> 5; h = (i >> 4) & 1; r = i & 15; m0 = 0; nq = 128; }
    const int dil = (g == 0) ? 1 : (g == 1) ? 4 : 16, hc = (2 * g + h) * 64;
    u.Q = ZQ + hc; u.O = ZQ + hc; u.qstride = dil; u.nq = nq; u.qrow0 = b * SEQ + m0 * dil + r;
    u.K = ZKV + hc; u.V = ZKV + 384 + hc; u.krow0 = b * SEQ + r; u.kstride = dil;
    u.t_lo = (m0 >= 128) ? (m0 - 128) / 64 : 0; u.t_hi = (m0 + nq) / 64; u.qidx0 = m0;
    u.lse = LSE + (size_t)u.qrow0 * 6 + (2 * g + h); u.lse_stride = 6 * dil;
}
}
struct Args { const float* in[14]; float* out; unsigned char* ws; int ph_lo, ph_hi, li, pad; };
constexpr int I_INQ = 16 * 80, I_ING = 16 * 96, I_PA = 2 * 32, I_PB = 6 * 32, I_PM = 4 * 32, I_O = 16 * 32, I_MKV = 16 * 16, I_UP = 16 * 128, I_DN = 64 * 32;
constexpr int I_LAYER = I_INQ + I_MKV + I_ING + I_PA + I_PB + I_PM + I_O + I_UP + I_DN, I_EARLY = I_INQ + I_MKV;
__device__ __forceinline__ TrD tr_desc(const float* const* in, unsigned char* ws, int it) {
    const int l = it / I_LAYER; int r = it % I_LAYER;
    unsigned char* wl = ws + WS_W + (size_t)l * W_LAYER; TrD d;
    if (r < I_INQ) { const int kb = r / 80, nb = r % 80; d = TrD{in[3] + (size_t)l * D * DIN, in[2] + l * D, (bf16*)(wl + W_IN), DIN, 1024, 64 * kb, 32 * nb, win_dest_row(32 * nb), 0}; return d; } r -= I_INQ;
    if (r < I_MKV) { const int kb = r / 16, nb = r % 16; d = TrD{in[9] + (size_t)l * D * 512, in[8] + l * D, (bf16*)(wl + W_MKV), 512, 1024, 64 * kb, 32 * nb, 32 * nb, 0}; return d; } r -= I_MKV;
    if (r < I_ING) { const int kb = r / 96, nb = 80 + r % 96; d = TrD{in[3] + (size_t)l * D * DIN, in[2] + l * D, (bf16*)(wl + W_IN), DIN, 1024, 64 * kb, 32 * nb, win_dest_row(32 * nb), 0}; return d; } r -= I_ING;
    if (r < I_PA) { const int kb = r / 32, nb = r % 32; d = TrD{in[4] + (size_t)l * 128 * D, nullptr, (bf16*)(wl + W_P), D, 1024, 64 * kb, 32 * nb, 32 * nb, 0}; return d; } r -= I_PA;
    if (r < I_PB) { const int kb = r / 32, nb = r % 32; d = TrD{in[5] + (size_t)l * 384 * D, nullptr, (bf16*)(wl + W_P), D, 1024, 64 * kb, 32 * nb, 32 * nb, 384}; return d; } r -= I_PB;
    if (r < I_PM) { const int kb = r / 32, nb = r % 32; d = TrD{in[6] + (size_t)l * 256 * D, nullptr, (bf16*)(wl + W_P), D, 1024, 64 * kb, 32 * nb, 32 * nb, 768}; return d; } r -= I_PM;
    if (r < I_O) { const int kb = r / 32, nb = r % 32; d = TrD{in[7] + (size_t)l * D * D, nullptr, (bf16*)(wl + W_O), D, 1024, 64 * kb, 32 * nb, 32 * nb, 0}; return d; } r -= I_O;
    if (r < I_UP) { const int kb = r / 128, nb = r % 128; d = TrD{in[11] + (size_t)l * D * FF, in[10] + l * D, (bf16*)(wl + W_UP), FF, 1024, 64 * kb, 32 * nb, 32 * nb, 0}; return d; } r -= I_UP;
    { const int kb = r / 32, nb = r % 32; d = TrD{in[12] + (size_t)l * FF * D, nullptr, (bf16*)(wl + W_DN), D, 4096, 64 * kb, 32 * nb, 32 * nb, 0}; return d; }
}

namespace pg8 {
struct EpiFinal {
    static constexpr bool PERM = true, AFTER_DRAIN = true;
    __device__ static bool stores16(const Unit&) { return true; }
    const bf16_t* xb; float* ssq; float* out; const float* gain; const XcdBarrier* bar;
    __device__ __forceinline__ void fused(f32x4 (&acc)[2][2][4][2], const Unit& u, int wr, int wc, int, int, PG8_LAS unsigned char* lds, int, int) const {
        int te_ = threadIdx.x; asm volatile("" : "+v"(te_) :: "memory"); const int fr = te_ & 15, fq = (te_ & 63) >> 4;
        PG8_LAS float* P = (PG8_LAS float*)lds;
        const int row0 = u.pm * BM + wr * 64 + fr, col0 = u.pn * BM + wc * 32 + 8 * fq;
        const unsigned o0 = (unsigned)row0 * 1024u + (unsigned)col0;
#pragma unroll
        for (int ai = 0; ai < 2; ++ai) {
            u32x4 bs[4][2];
#pragma unroll
            for (int m = 0; m < 4; ++m)
#pragma unroll
                for (int bj = 0; bj < 2; ++bj) bs[m][bj] = *(const u32x4*)(xb + (o0 + (unsigned)((ai * HALF + m * 16) * 1024 + bj * HALF)));
#pragma unroll
            for (int m = 0; m < 4; ++m) { float sq = 0.f;
#pragma unroll
                for (int bj = 0; bj < 2; ++bj) { float b[8]; unpack8(bs[m][bj], b);
                    acc[ai][bj][m][0] = acc[ai][bj][m][0] + (f32x4){b[0], b[1], b[2], b[3]}; acc[ai][bj][m][1] = acc[ai][bj][m][1] + (f32x4){b[4], b[5], b[6], b[7]};
                    const f32x4 x0 = acc[ai][bj][m][0], x1 = acc[ai][bj][m][1];
                    sq += (x0[0] * x0[0] + x0[1] * x0[1]) + (x0[2] * x0[2] + x0[3] * x0[3]) + (x1[0] * x1[0] + x1[1] * x1[1]) + (x1[2] * x1[2] + x1[3] * x1[3]); }
                sq = xsum16(sq); sq = xsum32(sq);
                if (fq == 0) P[(ai * HALF + wr * 64 + m * 16 + fr) * 4 + wc] = sq; }
        }
        asm volatile("s_waitcnt lgkmcnt(0)" ::: "memory"); __builtin_amdgcn_s_barrier(); asm volatile("" ::: "memory");
        if (te_ < 256) { const f32x4 p = *(PG8_LAS const f32x4*)(P + te_ * 4); ssq[(unsigned)(u.pm * BM + te_) * 4u + (unsigned)u.pn] = (p[0] + p[1]) + (p[2] + p[3]); }
        xcd_barrier(*bar);
        float rs[8]; rstd8(ssq, row0, fq, rs);
#pragma unroll
        for (int bj = 0; bj < 2; ++bj) { const f32x4 g0 = *(const f32x4*)(gain + col0 + bj * HALF), g1 = *(const f32x4*)(gain + col0 + bj * HALF + 4);
#pragma unroll
            for (int ai = 0; ai < 2; ++ai)
#pragma unroll
                for (int m = 0; m < 4; ++m) { const float r = rs[ai * 4 + m]; float* op = out + (o0 + (unsigned)((ai * HALF + m * 16) * 1024 + bj * HALF));
                    *(f32x4*)op = acc[ai][bj][m][0] * r * g0; *(f32x4*)(op + 4) = acc[ai][bj][m][1] * r * g1; } }
    }
};
}
constexpr int N_PHASES = 16;
#ifndef MK_ONE_LAUNCH
#define MK_ONE_LAUNCH 1
#endif
__global__ void __launch_bounds__(NWAVES * 64, 2) mega(Args args) {
    extern __shared__ __attribute__((aligned(16))) unsigned char lds_raw[];
    LAS unsigned char* lds = (LAS unsigned char*)lds_raw;
    volatile LAS unsigned* MISC = (volatile LAS unsigned*)(lds + MISC_OFF);
    const int tid = threadIdx.x, lane = tid & 63, wave = __builtin_amdgcn_readfirstlane(tid >> 6);
    const int G = gridDim.x; const int bx = blockIdx.x; const int vcu = (G % 8 == 0) ? (bx % 8) * (G / 8) + bx / 8 : bx;
    unsigned char* ws = args.ws;
    gu32* ctl = (gu32*)(ws + WS_CTL);
    for (int u = tid; u < (LDS_BYTES - LDSCTL_OFF) / 4; u += NWAVES * 64) ((LAS unsigned*)(lds + LDSCTL_OFF))[u] = 0u;
    __syncthreads();
    XcdBarrier bar; bar.bar = (unsigned*)(ctl + CW_BAR); bar.x = 0; bar.st = nullptr;
    if (MK_ONE_LAUNCH) bar = xcd_barrier_post((unsigned*)(ctl + CW_BAR), MISC + 8);
    const int lo = args.ph_lo, hi = args.ph_hi;
#define IN(k) (lo <= (k) && (k) < hi)
#ifndef MK_PROBE
#define MK_PROBE 0
#endif
#if MK_PROBE
    unsigned long long* const TS = (unsigned long long*)(ws + 512 * 1024);
#define STAMP(k) do { if (blockIdx.x == 0) { __hip_atomic_store(TS + (k), rt(), __ATOMIC_RELAXED, __HIP_MEMORY_SCOPE_AGENT); } } while (0)
#else
#define STAMP(k) do { } while (0)
#endif
#define SEAM(k) do { if (IN(k) && IN((k) + 1)) xcd_barrier(bar); STAMP((k) + 1); } while (0)
    STAMP(0);
    const float* x_in = args.in[0]; const float* mem = args.in[1];
    float* out = args.out;
    float* ROPE = (float*)(ws + WS_ROPE); float* SSQ = (float*)(ws + WS_SSQ); float* LSE = (float*)(ws + WS_LSE);
    bf16* MKV = (bf16*)(ws + WS_MKV); bf16* MEMN = (bf16*)(ws + WS_MEMN); bf16* XB = (bf16*)(ws + WS_XB);
    bf16* ZQ = (bf16*)(ws + WS_ZQ); bf16* ZKV = (bf16*)(ws + WS_ZKV); bf16* ZG = (bf16*)(ws + WS_ZG); bf16* U = (bf16*)(ws + WS_U);
    const int gw = vcu * NWAVES + wave, NGW = G * NWAVES;

    if (IN(0)) {
        LAS float* scr = (LAS float*)(lds + RING_OFF + wave * 16384);
        const float* const* intab = (const float* const*)(ws + WS_PTRS);
        if (tid == 0) { const float** tb = (const float**)(ws + WS_PTRS);
            tb[0] = args.in[0]; tb[1] = args.in[1]; tb[2] = args.in[2]; tb[3] = args.in[3]; tb[4] = args.in[4]; tb[5] = args.in[5]; tb[6] = args.in[6];
            tb[7] = args.in[7]; tb[8] = args.in[8]; tb[9] = args.in[9]; tb[10] = args.in[10]; tb[11] = args.in[11]; tb[12] = args.in[12]; tb[13] = args.in[13]; }
        asm volatile("s_waitcnt vmcnt(0)" ::: "memory"); __syncthreads();
        for (int it = gw; it < I_EARLY; it += 2 * NGW) {
            const bool two = (it + NGW) < I_EARLY;
            const TrD d0 = tr_desc(intab, ws, it), d1 = tr_desc(intab, ws, two ? it + NGW : it);
            f32x4 v0[8], v1[8]; float g0[8], g1[8];
            tr_load(d0, v0, g0, lane); if (two) tr_load(d1, v1, g1, lane);
            tr_fin(d0, v0, g0, scr, lane); if (two) tr_fin(d1, v1, g1, scr, lane);
        }
        for (int it = gw; it < 2 * 1024; it += NGW) { const int l = it >> 10, n = it & 1023; bf16* p = (bf16*)(ws + WS_W + (size_t)l * W_LAYER + W_P) + (size_t)n * 1024 + 128;
            if (lane < 32) ((GAS v4u*)p)[lane] = (v4u){0u, 0u, 0u, 0u}; }
        for (int e = bx * (NWAVES * 64) + tid; e < SEQ * 8; e += G * NWAVES * 64) { const int pos = e >> 3, i = e & 7;
            const float invf = (float)(1.0 / pow(500000.0, (double)i / 8.0)); const float ang = (float)pos * invf;
            const double rev = (double)ang * 0.15915494309189535; const float fr_ = (float)(rev - floor(rev));
            const _Float16 ch = (_Float16)__builtin_amdgcn_cosf(fr_), sh = (_Float16)__builtin_amdgcn_sinf(fr_);
            ((unsigned*)ROPE)[pos * 8 + i] = (unsigned)__builtin_bit_cast(unsigned short, ch) | ((unsigned)__builtin_bit_cast(unsigned short, sh) << 16); }
        for (int m = gw; m < T; m += 2 * NGW) { const int m1 = m + NGW;
            const GAS f32x4* xr = (const GAS f32x4*)(x_in + (size_t)m * D) + lane; const GAS f32x4* xr1 = (const GAS f32x4*)(x_in + (size_t)m1 * D) + lane; f32x4 v[4], w[4]; float s = 0.f, s1 = 0.f;
#pragma unroll
            for (int j = 0; j < 4; ++j) { v[j] = xr[64 * j]; w[j] = xr1[64 * j]; }
#pragma unroll
            for (int j = 0; j < 4; ++j) { s += (v[j].x * v[j].x + v[j].y * v[j].y) + (v[j].z * v[j].z + v[j].w * v[j].w); s1 += (w[j].x * w[j].x + w[j].y * w[j].y) + (w[j].z * w[j].z + w[j].w * w[j].w); }
            s = wave_sum(s); s1 = wave_sum(s1);
            GAS unsigned long long* o8 = (GAS unsigned long long*)(XB + (size_t)m * D) + lane; GAS unsigned long long* o81 = (GAS unsigned long long*)(XB + (size_t)m1 * D) + lane;
#pragma unroll
            for (int j = 0; j < 4; ++j) { o8[64 * j] = (unsigned long long)pk2(v[j].x, v[j].y) | ((unsigned long long)pk2(v[j].z, v[j].w) << 32); o81[64 * j] = (unsigned long long)pk2(w[j].x, w[j].y) | ((unsigned long long)pk2(w[j].z, w[j].w) << 32); }
            if (lane < 4) { SSQ[(size_t)m * 4 + lane] = (lane == 0) ? s : 0.f; SSQ[(size_t)m1 * 4 + lane] = (lane == 0) ? s1 : 0.f; } }
        for (int m = gw; m < NMEMROWS; m += NGW) { const GAS f32x4* xr = (const GAS f32x4*)(mem + (size_t)m * D) + lane; f32x4 v[4]; float s = 0.f;
#pragma unroll
            for (int j = 0; j < 4; ++j) { v[j] = xr[64 * j]; s += (v[j].x * v[j].x + v[j].y * v[j].y) + (v[j].z * v[j].z + v[j].w * v[j].w); }
            const float rstd = 1.0f / sqrtf(wave_sum(s) * (1.0f / 1024.0f) + 1e-6f);
            GAS unsigned long long* o8 = (GAS unsigned long long*)(MEMN + (size_t)m * D) + lane;
#pragma unroll
            for (int j = 0; j < 4; ++j) o8[64 * j] = (unsigned long long)pk2(v[j].x * rstd, v[j].y * rstd) | ((unsigned long long)pk2(v[j].z * rstd, v[j].w * rstd) << 32); }
    }
    SEAM(0);

    for (int l = 0; l < 2; ++l) {
        const int pb = 1 + 7 * l;
        unsigned char* wl = ws + WS_W + (size_t)l * W_LAYER;
        const bf16* WIN_t = (const bf16*)(wl + W_IN); const bf16* WUP_t = (const bf16*)(wl + W_UP); const bf16* WDN_t = (const bf16*)(wl + W_DN);
        const bf16* WO_t = (const bf16*)(wl + W_O); const bf16* WP_t = (const bf16*)(wl + W_P); const bf16* WMKV_t = (const bf16*)(wl + W_MKV);
        float* KSUM = (float*)(ws + WS_KSUM) + (size_t)l * 64 * 6 * 64;
        if (IN(pb + 0)) {
            { pg8::Gemm g{XB, WIN_t, 1024, 1024, 1024, nullptr, nullptr}; pg8::StaticOrder S; S.init(T, NQKV, G, bx);
              pg8::EpiQKV E{ZQ, ZKV, SSQ, (const unsigned*)ROPE, KSUM};
              pg8::gemm_phase<pg8::EpiQKV, pg8::StaticOrder, true, true>(lds + RING_OFF, g, S, E); }
            { pg8::Gemm g{MEMN, WMKV_t, 1024, 1024, 1024, nullptr, nullptr}; pg8::StaticOrder S; S.init(NMEMROWS, 512, G, (bx + 128) % G);
              pg8::EpiPlain E{MKV, 512};
              pg8::gemm_phase<pg8::EpiPlain, pg8::StaticOrder, true, true>(lds + RING_OFF, g, S, E); }
        }
        const int conv0 = (G > 160) ? 144 : 0;
        if (IN(pb + 0) && bx >= conv0) {
            LAS float* scr = (LAS float*)(lds + RING_OFF + wave * 16384);
            int tl_ = threadIdx.x; asm volatile("" : "+v"(tl_)); const int ln = tl_ & 63;
            const int rank = (bx - conv0) * NWAVES + wave, nrank = (G - conv0) * NWAVES; const float* const* intab2 = (const float* const*)(ws + WS_PTRS);
            const int it_lo = (l == 0) ? I_EARLY : I_LAYER + I_EARLY, it_hi = (l == 0) ? I_LAYER + I_EARLY : 2 * I_LAYER;
            for (int it = it_lo + rank; it < it_hi; it += 2 * nrank) {
                const bool two = (it + nrank) < it_hi;
                const TrD d0 = tr_desc(intab2, ws, it), d1 = tr_desc(intab2, ws, two ? it + nrank : it);
                f32x4 v0[8], v1[8]; float g0[8], g1[8];
                tr_load(d0, v0, g0, ln); tr_load(d1, v1, g1, ln);
                tr_fin(d0, v0, g0, scr, ln); if (two) tr_fin(d1, v1, g1, scr, ln);
            }
        }
        SEAM(pb + 0);
        if (IN(pb + 1)) {
            unsigned* qcnt = (unsigned*)(ctl + CW_QUEUE + 64 * l);
            for (;;) {
                if (threadIdx.x == 0) MISC[16] = __hip_atomic_fetch_add(qcnt, 1u, __ATOMIC_RELAXED, __HIP_MEMORY_SCOPE_AGENT);
                __syncthreads();
                const int idx = (int)MISC[16];
                if (idx >= att::N_UNITS) break;
                att::Unit au; att::make_unit(idx, au, ZQ, ZKV, MKV, KSUM, LSE);
                if (au.kind == 0) att::run_unit<0>(lds + RING_OFF, au); else if (au.kind == 1) att::run_unit<1>(lds + RING_OFF, au); else att::run_unit<2>(lds + RING_OFF, au);
            }
        }
        SEAM(pb + 1);
        if (IN(pb + 2)) {
            { int tl_ = threadIdx.x; asm volatile("" : "+v"(tl_)); const int ln = tl_ & 63, h = ln >> 5, c = 2 * (ln & 31);
              for (int row = gw; row < T; row += NGW) {
                const float l0 = LSE[(size_t)row * 6 + h], l1 = LSE[(size_t)row * 6 + 2 + h], l2 = LSE[(size_t)row * 6 + 4 + h];
                bf16* zr = ZQ + (size_t)row * 1024;
                const unsigned a0 = *(const GAS unsigned*)(zr + h * 64 + c), a1 = *(const GAS unsigned*)(zr + (2 + h) * 64 + c), a2 = *(const GAS unsigned*)(zr + (4 + h) * 64 + c);
                const float mx = fmaxf(l0, fmaxf(l1, l2));
                float w0 = __builtin_amdgcn_exp2f(l0 - mx), w1 = __builtin_amdgcn_exp2f(l1 - mx), w2 = __builtin_amdgcn_exp2f(l2 - mx);
                const float inv = 1.0f / (w0 + w1 + w2); w0 *= inv; w1 *= inv; w2 *= inv;
                const float lo = w0 * __uint_as_float(a0 << 16) + w1 * __uint_as_float(a1 << 16) + w2 * __uint_as_float(a2 << 16);
                const float hi_ = w0 * __uint_as_float(a0 & 0xffff0000u) + w1 * __uint_as_float(a1 & 0xffff0000u) + w2 * __uint_as_float(a2 & 0xffff0000u);
                const unsigned res = pk2(lo, hi_);
                asm volatile("s_waitcnt vmcnt(0)" ::: "memory");
                *(GAS unsigned*)(zr + h * 64 + c) = res; *(GAS unsigned*)(zr + 128 + 2 * ln) = 0u;
              } }
        }
        SEAM(pb + 2);
        if (IN(pb + 3)) {
            pg8::GateProjOrder S; S.init(T, D, G, bx);
            pg8::Gemm g{XB, WIN_t + (size_t)NQKV * 1024, 1024, 1024, 1024, ZQ, WP_t}; pg8::EpiGateProj E{ZG, SSQ};
            pg8::gemm_phase<pg8::EpiGateProj, pg8::GateProjOrder, true, true>(lds + RING_OFF, g, S, E);
        }
        SEAM(pb + 3);
        if (IN(pb + 4)) {
            pg8::Gemm g{ZG, WO_t, 3072, 1024, 1024, nullptr, nullptr}; pg8::StaticOrder S; S.init(T, D, G, bx);
            pg8::EpiRes E{XB, SSQ};
            pg8::gemm_phase<pg8::EpiRes, pg8::StaticOrder, false, true>(lds + RING_OFF, g, S, E);
        }
        SEAM(pb + 4);
        if (IN(pb + 5)) {
            pg8::Gemm g{XB, WUP_t, 1024, 1024, 1024, nullptr, nullptr}; pg8::StaticOrder S; S.init(T, FF, G, bx);
            pg8::EpiUp E{U, SSQ};
            pg8::gemm_phase<pg8::EpiUp, pg8::StaticOrder, true, true>(lds + RING_OFF, g, S, E);
        }
        SEAM(pb + 5);
        if (IN(pb + 6)) {
            pg8::Gemm g{U, WDN_t, 4096, 4096, 4096, nullptr, nullptr}; pg8::StaticOrder S; S.init(T, D, G, bx);
            if (l == 0) { pg8::EpiRes E{XB, SSQ}; pg8::gemm_phase<pg8::EpiRes, pg8::StaticOrder, false, true>(lds + RING_OFF, g, S, E); }
            else { pg8::EpiFinal E{XB, SSQ, out, args.in[13], &bar}; pg8::gemm_phase<pg8::EpiFinal, pg8::StaticOrder, false, true>(lds + RING_OFF, g, S, E); }
        }
#if MK_PROBE
        SEAM(pb + 6);
#else
        if (l == 0) SEAM(pb + 6);
#endif
    }
#if MK_PROBE
    if (IN(15)) {
        int tl_ = threadIdx.x; asm volatile("" : "+v"(tl_)); const int lane = tl_ & 63;
        const float pbv = (float)(__hip_atomic_load(TS + PROBE_B_HI, __ATOMIC_RELAXED, __HIP_MEMORY_SCOPE_AGENT) - __hip_atomic_load(TS + PROBE_B_LO, __ATOMIC_RELAXED, __HIP_MEMORY_SCOPE_AGENT)) * (PROBE_SCALE * 0.1f);
        for (int m = gw; m < T; m += NGW) { GAS f32x4* xr = (GAS f32x4*)(out + (size_t)m * D) + lane;
#pragma unroll
            for (int j = 0; j < 4; ++j) { f32x4 v = xr[64 * j]; v = v + pbv; xr[64 * j] = v; } }
        if (blockIdx.x == 0) { asm volatile("s_waitcnt vmcnt(0)" ::: "memory"); __syncthreads();
            const float pa = (float)(__hip_atomic_load(TS + PROBE_A_HI, __ATOMIC_RELAXED, __HIP_MEMORY_SCOPE_AGENT) - __hip_atomic_load(TS + PROBE_A_LO, __ATOMIC_RELAXED, __HIP_MEMORY_SCOPE_AGENT)) * PROBE_SCALE;
            if (threadIdx.x == 0) out[0] += pa; }
    }
#endif
#undef IN
#undef SEAM
}

extern "C" void kernel_launch(void* const* d_in, const int* in_sizes, int n_in, void* d_out, int out_size, void* d_ws, size_t ws_size, hipStream_t stream) {
    static int grid = 0;
    if (grid == 0) {
        if (n_in != 14 || in_sizes[0] != T * D || out_size != T * D || ws_size < WS_END) { fprintf(stderr, "kernel_launch: unexpected shapes (n_in %d, in0 %d, out %d, ws %zu)\n", n_in, n_in > 0 ? in_sizes[0] : -1, out_size, ws_size); grid = -1; return; }
        int dev = 0, cus = 0;
        if (hipGetDevice(&dev) != hipSuccess || hipDeviceGetAttribute(&cus, hipDeviceAttributeMultiprocessorCount, dev) != hipSuccess) { grid = -1; return; }
        if (hipFuncSetAttribute((const void*)mega, hipFuncAttributeMaxDynamicSharedMemorySize, LDS_BYTES) != hipSuccess) { fprintf(stderr, "kernel_launch: hipFuncSetAttribute failed\n"); grid = -1; return; }
        int per_cu = 0;
        (void)hipOccupancyMaxActiveBlocksPerMultiprocessor(&per_cu, (const void*)mega, NWAVES * 64, LDS_BYTES);
        (void)hipGetLastError();
        grid = cus;
    }
    if (grid < 0) return;
    (void)hipMemsetAsync((char*)d_ws + WS_CTL, 0, CTL_ZERO_BYTES, stream);
    Args a{};
    for (int i = 0; i < 14; ++i) a.in[i] = (const float*)d_in[i];
    a.out = (float*)d_out; a.ws = (unsigned char*)d_ws; a.li = 0; a.pad = 0;
#if MK_ONE_LAUNCH
    a.ph_lo = 0; a.ph_hi = N_PHASES;
    hipLaunchKernelGGL(mega, dim3(grid), dim3(NWAVES * 64), LDS_BYTES, stream, a);
#else
    for (int ph = 0; ph < N_PHASES; ++ph) {
        a.ph_lo = ph; a.ph_hi = ph + 1;
        hipLaunchKernelGGL(mega, dim3(grid), dim3(NWAVES * 64), LDS_BYTES, stream, a);
    }
#endif
}
```

```cpp
#include <hip/hip_runtime.h>
#include <cstdio>
#include <cstdint>
namespace pg8 {
#define PG8_LAS __attribute__((address_space(3)))
typedef unsigned short bf16_t;
typedef short bf16x8 __attribute__((ext_vector_type(8)));
typedef float f32x4 __attribute__((ext_vector_type(4)));
typedef unsigned u32x4 __attribute__((ext_vector_type(4)));
constexpr int BM = 256, BK = 64, HALF = 128, HTB = HALF * BK * 2  , STAGE_BYTES = 8 * HTB, NXCD = 8, WGM = 4;

__host__ __device__ __forceinline__ int lds_byte(int r, int c) { const int st = (r >> 4) * 2 + (c >> 5), rr = r & 15, cc = c & 31, ob = rr * 64 + cc * 2; return st * 1024 + (ob ^ (((ob >> 9) & 1) << 5)); }
__host__ __device__ __forceinline__ void stage_rc(int b, int& R, int& C) { const int st = b / 1024, sb = b % 1024, swz = sb ^ (((sb >> 9) & 1) << 5); R = (st >> 1) * 16 + swz / 64; C = (st & 1) * 32 + (swz % 64) / 2; }
__host__ __device__ __forceinline__ int perm32(int rho) { const int n = rho >> 4, i = rho & 15; return 8 * (i >> 2) + 4 * n + (i & 3); }

struct Unit { int pm, pn, k0, nt, br, pb, sel; };
struct Gemm { const bf16_t* A; const bf16_t* Bt; int lda, ldb, K; const bf16_t* A2; const bf16_t* Bt2; };

struct StaticOrder {
    static constexpr bool KSEG = false;
    __host__ __device__ static bool carry(const Unit&) { return false; }
    int nM, nN, nwg, G, c;
    __host__ __device__ void init(int M, int N, int G_, int c_) { nM = M / BM; nN = N / BM; nwg = nM * nN; G = G_; c = c_; }
    __host__ __device__ bool next(int i, Unit& u) const {
        const long L = (long)i * G + c; if (L >= nwg) return false;
        int wgid = (int)L; { const int q = nwg / NXCD, r = nwg % NXCD, xcd = wgid % NXCD, off = wgid / NXCD; wgid = (xcd < r ? xcd * (q + 1) : r * (q + 1) + (xcd - r) * q) + off; }
        const int nig = WGM * nN, gid = wgid / nig, fm = gid * WGM, gsz = (nM - fm) < WGM ? (nM - fm) : WGM;
        u.pm = fm + ((wgid % nig) % gsz); u.pn = (wgid % nig) / gsz; u.k0 = 0; u.nt = 0; u.br = 0; u.pb = u.pn; u.sel = 0; return true;
    }
    __device__ __forceinline__ void a_ready(const Unit&) const {}
    __device__ __forceinline__ void done(const Unit&) const {}
};

typedef float f32x2c_t __attribute__((ext_vector_type(2))); typedef __bf16 bf16x2c_t __attribute__((ext_vector_type(2)));
__device__ __forceinline__ unsigned cvt_pk_bf16(float lo, float hi) { const f32x2c_t v = {lo, hi}; const bf16x2c_t b = __builtin_convertvector(v, bf16x2c_t); return __builtin_bit_cast(unsigned, b); }
typedef float f32x2 __attribute__((ext_vector_type(2)));
template <class Epi, class Sched, bool ALIGN_EPI = false, bool SP2 = false>
__device__ __forceinline__ void gemm_phase(PG8_LAS unsigned char* lds, const Gemm g, const Sched& S, const Epi& E) {
    int tid_ = threadIdx.x; asm volatile("" : "+v"(tid_));
    const int tid = tid_, wid = __builtin_amdgcn_readfirstlane(tid >> 6), lane = tid & 63, wr = wid >> 2, wc = wid & 3, fr = lane & 15, fq = lane >> 4;
    const int K = g.K; int nt = K / BK;
    unsigned voffA[2], voffB[2];
#pragma unroll
    for (int i = 0; i < 2; ++i) { int R, C; stage_rc(tid * 16 + i * 8192, R, C); const int Rb = Epi::PERM ? ((R & ~31) + perm32(R & 31)) : R;
        voffA[i] = (unsigned)(R * g.lda + C) * 2u; voffB[i] = (unsigned)(Rb * g.ldb + C) * 2u; }
    const size_t kstep = (size_t)(BK * 2);
    const size_t hstepA = (size_t)HALF * g.lda * 2, hstepB = (size_t)HALF * g.ldb * 2;
    const size_t tstepA = 2 * hstepA, tstepB = 2 * hstepB;
    const unsigned ldsw = (unsigned)wid * 1024u;
    const int aoff = lds_byte(wr * 64 + fr, fq * 8), boff = lds_byte(wc * 32 + fr, fq * 8);
#define PG8_SA(b, h) (((b) * 2 + (h)) * HTB)
#define PG8_SB(b, h) ((4 + (b) * 2 + (h)) * HTB)
#define PG8_STAGE(bufoff, gbase, voff) do { _Pragma("unroll") for (int _i = 0; _i < 2; ++_i) \
        __builtin_amdgcn_global_load_lds((const unsigned*)((const char*)(gbase) + (voff)[_i]), (PG8_LAS unsigned*)(lds + (bufoff) + ldsw + _i * 8192), 16, 0, 0); } while (0)
#define PG8_LDA(dst, b, h) do { _Pragma("unroll") for (int m = 0; m < 4; ++m) _Pragma("unroll") for (int k = 0; k < 2; ++k) dst[m][k] = *(const PG8_LAS bf16x8*)(lds + PG8_SA(b, h) + aoff + m * 2048 + k * 1024); } while (0)
#define PG8_LDB(dst, b, h) do { _Pragma("unroll") for (int n = 0; n < 2; ++n) _Pragma("unroll") for (int k = 0; k < 2; ++k) dst[n][k] = *(const PG8_LAS bf16x8*)(lds + PG8_SB(b, h) + boff + n * 2048 + k * 1024); } while (0)
#define PG8_MMA(ai, bj, At, Bt) do { __builtin_amdgcn_s_setprio(1); _Pragma("unroll") for (int m = 0; m < 4; ++m) _Pragma("unroll") for (int n = 0; n < 2; ++n) _Pragma("unroll") for (int k = 0; k < 2; ++k) \
        acc[ai][bj][m][n] = __builtin_amdgcn_mfma_f32_16x16x32_bf16(Bt[n][k], At[m][k], acc[ai][bj][m][n], 0, 0, 0); __builtin_amdgcn_s_setprio(0); } while (0)
#define PG8_WAIT_V(n) asm volatile("s_waitcnt vmcnt(" #n ")" ::: "memory")
#define PG8_WAIT_L(n) asm volatile("s_waitcnt lgkmcnt(" #n ")" ::: "memory")
#define PG8_BAR __builtin_amdgcn_s_barrier()
#define PG8_SCHED __builtin_amdgcn_sched_barrier(0)
    Unit cur, nxt; int ui = 0;
    if (!S.next(0, cur)) return;
    f32x4 acc[2][2][4][2];
#pragma unroll
    for (int a = 0; a < 2; ++a)
#pragma unroll
        for (int b = 0; b < 2; ++b)
#pragma unroll
            for (int m = 0; m < 4; ++m)
#pragma unroll
                for (int n = 0; n < 2; ++n) acc[a][b][m][n] = (f32x4){0.f, 0.f, 0.f, 0.f};
    bf16x8 At[4][2], B0[2][2], B1[2][2];
    if constexpr (Sched::KSEG) nt = cur.nt;
    const char* cA = (const char*)((Sched::KSEG && cur.sel) ? g.A2 : g.A) + (size_t)cur.pm * tstepA + (Sched::KSEG ? (size_t)cur.k0 * 2 : 0); const char* cB = (const char*)((Sched::KSEG && cur.sel) ? g.Bt2 : g.Bt) + (size_t)cur.pb * tstepB + (Sched::KSEG ? (size_t)cur.k0 * 2 : 0);
    S.a_ready(cur);
    if constexpr (SP2) {
        PG8_STAGE(PG8_SB(0, 0), cB, voffB); PG8_STAGE(PG8_SB(0, 1), cB + hstepB, voffB); PG8_STAGE(PG8_SA(0, 0), cA, voffA); PG8_STAGE(PG8_SA(0, 1), cA + hstepA, voffA);
        if (wr == 1) PG8_BAR;
        PG8_WAIT_V(2); PG8_BAR;
        PG8_STAGE(PG8_SB(1, 0), cB + kstep, voffB); PG8_STAGE(PG8_SA(1, 0), cA + kstep, voffA); PG8_STAGE(PG8_SB(1, 1), cB + hstepB + kstep, voffB);
        PG8_WAIT_V(6); PG8_BAR;
    } else {
        PG8_STAGE(PG8_SB(0, 0), cB, voffB); PG8_STAGE(PG8_SA(0, 0), cA, voffA); PG8_STAGE(PG8_SB(0, 1), cB + hstepB, voffB); PG8_STAGE(PG8_SA(0, 1), cA + hstepA, voffA);
        if (wr == 1) PG8_BAR;
        PG8_WAIT_V(4); PG8_BAR;
        PG8_STAGE(PG8_SB(1, 0), cB + kstep, voffB); PG8_STAGE(PG8_SA(1, 0), cA + kstep, voffA); PG8_STAGE(PG8_SB(1, 1), cB + hstepB + kstep, voffB);
        PG8_WAIT_V(6); PG8_BAR;
    }
    for (;;) {
        const bool has_next = S.next(ui + 1, nxt);
        const char* nA = has_next ? (const char*)((Sched::KSEG && nxt.sel) ? g.A2 : g.A) + (size_t)nxt.pm * tstepA + (Sched::KSEG ? (size_t)nxt.k0 * 2 : 0) : cA; const char* nB = has_next ? (const char*)((Sched::KSEG && nxt.sel) ? g.Bt2 : g.Bt) + (size_t)nxt.pb * tstepB + (Sched::KSEG ? (size_t)nxt.k0 * 2 : 0) : cB;
        for (int t = 0; t < nt; t += 2) {
            const bool last = (t == nt - 2);
            const char* a1 = cA + (size_t)(t + 1) * kstep;
            const char* a2 = last ? nA : cA + (size_t)(t + 2) * kstep; const char* b2 = last ? nB : cB + (size_t)(t + 2) * kstep;
            const char* a3 = a2 + kstep; const char* b3 = b2 + kstep;
            if (last && has_next) S.a_ready(nxt);
            if constexpr (SP2) {
            PG8_LDB(B0, 0, 0); PG8_LDB(B1, 0, 1); PG8_SCHED; PG8_LDA(At, 0, 0); PG8_STAGE(PG8_SA(1, 1), a1 + hstepA, voffA);
            PG8_WAIT_V(8); PG8_WAIT_L(0); PG8_BAR; PG8_MMA(0, 0, At, B0); PG8_MMA(0, 1, At, B1); PG8_BAR; PG8_SCHED;
            PG8_LDA(At, 0, 1); PG8_STAGE(PG8_SB(0, 0), b2, voffB); PG8_STAGE(PG8_SB(0, 1), b2 + hstepB, voffB); PG8_STAGE(PG8_SA(0, 0), a2, voffA);
            PG8_WAIT_V(8); PG8_WAIT_L(0); PG8_BAR; PG8_MMA(1, 0, At, B0); PG8_MMA(1, 1, At, B1); PG8_BAR; PG8_SCHED;
            PG8_LDB(B0, 1, 0); PG8_LDB(B1, 1, 1); PG8_SCHED; PG8_LDA(At, 1, 0); PG8_STAGE(PG8_SA(0, 1), a2 + hstepA, voffA);
            PG8_WAIT_V(8); PG8_WAIT_L(0); PG8_BAR; PG8_MMA(0, 0, At, B0); PG8_MMA(0, 1, At, B1); PG8_BAR; PG8_SCHED;
            PG8_LDA(At, 1, 1); PG8_STAGE(PG8_SB(1, 0), b3, voffB); PG8_STAGE(PG8_SB(1, 1), b3 + hstepB, voffB); PG8_STAGE(PG8_SA(1, 0), a3, voffA);
            PG8_WAIT_V(8); PG8_WAIT_L(0); PG8_BAR; PG8_MMA(1, 0, At, B0); PG8_MMA(1, 1, At, B1); PG8_BAR; PG8_SCHED;
            } else {
            PG8_LDB(B0, 0, 0); PG8_SCHED; PG8_LDA(At, 0, 0); PG8_STAGE(PG8_SA(1, 1), a1 + hstepA, voffA);
            PG8_WAIT_L(8); PG8_BAR; PG8_WAIT_L(0); PG8_MMA(0, 0, At, B0); PG8_BAR; PG8_SCHED;
            PG8_LDB(B1, 0, 1); PG8_STAGE(PG8_SB(0, 0), b2, voffB);
            PG8_BAR; PG8_WAIT_L(0); PG8_MMA(0, 1, At, B1); PG8_BAR;
            PG8_LDA(At, 0, 1); PG8_STAGE(PG8_SA(0, 0), a2, voffA);
            PG8_BAR; PG8_WAIT_L(0); PG8_MMA(1, 0, At, B0); PG8_BAR; PG8_SCHED;
            PG8_STAGE(PG8_SB(0, 1), b2 + hstepB, voffB);
            PG8_WAIT_V(6); PG8_BAR; PG8_MMA(1, 1, At, B1); PG8_BAR;
            PG8_LDB(B0, 1, 0); PG8_SCHED; PG8_LDA(At, 1, 0); PG8_STAGE(PG8_SA(0, 1), a2 + hstepA, voffA);
            PG8_WAIT_L(8); PG8_BAR; PG8_WAIT_L(0); PG8_MMA(0, 0, At, B0); PG8_BAR; PG8_SCHED;
            PG8_LDB(B1, 1, 1); PG8_STAGE(PG8_SB(1, 0), b3, voffB);
            PG8_BAR; PG8_WAIT_L(0); PG8_MMA(0, 1, At, B1); PG8_BAR;
            PG8_LDA(At, 1, 1); PG8_STAGE(PG8_SA(1, 0), a3, voffA);
            PG8_BAR; PG8_WAIT_L(0); PG8_MMA(1, 0, At, B0); PG8_BAR; PG8_SCHED;
            PG8_STAGE(PG8_SB(1, 1), b3 + hstepB, voffB);
            PG8_WAIT_V(6); PG8_BAR; PG8_MMA(1, 1, At, B1); PG8_BAR;
            }
        }
        if constexpr (ALIGN_EPI) { if (wr == 0) PG8_BAR; }
        if constexpr (!Epi::AFTER_DRAIN) { int te_ = threadIdx.x; asm volatile("" : "+v"(te_) :: "memory");     E(acc, cur, wr, wc, te_ & 15, (te_ & 63) >> 4); S.done(cur); }
        if (!has_next) break;
        if (!Sched::carry(cur)) {
#pragma unroll
        for (int a = 0; a < 2; ++a)
#pragma unroll
            for (int b = 0; b < 2; ++b)
#pragma unroll
                for (int m = 0; m < 4; ++m)
#pragma unroll
                    for (int n = 0; n < 2; ++n) acc[a][b][m][n] = (f32x4){0.f, 0.f, 0.f, 0.f};
        }
        cur = nxt; cA = nA; cB = nB; ++ui; if constexpr (Sched::KSEG) nt = cur.nt;
        if constexpr (ALIGN_EPI) { if (wr == 1) PG8_BAR; }
    }
    PG8_WAIT_V(0);
    if constexpr (!ALIGN_EPI) { if (wr == 0) PG8_BAR; }
    PG8_BAR;
    if constexpr (Epi::AFTER_DRAIN) { E.fused(acc, cur, wr, wc, fr, fq, lds, wid, lane); S.done(cur); }
#undef PG8_SA
#undef PG8_SB
#undef PG8_STAGE
#undef PG8_LDA
#undef PG8_LDB
#undef PG8_MMA
#undef PG8_WAIT_V
#undef PG8_WAIT_L
#undef PG8_BAR
#undef PG8_SCHED
}
}
namespace pg8 {
__device__ __forceinline__ float row_rstd(const float* ssq, int row) {
    const f32x4 a = *(const f32x4*)(ssq + (size_t)row * 4);
    return 1.0f / sqrtf(((a[0] + a[1]) + (a[2] + a[3])) * (1.0f / 1024.0f) + 1e-6f);
}
__device__ __forceinline__ void rstd8(const float* ssq, int row0, int, float (&rs)[8]) {
    f32x4 q[8];
#pragma unroll
    for (int i = 0; i < 8; ++i) q[i] = *(const f32x4*)(ssq + (size_t)(row0 + (i >> 2) * HALF + (i & 3) * 16) * 4);
#pragma unroll
    for (int i = 0; i < 8; ++i) { const float t = (q[i][0] + q[i][1]) + (q[i][2] + q[i][3]); rs[i] = __builtin_amdgcn_rsqf(t * (1.0f / 1024.0f) + 1e-6f); }
}
__device__ __forceinline__ float xsum32(float v) { const auto r = __builtin_amdgcn_permlane32_swap(__float_as_uint(v), __float_as_uint(v), false, false); return __uint_as_float(r[0]) + __uint_as_float(r[1]); }
__device__ __forceinline__ float xsum16(float v) { const auto r = __builtin_amdgcn_permlane16_swap(__float_as_uint(v), __float_as_uint(v), false, false); return __uint_as_float(r[0]) + __uint_as_float(r[1]); }
__device__ __forceinline__ float xmax32(float v) { const auto r = __builtin_amdgcn_permlane32_swap(__float_as_uint(v), __float_as_uint(v), false, false); return __builtin_fmaxf(__uint_as_float(r[0]), __uint_as_float(r[1])); }
__device__ __forceinline__ float partner16(float v, bool odd16) { const auto r = __builtin_amdgcn_permlane16_swap(__float_as_uint(v), __float_as_uint(v), false, false); return __uint_as_float(odd16 ? r[0] : r[1]); }
__device__ __forceinline__ void store_wt(void* p, u32x4 v) { asm volatile("global_store_dwordx4 %0, %1, off sc1\n\ts_nop 1" :: "v"(p), "v"(v) : "memory"); }
__device__ __forceinline__ u32x4 pack8(const float (&v)[8]) { u32x4 w; w.x = cvt_pk_bf16(v[0], v[1]); w.y = cvt_pk_bf16(v[2], v[3]); w.z = cvt_pk_bf16(v[4], v[5]); w.w = cvt_pk_bf16(v[6], v[7]); return w; }
__device__ __forceinline__ void unpack8(const u32x4 w, float (&v)[8]) {
    v[0] = __uint_as_float(w.x << 16); v[1] = __uint_as_float(w.x & 0xffff0000u); v[2] = __uint_as_float(w.y << 16); v[3] = __uint_as_float(w.y & 0xffff0000u);
    v[4] = __uint_as_float(w.z << 16); v[5] = __uint_as_float(w.z & 0xffff0000u); v[6] = __uint_as_float(w.w << 16); v[7] = __uint_as_float(w.w & 0xffff0000u);
}
#define PG8_V8(v, a, b, sc) do { v[0] = a[0] * (sc); v[1] = a[1] * (sc); v[2] = a[2] * (sc); v[3] = a[3] * (sc); v[4] = b[0] * (sc); v[5] = b[1] * (sc); v[6] = b[2] * (sc); v[7] = b[3] * (sc); } while (0)

struct EpiQKV {
    static constexpr bool PERM = true, AFTER_DRAIN = false;
    bf16_t* ZQ; bf16_t* ZKV; const float* ssq; const unsigned* rope; float* ksum;
    template <int NB, bool KSUM> __device__ __forceinline__ void body(const f32x4 (&acc)[2][2][4][2], const Unit& u, int wr, int wc, int fr, int fq) const {
        const int row0 = u.pm * BM + wr * 64 + fr, colt = u.pn * BM;
        bf16_t* base; int ldc, cb;
        if (colt < 1024) { base = ZQ; ldc = 1024; cb = colt; } else { base = ZKV; ldc = 1536; cb = colt - 1024; }
        const int hg0 = (colt + wc * 32) >> 6;
        const bool half0 = (wc & 1) == 0;
        const bool rope0 = (hg0 < 12) || (hg0 >= 16 && hg0 < 22) || (hg0 >= 28 && hg0 < 34), rope1 = (hg0 + 2 < 12) || (hg0 + 2 >= 16 && hg0 + 2 < 22) || (hg0 + 2 >= 28 && hg0 + 2 < 34);
        const bool anyrope = half0 && (rope0 || rope1);
        float rs[8]; rstd8(ssq, row0, fq, rs);
        asm volatile("" ::: "memory");
        float ks[2][8];
        if (KSUM) {
#pragma unroll
            for (int bj = 0; bj < 2; ++bj)
#pragma unroll
                for (int j = 0; j < 8; ++j) ks[bj][j] = 0.f; }
#pragma unroll
        for (int rb = 0; rb < 8; rb += NB) {
            u32x4 rt[NB][2];
            if (anyrope) {
#pragma unroll
                for (int i = 0; i < NB; ++i) { const int ri = rb + i; const u32x4* rp = (const u32x4*)(rope + (size_t)((row0 + (ri >> 2) * HALF + (ri & 3) * 16) & 2047) * 8);
                    rt[i][0] = rp[0]; rt[i][1] = rp[1]; } }
#pragma unroll
            for (int i = 0; i < NB; ++i) {
                const int ri = rb + i, ai = ri >> 2, m = ri & 3;
                const int row = row0 + ai * HALF + m * 16;
                const float rstd = rs[ri];
#pragma unroll
                for (int bj = 0; bj < 2; ++bj) {
                    const int hg = hg0 + 2 * bj;
                    const bool isrope = bj == 0 ? rope0 : rope1;
                    float v[8]; PG8_V8(v, acc[ai][bj][m][0], acc[ai][bj][m][1], rstd);
                    if (isrope && half0) {
                        float p[8];
#pragma unroll
                        for (int j = 0; j < 8; ++j) p[j] = partner16(v[j], (fq & 1) != 0);
                        if (fq < 2) { const float sg = (fq == 0) ? -1.f : 1.f;
#pragma unroll
                            for (int j = 0; j < 8; ++j) { const unsigned w = rt[i][j >> 2][j & 3]; const float cs = (float)__builtin_bit_cast(_Float16, (unsigned short)(w & 0xffffu)), sn = (float)__builtin_bit_cast(_Float16, (unsigned short)(w >> 16));
                                v[j] = v[j] * cs + sg * (p[j] * sn); } }
                    }
                    if (hg < 16) {
#pragma unroll
                        for (int j = 0; j < 8; ++j) v[j] *= 0.18033688011112042f; }
                    *(u32x4*)(base + ((unsigned)row * (unsigned)ldc + (unsigned)(cb + bj * HALF + wc * 32 + 8 * fq))) = pack8(v);
                    if (KSUM) { if (hg >= 28 && hg < 34) {
#pragma unroll
                        for (int j = 0; j < 8; ++j) ks[bj][j] += v[j]; } }
                }
            }
        }
        if (KSUM) {
#pragma unroll
            for (int bj = 0; bj < 2; ++bj) { const int hg = hg0 + 2 * bj;
                if (hg >= 28 && hg < 34) {
                    float* kp = ksum + (size_t)(u.pm * 6 + (hg - 28)) * 64 + (wc & 1) * 32 + 8 * fq;
#pragma unroll
                    for (int j = 0; j < 8; ++j) { float s = ks[bj][j]; s += __shfl_xor(s, 1); s += __shfl_xor(s, 2); s += __shfl_xor(s, 4); s += __shfl_xor(s, 8);
                        if (fr == 0) atomicAdd(kp + j, s); }
                } }
        }
    }
    __device__ __forceinline__ void operator()(const f32x4 (&acc)[2][2][4][2], const Unit& u, int wr, int wc, int fr, int fq) const {
        if (u.pn == 7 || u.pn == 8) body<4, true>(acc, u, wr, wc, fr, fq); else body<4, false>(acc, u, wr, wc, fr, fq);
    }
};
struct EpiGate {
    static constexpr bool PERM = true, AFTER_DRAIN = false;
    bf16_t* ZG; const float* ssq;
    __device__ __forceinline__ void operator()(const f32x4 (&acc)[2][2][4][2], const Unit& u, int wr, int wc, int fr, int fq) const {
        const int row0 = u.pm * BM + wr * 64 + fr, col0 = u.pn * BM + wc * 32 + 8 * fq;
        float rs[8]; rstd8(ssq, row0, fq, rs);
#pragma unroll
        for (int ai = 0; ai < 2; ++ai)
#pragma unroll
            for (int m = 0; m < 4; ++m) { const int row = row0 + ai * HALF + m * 16; const float rstd = rs[ai * 4 + m];
#pragma unroll
                for (int bj = 0; bj < 2; ++bj) { float v[8]; PG8_V8(v, acc[ai][bj][m][0], acc[ai][bj][m][1], rstd);
#pragma unroll
                    for (int j = 0; j < 8; ++j) v[j] = __builtin_amdgcn_rcpf(1.0f + __builtin_amdgcn_exp2f(v[j] * -1.4426950408889634f));
                    *(u32x4*)(ZG + (size_t)row * 3072 + col0 + bj * HALF) = pack8(v); } }
    }
};
struct EpiPlain {
    static constexpr bool PERM = true, AFTER_DRAIN = false;
    bf16_t* O; int ldc;
    __device__ __forceinline__ void operator()(const f32x4 (&acc)[2][2][4][2], const Unit& u, int wr, int wc, int fr, int fq) const {
        const int row0 = u.pm * BM + wr * 64 + fr, col0 = u.pn * BM + wc * 32 + 8 * fq;
#pragma unroll
        for (int ai = 0; ai < 2; ++ai)
#pragma unroll
            for (int m = 0; m < 4; ++m) { const int row = row0 + ai * HALF + m * 16;
#pragma unroll
                for (int bj = 0; bj < 2; ++bj) { float v[8]; PG8_V8(v, acc[ai][bj][m][0], acc[ai][bj][m][1], 1.0f);
                    *(u32x4*)(O + (size_t)row * ldc + col0 + bj * HALF) = pack8(v); } }
    }
};
template <int BR> struct EpiProj {
    static constexpr bool PERM = true, AFTER_DRAIN = false;
    bf16_t* ZG;
    __device__ __forceinline__ void operator()(const f32x4 (&acc)[2][2][4][2], const Unit& u, int wr, int wc, int fr, int fq) const {
        const int row0 = u.pm * BM + wr * 64 + fr, col0 = u.pn * BM + wc * 32 + 8 * fq;
#pragma unroll
        for (int ai = 0; ai < 2; ++ai)
#pragma unroll
            for (int m = 0; m < 4; ++m) { const int row = row0 + ai * HALF + m * 16;
#pragma unroll
                for (int bj = 0; bj < 2; ++bj) { bf16_t* yp = ZG + (size_t)row * 3072 + col0 + bj * HALF;
                    float g[8], v[8]; unpack8(*(const u32x4*)(yp + BR * 1024), g); PG8_V8(v, acc[ai][bj][m][0], acc[ai][bj][m][1], 1.0f);
                    if (BR > 0) { float y[8]; unpack8(*(const u32x4*)yp, y);
#pragma unroll
                        for (int j = 0; j < 8; ++j) v[j] = y[j] + g[j] * v[j]; }
                    else {
#pragma unroll
                        for (int j = 0; j < 8; ++j) v[j] = g[j] * v[j]; }
                    *(u32x4*)yp = pack8(v); } }
    }
};
struct GateProjOrder : StaticOrder {
    static constexpr bool KSEG = true;
    __host__ __device__ static bool carry(const Unit& u) { return u.br == 3 || u.br == 4; }
    __host__ __device__ bool next(int i, Unit& u) const {
        if (!StaticOrder::next(i / 6, u)) return false;
        const int sg = i % 6; u.br = sg;
        if (sg < 3) { u.sel = 0; u.pb = 4 * sg + u.pn; u.k0 = 0; u.nt = 16; }
        else { u.sel = 1; u.pb = u.pn; u.k0 = (sg == 3) ? 0 : (sg == 4) ? 384 : 768; u.nt = (sg == 3) ? 2 : (sg == 4) ? 6 : 4; }
        return true;
    }
};
struct EpiGateProj {
    static constexpr bool PERM = true, AFTER_DRAIN = false;
    bf16_t* ZG; const float* ssq;
    __device__ __forceinline__ void operator()(f32x4 (&acc)[2][2][4][2], const Unit& u, int wr, int wc, int fr, int fq) const {
        const int row0 = u.pm * BM + wr * 64 + fr, col0 = u.pn * BM + wc * 32 + 8 * fq;
        const unsigned o0 = (unsigned)row0 * 3072u + (unsigned)col0;
        if (u.br < 3) {
            float rs[8]; rstd8(ssq, row0, fq, rs);
            const unsigned og = o0 + (unsigned)u.br * 1024u;
#pragma unroll
            for (int ai = 0; ai < 2; ++ai)
#pragma unroll
                for (int m = 0; m < 4; ++m) { const float rstd = rs[ai * 4 + m];
#pragma unroll
                    for (int bj = 0; bj < 2; ++bj) { float v[8]; PG8_V8(v, acc[ai][bj][m][0], acc[ai][bj][m][1], rstd);
#pragma unroll
                        for (int j = 0; j < 8; ++j) v[j] = __builtin_amdgcn_rcpf(1.0f + __builtin_amdgcn_exp2f(v[j] * -1.4426950408889634f));
                        *(u32x4*)(ZG + (og + (unsigned)((ai * HALF + m * 16) * 3072 + bj * HALF))) = pack8(v); } }
        } else if (u.br == 5) {
#pragma unroll
            for (int ai = 0; ai < 2; ++ai) {
                u32x4 g2[4][2];
#pragma unroll
                for (int m = 0; m < 4; ++m)
#pragma unroll
                    for (int bj = 0; bj < 2; ++bj) g2[m][bj] = *(const u32x4*)(ZG + (o0 + 2048u + (unsigned)((ai * HALF + m * 16) * 3072 + bj * HALF)));
#pragma unroll
                for (int m = 0; m < 4; ++m)
#pragma unroll
                    for (int bj = 0; bj < 2; ++bj) { float gn[8], v[8]; unpack8(g2[m][bj], gn); PG8_V8(v, acc[ai][bj][m][0], acc[ai][bj][m][1], 1.0f);
#pragma unroll
                        for (int j = 0; j < 8; ++j) v[j] = gn[j] * v[j];
                        store_wt(ZG + (o0 + (unsigned)((ai * HALF + m * 16) * 3072 + bj * HALF)), pack8(v)); }
            }
        }
        if (u.br == 3 || u.br == 4) {
            const unsigned on = o0 + (unsigned)(u.br - 3) * 1024u;
#pragma unroll
            for (int ai = 0; ai < 2; ++ai)
#pragma unroll
                for (int mp = 0; mp < 4; mp += 2) {
                    u32x4 gn_[2][2], gd_[2][2];
#pragma unroll
                    for (int mm = 0; mm < 2; ++mm)
#pragma unroll
                        for (int bj = 0; bj < 2; ++bj) { const unsigned o = on + (unsigned)((ai * HALF + (mp + mm) * 16) * 3072 + bj * HALF); gn_[mm][bj] = *(const u32x4*)(ZG + o); gd_[mm][bj] = *(const u32x4*)(ZG + (o + 1024u)); }
#pragma unroll
                    for (int mm = 0; mm < 2; ++mm)
#pragma unroll
                        for (int bj = 0; bj < 2; ++bj) { const int m = mp + mm; float gn[8], gd[8]; unpack8(gn_[mm][bj], gn); unpack8(gd_[mm][bj], gd);
#pragma unroll
                            for (int j = 0; j < 8; ++j) gn[j] = gn[j] * __builtin_amdgcn_rcpf(fmaxf(gd[j], 1e-30f));
                            acc[ai][bj][m][0] = acc[ai][bj][m][0] * (f32x4){gn[0], gn[1], gn[2], gn[3]}; acc[ai][bj][m][1] = acc[ai][bj][m][1] * (f32x4){gn[4], gn[5], gn[6], gn[7]};
                            asm volatile("" : "+v"(acc[ai][bj][m][0]), "+v"(acc[ai][bj][m][1])); }
                }
        }
    }
};
struct EpiRes {
    static constexpr bool PERM = true, AFTER_DRAIN = true;
    __device__ static bool stores16(const Unit&) { return true; }
    bf16_t* xb; float* ssq;
    __device__ __forceinline__ void fused(const f32x4 (&acc)[2][2][4][2], const Unit& u, int wr, int wc, int, int, PG8_LAS unsigned char* lds, int, int) const {
        int te_ = threadIdx.x; asm volatile("" : "+v"(te_) :: "memory"); const int fr = te_ & 15, fq = (te_ & 63) >> 4;
        const int row0 = u.pm * BM + wr * 64 + fr, col0 = u.pn * BM + wc * 32 + 8 * fq;
        const unsigned o0 = (unsigned)row0 * 1024u + (unsigned)col0;
        PG8_LAS float* P = (PG8_LAS float*)lds;
        u32x4 bs[2][4][2];
#pragma unroll
        for (int ai = 0; ai < 2; ++ai)
#pragma unroll
            for (int m = 0; m < 4; ++m)
#pragma unroll
                for (int bj = 0; bj < 2; ++bj) bs[ai][m][bj] = *(const u32x4*)(xb + (o0 + (unsigned)((ai * HALF + m * 16) * 1024 + bj * HALF)));
#pragma unroll
        for (int ai = 0; ai < 2; ++ai) {
#pragma unroll
            for (int m = 0; m < 4; ++m) { float sq = 0.f;
#pragma unroll
                for (int bj = 0; bj < 2; ++bj) {
                    float b[8], v[8]; unpack8(bs[ai][m][bj], b); PG8_V8(v, acc[ai][bj][m][0], acc[ai][bj][m][1], 1.0f);
#pragma unroll
                    for (int j = 0; j < 8; ++j) { v[j] += b[j]; sq += v[j] * v[j]; }
                    store_wt(xb + (o0 + (unsigned)((ai * HALF + m * 16) * 1024 + bj * HALF)), pack8(v)); }
                sq = xsum16(sq); sq = xsum32(sq);
                if (fq == 0) P[(ai * HALF + wr * 64 + m * 16 + fr) * 4 + wc] = sq; }
        }
        asm volatile("s_waitcnt lgkmcnt(0)" ::: "memory"); __builtin_amdgcn_s_barrier(); asm volatile("" ::: "memory");
        if (te_ < 256) { const f32x4 p = *(PG8_LAS const f32x4*)(P + te_ * 4); ssq[(unsigned)(u.pm * BM + te_) * 4u + (unsigned)u.pn] = (p[0] + p[1]) + (p[2] + p[3]); }
    }
};
struct EpiUp {
    static constexpr bool PERM = true, AFTER_DRAIN = false;
    bf16_t* U; const float* ssq;
    __device__ __forceinline__ void operator()(const f32x4 (&acc)[2][2][4][2], const Unit& u, int wr, int wc, int fr, int fq) const {
        const int row0 = u.pm * BM + wr * 64 + fr, col0 = u.pn * BM + wc * 32 + 8 * fq;
        float rs[8]; rstd8(ssq, row0, fq, rs);
#pragma unroll
        for (int ai = 0; ai < 2; ++ai)
#pragma unroll
            for (int m = 0; m < 4; ++m) { const int row = row0 + ai * HALF + m * 16; const float rstd = rs[ai * 4 + m];
#pragma unroll
                for (int bj = 0; bj < 2; ++bj) { float v[8]; PG8_V8(v, acc[ai][bj][m][0], acc[ai][bj][m][1], rstd);
#pragma unroll
                    for (int j = 0; j < 8; ++j) { const float r = fmaxf(v[j], 0.f); v[j] = r * r; }
                    store_wt(U + (size_t)row * 4096 + col0 + bj * HALF, pack8(v)); } }
    }
};
}
#define GAS __attribute__((address_space(1)))
#define LAS __attribute__((address_space(3)))
typedef unsigned short bf16;
typedef unsigned v4u __attribute__((ext_vector_type(4)));
typedef float f32x4 __attribute__((ext_vector_type(4)));
typedef short bf16x8 __attribute__((ext_vector_type(8)));
typedef GAS unsigned gu32;
typedef GAS unsigned long long gu64;
#define RLX_AGENT __ATOMIC_RELAXED, __HIP_MEMORY_SCOPE_AGENT
#define LDS_WAIT() asm volatile("s_waitcnt lgkmcnt(0)" ::: "memory")
#define VM_WAIT() asm volatile("s_waitcnt vmcnt(0)" ::: "memory")
__device__ __forceinline__ unsigned long long rt() { return __builtin_amdgcn_s_memrealtime(); }
__device__ __forceinline__ unsigned f2bf(float f) { unsigned u = __builtin_bit_cast(unsigned, f); return (u + 0x7fffu + ((u >> 16) & 1u)) >> 16; }
__device__ __forceinline__ unsigned pk2(float lo, float hi) { return f2bf(lo) | (f2bf(hi) << 16); }

#define XB_TMO      128
#define XB_XCNT(j)  (256  + 64 * (j))
#define XB_XSUB(j)  (1280 + 64 * (j))
#define XB_XGEN(j)  (2304 + 64 * (j))
#define XB_TOP      3328
#define XB_TOPGEN   3392
#define XCD_BAR_WORDS 3456
#define XB_SPIN_CAP (1u << 18)

__device__ __forceinline__ unsigned xb_ld(unsigned* p)              { return __hip_atomic_load(p, __ATOMIC_RELAXED, __HIP_MEMORY_SCOPE_AGENT); }
__device__ __forceinline__ unsigned xb_add(unsigned* p, unsigned v) { return __hip_atomic_fetch_add(p, v, __ATOMIC_RELAXED, __HIP_MEMORY_SCOPE_AGENT); }
__device__ __forceinline__ unsigned xb_xcc_id() { return (unsigned)__builtin_amdgcn_s_getreg((3 << 11) | 20) & 0xFu; }
#define XB_SPIN(cond, bar) do { unsigned _sp = 0; while (cond) { __builtin_amdgcn_s_sleep(1); \
    if ((++_sp & 255u) == 0u) { if (xb_ld(&(bar)[XB_TMO])) break; if (_sp > XB_SPIN_CAP) { atomicAdd(&(bar)[XB_TMO], 1u); break; } } } } while (0)

struct XcdBarrier {
    unsigned* bar; unsigned x;
    volatile LAS unsigned* st;
};

__device__ __forceinline__ XcdBarrier xcd_barrier_post(unsigned* bar, volatile LAS unsigned* st) {
    XcdBarrier b; b.bar = bar; b.x = xb_xcc_id(); b.st = st;
    if (threadIdx.x == 0) (void)xb_add(&bar[XB_XCNT(b.x)], 1u);
    return b;
}
__device__ __forceinline__ void xcd_barrier_complete(unsigned* bar, unsigned x, unsigned& nloc, unsigned& nx) {
    const unsigned G = gridDim.x * gridDim.y * gridDim.z;
    unsigned sum, cnt, mine, sp = 0u;
    for (;;) {
        sum = 0u; cnt = 0u; mine = 0u;
#pragma unroll
        for (unsigned j = 0; j < 16; ++j) { const unsigned c = xb_ld(&bar[XB_XCNT(j)]); sum += c; cnt += (c > 0u) ? 1u : 0u; mine = (j == x) ? c : mine; }
        if (sum == G) break;
        __builtin_amdgcn_s_sleep(1);
        if ((++sp & 255u) == 0u) { if (xb_ld(&bar[XB_TMO])) break; if (sp > XB_SPIN_CAP) { atomicAdd(&bar[XB_TMO], 1u); break; } }
    }
    nloc = mine > 0u ? mine : 1u; nx = cnt > 0u ? cnt : 1u;
}

__device__ __forceinline__ void xcd_barrier(const XcdBarrier& b) {
    asm volatile("s_waitcnt vmcnt(0)" ::: "memory");
    __syncthreads();
    if (threadIdx.x == 0) {
        unsigned* bar = b.bar;
        __builtin_amdgcn_s_waitcnt(0);
        unsigned nloc = b.st[0], nx = b.st[1];
        if (nloc == 0u) { xcd_barrier_complete(bar, b.x, nloc, nx); b.st[0] = nloc; b.st[1] = nx; }
        const unsigned old = xb_add(&bar[XB_XSUB(b.x)], 1u);
        const unsigned gen = old / nloc;
        if (old + 1u == (gen + 1u) * nloc) {
            __builtin_amdgcn_fence(__ATOMIC_RELEASE, "agent");
            asm volatile("s_waitcnt vmcnt(0)" ::: "memory");
            const unsigned og = xb_add(&bar[XB_TOP], 1u);
            const unsigned tg = og / nx;
            if (og + 1u == (tg + 1u) * nx) xb_add(&bar[XB_TOPGEN], 1u);
            else XB_SPIN(xb_ld(&bar[XB_TOPGEN]) == tg, bar);
            __builtin_amdgcn_fence(__ATOMIC_ACQUIRE, "agent");
            xb_add(&bar[XB_XGEN(b.x)], 1u);
            asm volatile("s_waitcnt vmcnt(0)" ::: "memory");
        } else {
            XB_SPIN(xb_ld(&bar[XB_XGEN(b.x)]) == gen, bar);
            __builtin_amdgcn_fence(__ATOMIC_ACQUIRE, "agent");
            asm volatile("s_waitcnt vmcnt(0)" ::: "memory");
        }
    }
    __syncthreads();
}

constexpr int NWAVES = 8;
constexpr int T = 16384, D = 1024, SEQ = 2048, FF = 4096, DIN = 5632, NQKV = 2560, NGATE = 3072, NMEMROWS = 2048;
constexpr size_t MiB = 1u << 20;
constexpr size_t WS_CTL = 0, CTL_ZERO_BYTES = 1 * MiB;
constexpr size_t WS_KSUM = 256 * 1024;
constexpr size_t WS_ROPE = 1 * MiB;
constexpr size_t WS_SSQ = 2 * MiB;
constexpr size_t WS_PTRS = 768 * 1024;
constexpr size_t WS_LSE = 3 * MiB;
constexpr size_t WS_MKV = 4 * MiB;
constexpr size_t WS_MEMN = 6 * MiB;
constexpr size_t WS_W = 10 * MiB;
constexpr size_t W_IN = 0, W_UP = 11 * MiB, W_DN = 19 * MiB, W_O = 27 * MiB, W_P = 29 * MiB, W_MKV = 31 * MiB, W_LAYER = 32 * MiB;
constexpr size_t WS_XB = 74 * MiB;
constexpr size_t WS_ZQ = 106 * MiB;
constexpr size_t WS_ZKV = 138 * MiB;
constexpr size_t WS_ZG = 138 * MiB;
constexpr size_t WS_U = 106 * MiB;
constexpr size_t WS_END = 234 * MiB;
constexpr int CW_QUEUE = 2048;
constexpr int CW_BAR = 4096;
constexpr int RING_OFF = 0, RING_BYTES = 131072, LDSCTL_OFF = RING_BYTES, MISC_OFF = LDSCTL_OFF + 320, LDS_BYTES = 147456;

__device__ __forceinline__ float wave_sum(float v) {
#pragma unroll
    for (int o = 1; o < 64; o <<= 1) v += __shfl_xor(v, o);
    return v;
}
__device__ __forceinline__ float bf2f(bf16 h) { return __uint_as_float((unsigned)h << 16); }

struct TrD { const float* W; const float* gain; bf16* WT; int N, ldt, k0, n0, drow, dcol; };
__device__ __forceinline__ void tr_load(const TrD& d, f32x4 (&v)[8], float (&gn)[8], int lane) {
    const int lr = lane >> 3, n4 = lane & 7;
#pragma unroll
    for (int i = 0; i < 8; ++i) { const int kk = 8 * i + lr; v[i] = __builtin_nontemporal_load((const GAS f32x4*)(d.W + (size_t)(d.k0 + kk) * d.N + d.n0 + 4 * n4)); gn[i] = d.gain ? d.gain[d.k0 + kk] : 1.0f; }
}
__device__ __forceinline__ void tr_fin(const TrD& d, const f32x4 (&v)[8], const float (&gn)[8], LAS float* scr, int lane) {
    const int lr = lane >> 3, n4 = lane & 7;
#pragma unroll
    for (int i = 0; i < 8; ++i) { const int kk = 8 * i + lr; LAS float* q = scr + kk * 33 + 4 * n4; q[0] = v[i].x * gn[i]; q[1] = v[i].y * gn[i]; q[2] = v[i].z * gn[i]; q[3] = v[i].w * gn[i]; }
    LDS_WAIT(); asm volatile("" ::: "memory");
    const int c = lane & 7;
#pragma unroll
    for (int j = 0; j < 4; ++j) { const int n = (lane >> 3) + 8 * j; const LAS float* s = scr + (8 * c) * 33 + n;
        v4u o; o.x = pk2(s[0 * 33], s[1 * 33]); o.y = pk2(s[2 * 33], s[3 * 33]); o.z = pk2(s[4 * 33], s[5 * 33]); o.w = pk2(s[6 * 33], s[7 * 33]);
        *(GAS v4u*)(d.WT + (size_t)(d.drow + n) * d.ldt + d.dcol + d.k0 + 8 * c) = o; }
    LDS_WAIT(); asm volatile("" ::: "memory");
}
__device__ __forceinline__ int win_dest_row(int n) {
    if (n < 384) return n;
    if (n < 768) return 1024 + (n - 384);
    if (n < 1152) return 1024 + 384 + (n - 768);
    if (n < 1536) return 384 + (n - 1152);
    if (n < 1920) return 1024 + 768 + (n - 1536);
    if (n < 2304) return 1024 + 1152 + (n - 1920);
    if (n < 2560) return 768 + (n - 2304);
    return n;
}

typedef unsigned u32x4p __attribute__((ext_vector_type(4)));

namespace att {
typedef short bf16x8 __attribute__((ext_vector_type(8)));
typedef short s16x4 __attribute__((ext_vector_type(4)));
typedef float f32x16 __attribute__((ext_vector_type(16)));
constexpr int KP = 144, VP = 192;
constexpr int KBUF = 64 * KP, VBUF = 64 * VP, BUF = KBUF + VBUF;
constexpr float LOG2E = 1.4426950408889634f;
__device__ __forceinline__ int crow(int r, int hi) { return (r & 3) + 8 * (r >> 2) + 4 * hi; }
__device__ __forceinline__ float xsum(float v) { return pg8::xsum32(v); }
__device__ __forceinline__ float xmax(float v) { return pg8::xmax32(v); }
__device__ __forceinline__ s16x4 vtr(LAS const unsigned char* p) { typedef short v4i16_t __attribute__((ext_vector_type(4))); return __builtin_bit_cast(s16x4, __builtin_amdgcn_ds_read_tr16_b64_v4i16((LAS v4i16_t*)p)); }

struct Unit {
    int kind;
    const bf16* Q; bf16* O;
    int qrow0, qstride, nq;
    const bf16* K; const bf16* V; int kvpitch;
    int krow0, kstride;
    int t_lo, t_hi;
    int qidx0;
    int qb;
    const float* ksum;
    float* lse; int lse_stride;
};

template <int KIND> __device__ __forceinline__ void att_tile(LAS const unsigned char* kb, const Unit& u, int t, int wid, int qi, int hi, unsigned koff, unsigned voff, unsigned sel,
                                                             const bf16x8 (&qf)[4], float& m, f32x16& o0, f32x16& o1, f32x16& o2) {
    bf16x8 ka[4], kc[4];
#pragma unroll
    for (int ks = 0; ks < 4; ++ks) { ka[ks] = *(LAS const bf16x8*)(kb + koff + 32 * ks); kc[ks] = *(LAS const bf16x8*)(kb + koff + 32 * KP + 32 * ks); }
    bf16x8 va[2][2], vc[2][2];
#pragma unroll
    for (int sub_ = 0; sub_ < 2; ++sub_)
#pragma unroll
        for (int s = 0; s < 2; ++s) {
            LAS const unsigned char* vb = kb + voff + (32 * sub_ + 16 * s) * VP;
            const s16x4 a_lo = vtr(vb), a_hi = vtr(vb + 8 * VP), b_lo = vtr(vb + 64), b_hi = vtr(vb + 8 * VP + 64);
            va[sub_][s] = (bf16x8){a_lo[0], a_lo[1], a_lo[2], a_lo[3], a_hi[0], a_hi[1], a_hi[2], a_hi[3]};
            vc[sub_][s] = (bf16x8){b_lo[0], b_lo[1], b_lo[2], b_lo[3], b_hi[0], b_hi[1], b_hi[2], b_hi[3]};
        }
    const int qlo = u.qidx0 + 32 * wid;
    bool bs = true, needmask = false;
    if (KIND == 0) { const int blk = t >> 2; if (blk < u.qb) bs = (sel >> blk) & 1u; else needmask = (64 * t + 63 > qlo); }
    if (KIND == 2) needmask = !((64 * t + 63 <= qlo) && (64 * t >= qlo + 31 - 128));
    const bool unset = (m == -INFINITY);
    const float mref = unset ? 0.f : m;
    const float nv = bs ? -mref : -1e30f;
    f32x16 negt;
#pragma unroll
    for (int r = 0; r < 16; ++r) negt[r] = nv;
    f32x16 p0 = __builtin_amdgcn_mfma_f32_32x32x16_bf16(ka[0], qf[0], negt, 0, 0, 0);
    f32x16 p1 = __builtin_amdgcn_mfma_f32_32x32x16_bf16(kc[0], qf[0], negt, 0, 0, 0);
#pragma unroll
    for (int ks = 1; ks < 4; ++ks) {
        p0 = __builtin_amdgcn_mfma_f32_32x32x16_bf16(ka[ks], qf[ks], p0, 0, 0, 0);
        p1 = __builtin_amdgcn_mfma_f32_32x32x16_bf16(kc[ks], qf[ks], p1, 0, 0, 0);
    }
    if (needmask) {
#pragma unroll
        for (int r = 0; r < 16; ++r) {
            const int j0 = 64 * t + crow(r, hi), j1 = j0 + 32;
            bool v0 = j0 <= qi, v1 = j1 <= qi;
            if (KIND == 2) { v0 = v0 && (j0 >= qi - 128); v1 = v1 && (j1 >= qi - 128); }
            p0[r] = v0 ? p0[r] : -INFINITY; p1[r] = v1 ? p1[r] : -INFINITY;
        }
    }
    float rm = __builtin_fmaxf(p0[0], p1[0]);
#pragma unroll
    for (int r = 1; r < 16; ++r) rm = __builtin_fmaxf(__builtin_fmaxf(rm, p0[r]), p1[r]);
    rm = xmax(rm);
    const bool trig = bs && (rm > 8.0f || (unset && rm > -1e29f));
    if (__any(trig)) {
        const float dl = trig ? rm : 0.f;
        const float alpha = (trig && !unset) ? __builtin_amdgcn_exp2f(-dl) : 1.0f;
        m = trig ? (mref + dl) : m;
#pragma unroll
        for (int r = 0; r < 16; ++r) { p0[r] -= dl; p1[r] -= dl; o0[r] *= alpha; o1[r] *= alpha; o2[r] *= alpha; }
    }
#pragma unroll
    for (int r = 0; r < 16; ++r) { p0[r] = __builtin_amdgcn_exp2f(p0[r]); p1[r] = __builtin_amdgcn_exp2f(p1[r]); }
    bf16x8 pf[2][2];
#pragma unroll
    for (int s = 0; s < 2; ++s) {
        u32x4p w0, w1;
        w0.x = pg8::cvt_pk_bf16(p0[8 * s + 0], p0[8 * s + 1]); w0.y = pg8::cvt_pk_bf16(p0[8 * s + 2], p0[8 * s + 3]); w0.z = pg8::cvt_pk_bf16(p0[8 * s + 4], p0[8 * s + 5]); w0.w = pg8::cvt_pk_bf16(p0[8 * s + 6], p0[8 * s + 7]);
        w1.x = pg8::cvt_pk_bf16(p1[8 * s + 0], p1[8 * s + 1]); w1.y = pg8::cvt_pk_bf16(p1[8 * s + 2], p1[8 * s + 3]); w1.z = pg8::cvt_pk_bf16(p1[8 * s + 4], p1[8 * s + 5]); w1.w = pg8::cvt_pk_bf16(p1[8 * s + 6], p1[8 * s + 7]);
        pf[0][s] = __builtin_bit_cast(bf16x8, w0); pf[1][s] = __builtin_bit_cast(bf16x8, w1);
    }
    const bf16x8 ones = (bf16x8){0x3F80, 0x3F80, 0x3F80, 0x3F80, 0x3F80, 0x3F80, 0x3F80, 0x3F80};
#pragma unroll
    for (int sub_ = 0; sub_ < 2; ++sub_)
#pragma unroll
        for (int s = 0; s < 2; ++s) {
            o0 = __builtin_amdgcn_mfma_f32_32x32x16_bf16(va[sub_][s], pf[sub_][s], o0, 0, 0, 0);
            o1 = __builtin_amdgcn_mfma_f32_32x32x16_bf16(vc[sub_][s], pf[sub_][s], o1, 0, 0, 0);
            o2 = __builtin_amdgcn_mfma_f32_32x32x16_bf16(ones, pf[sub_][s], o2, 0, 0, 0);
        }
}

template <int KIND> __device__ __forceinline__ void run_unit(LAS unsigned char* lds, const Unit& u) {
    int tid_ = threadIdx.x; asm volatile("" : "+v"(tid_));
    const int tid = tid_, lane = tid & 63, wid = __builtin_amdgcn_readfirstlane(tid >> 6), ql = lane & 31, hi = lane >> 5;
    const bool wactive = (32 * wid) < u.nq;
    const int srow = tid >> 3, sch = tid & 7;
    const unsigned kdst = (unsigned)(srow * KP + sch * 16), vdst = (unsigned)(KBUF + srow * VP + sch * 16);
    v4u kA, vA, kB, vB;
#define ATT_LOAD(KR, VR, t) do { const size_t r_ = (size_t)(u.krow0 + (64 * (t) + srow) * u.kstride) * u.kvpitch + sch * 8; KR = *(const GAS v4u*)(u.K + r_); VR = *(const GAS v4u*)(u.V + r_); } while (0)
#define ATT_WRITE(KR, VR, b) do { *(LAS v4u*)(lds + (b) * BUF + kdst) = KR; *(LAS v4u*)(lds + (b) * BUF + vdst) = VR; } while (0)
    ATT_LOAD(kA, vA, u.t_lo);
    if (u.t_lo + 1 < u.t_hi) ATT_LOAD(kB, vB, u.t_lo + 1);
    const int qi = u.qidx0 + 32 * wid + ql;
    const size_t qrow = (size_t)(u.qrow0 + (32 * wid + ql) * u.qstride);
    bf16x8 qf[4];
#pragma unroll
    for (int ks = 0; ks < 4; ++ks) qf[ks] = wactive ? *(const bf16x8*)(u.Q + qrow * 1024 + 16 * ks + 8 * hi) : (bf16x8){0, 0, 0, 0, 0, 0, 0, 0};
    unsigned sel = 0xffu;
    if (KIND == 0) {
        float gsc[7];
#pragma unroll
        for (int n = 0; n < 7; ++n) { gsc[n] = -INFINITY;
            if (n < u.qb) { const float* kp = u.ksum + n * 384 + 8 * hi; float s = 0.f;
#pragma unroll
                for (int ks = 0; ks < 4; ++ks) { const f32x4 k0 = *(const f32x4*)(kp + 16 * ks), k1 = *(const f32x4*)(kp + 16 * ks + 4);
#pragma unroll
                    for (int j = 0; j < 4; ++j) { s += bf2f((bf16)qf[ks][j]) * k0[j]; s += bf2f((bf16)qf[ks][4 + j]) * k1[j]; } }
                s = xsum(s); gsc[n] = s; } }
        sel = 0u;
#pragma unroll
        for (int r = 0; r < 3; ++r) { int best = -1; float bv = -INFINITY;
#pragma unroll
            for (int n = 0; n < 7; ++n) if (n < u.qb && !((sel >> n) & 1u) && gsc[n] > bv) { bv = gsc[n]; best = n; }
            if (best >= 0) sel |= 1u << best; }
    }
    float m = -INFINITY; f32x16 o0 = {}, o1 = {}, o2 = {};
    ATT_WRITE(kA, vA, 0); if (u.t_lo + 1 < u.t_hi) ATT_WRITE(kB, vB, 1);
    __syncthreads();
    const unsigned koff = (unsigned)(ql * KP + 16 * hi);
    const unsigned voff = (unsigned)(KBUF + (4 * hi + ((lane & 15) >> 2)) * VP + ((lane >> 4) & 1) * 32 + (lane & 3) * 8);
#define ATT_NEED(t) (wactive && !(KIND == 0 && ((t) >> 2) == u.qb && 64 * (t) > u.qidx0 + 32 * wid + 31) && !(KIND == 2 && (64 * (t) > u.qidx0 + 32 * wid + 31 || 64 * (t) + 63 < u.qidx0 + 32 * wid - 128)))
    for (int t = u.t_lo; t < u.t_hi; t += 2) {
        const bool more = (t + 2 < u.t_hi), more2 = (t + 3 < u.t_hi);
        if (more) ATT_LOAD(kA, vA, t + 2);
        if (more2) ATT_LOAD(kB, vB, t + 3);
        if (ATT_NEED(t)) att_tile<KIND>(lds, u, t, wid, qi, hi, koff, voff, sel, qf, m, o0, o1, o2);
        if (t + 1 < u.t_hi) { if (ATT_NEED(t + 1)) att_tile<KIND>(lds + BUF, u, t + 1, wid, qi, hi, koff, voff, sel, qf, m, o0, o1, o2); }
        __syncthreads();
        if (more) { ATT_WRITE(kA, vA, 0); if (more2) ATT_WRITE(kB, vB, 1); __syncthreads(); }
    }
    if (wactive) {
        const float lt = o2[0]; const float inv = 1.0f / lt;
        bf16* orow = u.O + qrow * 1024;
#pragma unroll
        for (int g = 0; g < 4; ++g) {
            unsigned long long w0 = (unsigned long long)pg8::cvt_pk_bf16(o0[4 * g] * inv, o0[4 * g + 1] * inv) | ((unsigned long long)pg8::cvt_pk_bf16(o0[4 * g + 2] * inv, o0[4 * g + 3] * inv) << 32);
            unsigned long long w1 = (unsigned long long)pg8::cvt_pk_bf16(o1[4 * g] * inv, o1[4 * g + 1] * inv) | ((unsigned long long)pg8::cvt_pk_bf16(o1[4 * g + 2] * inv, o1[4 * g + 3] * inv) << 32);
            *(unsigned long long*)(orow + 8 * g + 4 * hi) = w0; *(unsigned long long*)(orow + 32 + 8 * g + 4 * hi) = w1;
        }
        if (KIND == 2) { if (hi == 0) u.lse[(size_t)(32 * wid + ql) * u.lse_stride] = m + __builtin_log2f(lt); }
    }
#undef ATT_LOAD
#undef ATT_WRITE
#undef ATT_NEED
}

constexpr int N_UNITS = 1152;
__device__ __forceinline__ void make_unit(int idx, Unit& u, bf16* ZQ, const bf16* ZKV, const bf16* MKV, const float* KSUM, float* LSE) {
    u.qstride = 1; u.nq = 256; u.kstride = 1; u.qb = 0; u.ksum = nullptr; u.lse = nullptr; u.lse_stride = 0; u.qidx0 = 0;
    int mb = -1, mqb = 0;
    if (idx < 288) { mqb = 7 - idx / 48; mb = idx % 48; }
    else if (idx < 336) { mqb = 1; mb = idx - 288; }
    else if (idx >= 592 && idx < 640) { mqb = 0; mb = idx - 592; }
    if (mb >= 0) {
        const int b = mb / 6, h = mb % 6;
        u.kind = 0; u.Q = ZQ + 384 + h * 64; u.O = ZQ + 384 + h * 64; u.qrow0 = b * SEQ + 256 * mqb;
        u.K = ZKV + 768 + h * 64; u.V = ZKV + 1152 + h * 64; u.kvpitch = 1536; u.krow0 = b * SEQ;
        u.t_lo = 0; u.t_hi = 4 * (mqb + 1); u.qidx0 = 256 * mqb; u.qb = mqb; u.ksum = KSUM + (size_t)(b * 8) * 384 + h * 64;
        return;
    }
    if (idx >= 640 && idx < 896) {
        const int i = idx - 640, bh = i >> 3, blk = i & 7, b = bh >> 2, h = bh & 3;
        u.kind = 1; u.Q = ZQ + 768 + h * 64; u.O = ZQ + 768 + h * 64; u.qrow0 = b * SEQ + 256 * blk;
        u.K = MKV + h * 64; u.V = MKV + 256 + h * 64; u.kvpitch = 512; u.krow0 = b * 256; u.t_lo = 0; u.t_hi = 4;
        return;
    }
    u.kind = 2; u.kvpitch = 1536; u.lse_stride = 6;
    int g, b, h, r, m0, nq;
    if (idx < 464) { const int i = idx - 336; g = 0; b = i >> 4; h = (i >> 3) & 1; r = 0; m0 = 256 * (i & 7); nq = 256; }
    else if (idx < 592) { const int i = idx - 464; g = 1; b = i >> 4; h = (i >> 3) & 1; r = (i >> 1) & 3; m0 = 256 * (i & 1); nq = 256; }
    else { const int i = idx - 896; g = 2; b = i >> 5; h = (i >> 4) & 1; r = i & 15; m0 = 0; nq = 128; }
    const int dil = (g == 0) ? 1 : (g == 1) ? 4 : 16, hc = (2 * g + h) * 64;
    u.Q = ZQ + hc; u.O = ZQ + hc; u.qstride = dil; u.nq = nq; u.qrow0 = b * SEQ + m0 * dil + r;
    u.K = ZKV + hc; u.V = ZKV + 384 + hc; u.krow0 = b * SEQ + r; u.kstride = dil;
    u.t_lo = (m0 >= 128) ? (m0 - 128) / 64 : 0; u.t_hi = (m0 + nq) / 64; u.qidx0 = m0;
    u.lse = LSE + (size_t)u.qrow0 * 6 + (2 * g + h); u.lse_stride = 6 * dil;
}
}
struct Args { const float* in[14]; float* out; unsigned char* ws; int ph_lo, ph_hi, li, pad; };
constexpr int I_INQ = 16 * 80, I_ING = 16 * 96, I_PA = 2 * 32, I_PB = 6 * 32, I_PM = 4 * 32, I_O = 16 * 32, I_MKV = 16 * 16, I_UP = 16 * 128, I_DN = 64 * 32;
constexpr int I_LAYER = I_INQ + I_MKV + I_ING + I_PA + I_PB + I_PM + I_O + I_UP + I_DN, I_EARLY = I_INQ + I_MKV;
__device__ __forceinline__ TrD tr_desc(const float* const* in, unsigned char* ws, int it) {
    const int l = it / I_LAYER; int r = it % I_LAYER;
    unsigned char* wl = ws + WS_W + (size_t)l * W_LAYER; TrD d;
    if (r < I_INQ) { const int kb = r / 80, nb = r % 80; d = TrD{in[3] + (size_t)l * D * DIN, in[2] + l * D, (bf16*)(wl + W_IN), DIN, 1024, 64 * kb, 32 * nb, win_dest_row(32 * nb), 0}; return d; } r -= I_INQ;
    if (r < I_MKV) { const int kb = r / 16, nb = r % 16; d = TrD{in[9] + (size_t)l * D * 512, in[8] + l * D, (bf16*)(wl + W_MKV), 512, 1024, 64 * kb, 32 * nb, 32 * nb, 0}; return d; } r -= I_MKV;
    if (r < I_ING) { const int kb = r / 96, nb = 80 + r % 96; d = TrD{in[3] + (size_t)l * D * DIN, in[2] + l * D, (bf16*)(wl + W_IN), DIN, 1024, 64 * kb, 32 * nb, win_dest_row(32 * nb), 0}; return d; } r -= I_ING;
    if (r < I_PA) { const int kb = r / 32, nb = r % 32; d = TrD{in[4] + (size_t)l * 128 * D, nullptr, (bf16*)(wl + W_P), D, 1024, 64 * kb, 32 * nb, 32 * nb, 0}; return d; } r -= I_PA;
    if (r < I_PB) { const int kb = r / 32, nb = r % 32; d = TrD{in[5] + (size_t)l * 384 * D, nullptr, (bf16*)(wl + W_P), D, 1024, 64 * kb, 32 * nb, 32 * nb, 384}; return d; } r -= I_PB;
    if (r < I_PM) { const int kb = r / 32, nb = r % 32; d = TrD{in[6] + (size_t)l * 256 * D, nullptr, (bf16*)(wl + W_P), D, 1024, 64 * kb, 32 * nb, 32 * nb, 768}; return d; } r -= I_PM;
    if (r < I_O) { const int kb = r / 32, nb = r % 32; d = TrD{in[7] + (size_t)l * D * D, nullptr, (bf16*)(wl + W_O), D, 1024, 64 * kb, 32 * nb, 32 * nb, 0}; return d; } r -= I_O;
    if (r < I_UP) { const int kb = r / 128, nb = r % 128; d = TrD{in[11] + (size_t)l * D * FF, in[10] + l * D, (bf16*)(wl + W_UP), FF, 1024, 64 * kb, 32 * nb, 32 * nb, 0}; return d; } r -= I_UP;
    { const int kb = r / 32, nb = r % 32; d = TrD{in[12] + (size_t)l * FF * D, nullptr, (bf16*)(wl + W_DN), D, 4096, 64 * kb, 32 * nb, 32 * nb, 0}; return d; }
}

namespace pg8 {
struct EpiFinal {
    static constexpr bool PERM = true, AFTER_DRAIN = true;
    __device__ static bool stores16(const Unit&) { return true; }
    const bf16_t* xb; float* ssq; float* out; const float* gain; const XcdBarrier* bar;
    __device__ __forceinline__ void fused(f32x4 (&acc)[2][2][4][2], const Unit& u, int wr, int wc, int, int, PG8_LAS unsigned char* lds, int, int) const {
        int te_ = threadIdx.x; asm volatile("" : "+v"(te_) :: "memory"); const int fr = te_ & 15, fq = (te_ & 63) >> 4;
        PG8_LAS float* P = (PG8_LAS float*)lds;
        const int row0 = u.pm * BM + wr * 64 + fr, col0 = u.pn * BM + wc * 32 + 8 * fq;
        const unsigned o0 = (unsigned)row0 * 1024u + (unsigned)col0;
#pragma unroll
        for (int ai = 0; ai < 2; ++ai) {
            u32x4 bs[4][2];
#pragma unroll
            for (int m = 0; m < 4; ++m)
#pragma unroll
                for (int bj = 0; bj < 2; ++bj) bs[m][bj] = *(const u32x4*)(xb + (o0 + (unsigned)((ai * HALF + m * 16) * 1024 + bj * HALF)));
#pragma unroll
            for (int m = 0; m < 4; ++m) { float sq = 0.f;
#pragma unroll
                for (int bj = 0; bj < 2; ++bj) { float b[8]; unpack8(bs[m][bj], b);
                    acc[ai][bj][m][0] = acc[ai][bj][m][0] + (f32x4){b[0], b[1], b[2], b[3]}; acc[ai][bj][m][1] = acc[ai][bj][m][1] + (f32x4){b[4], b[5], b[6], b[7]};
                    const f32x4 x0 = acc[ai][bj][m][0], x1 = acc[ai][bj][m][1];
                    sq += (x0[0] * x0[0] + x0[1] * x0[1]) + (x0[2] * x0[2] + x0[3] * x0[3]) + (x1[0] * x1[0] + x1[1] * x1[1]) + (x1[2] * x1[2] + x1[3] * x1[3]); }
                sq = xsum16(sq); sq = xsum32(sq);
                if (fq == 0) P[(ai * HALF + wr * 64 + m * 16 + fr) * 4 + wc] = sq; }
        }
        asm volatile("s_waitcnt lgkmcnt(0)" ::: "memory"); __builtin_amdgcn_s_barrier(); asm volatile("" ::: "memory");
        if (te_ < 256) { const f32x4 p = *(PG8_LAS const f32x4*)(P + te_ * 4); ssq[(unsigned)(u.pm * BM + te_) * 4u + (unsigned)u.pn] = (p[0] + p[1]) + (p[2] + p[3]); }
        xcd_barrier(*bar);
        float rs[8]; rstd8(ssq, row0, fq, rs);
#pragma unroll
        for (int bj = 0; bj < 2; ++bj) { const f32x4 g0 = *(const f32x4*)(gain + col0 + bj * HALF), g1 = *(const f32x4*)(gain + col0 + bj * HALF + 4);
#pragma unroll
            for (int ai = 0; ai < 2; ++ai)
#pragma unroll
                for (int m = 0; m < 4; ++m) { const float r = rs[ai * 4 + m]; float* op = out + (o0 + (unsigned)((ai * HALF + m * 16) * 1024 + bj * HALF));
                    *(f32x4*)op = acc[ai][bj][m][0] * r * g0; *(f32x4*)(op + 4) = acc[ai][bj][m][1] * r * g1; } }
    }
};
}
constexpr int N_PHASES = 16;
#ifndef MK_ONE_LAUNCH
#define MK_ONE_LAUNCH 1
#endif
__global__ void __launch_bounds__(NWAVES * 64, 2) mega(Args args) {
    extern __shared__ __attribute__((aligned(16))) unsigned char lds_raw[];
    LAS unsigned char* lds = (LAS unsigned char*)lds_raw;
    volatile LAS unsigned* MISC = (volatile LAS unsigned*)(lds + MISC_OFF);
    const int tid = threadIdx.x, lane = tid & 63, wave = __builtin_amdgcn_readfirstlane(tid >> 6);
    const int G = gridDim.x; const int bx = blockIdx.x; const int vcu = (G % 8 == 0) ? (bx % 8) * (G / 8) + bx / 8 : bx;
    unsigned char* ws = args.ws;
    gu32* ctl = (gu32*)(ws + WS_CTL);
    for (int u = tid; u < (LDS_BYTES - LDSCTL_OFF) / 4; u += NWAVES * 64) ((LAS unsigned*)(lds + LDSCTL_OFF))[u] = 0u;
    __syncthreads();
    XcdBarrier bar; bar.bar = (unsigned*)(ctl + CW_BAR); bar.x = 0; bar.st = nullptr;
    if (MK_ONE_LAUNCH) bar = xcd_barrier_post((unsigned*)(ctl + CW_BAR), MISC + 8);
    const int lo = args.ph_lo, hi = args.ph_hi;
#define IN(k) (lo <= (k) && (k) < hi)
#ifndef MK_PROBE
#define MK_PROBE 0
#endif
#if MK_PROBE
    unsigned long long* const TS = (unsigned long long*)(ws + 512 * 1024);
#define STAMP(k) do { if (blockIdx.x == 0) { __hip_atomic_store(TS + (k), rt(), __ATOMIC_RELAXED, __HIP_MEMORY_SCOPE_AGENT); } } while (0)
#else
#define STAMP(k) do { } while (0)
#endif
#define SEAM(k) do { if (IN(k) && IN((k) + 1)) xcd_barrier(bar); STAMP((k) + 1); } while (0)
    STAMP(0);
    const float* x_in = args.in[0]; const float* mem = args.in[1];
    float* out = args.out;
    float* ROPE = (float*)(ws + WS_ROPE); float* SSQ = (float*)(ws + WS_SSQ); float* LSE = (float*)(ws + WS_LSE);
    bf16* MKV = (bf16*)(ws + WS_MKV); bf16* MEMN = (bf16*)(ws + WS_MEMN); bf16* XB = (bf16*)(ws + WS_XB);
    bf16* ZQ = (bf16*)(ws + WS_ZQ); bf16* ZKV = (bf16*)(ws + WS_ZKV); bf16* ZG = (bf16*)(ws + WS_ZG); bf16* U = (bf16*)(ws + WS_U);
    const int gw = vcu * NWAVES + wave, NGW = G * NWAVES;

    if (IN(0)) {
        LAS float* scr = (LAS float*)(lds + RING_OFF + wave * 16384);
        const float* const* intab = (const float* const*)(ws + WS_PTRS);
        if (tid == 0) { const float** tb = (const float**)(ws + WS_PTRS);
            tb[0] = args.in[0]; tb[1] = args.in[1]; tb[2] = args.in[2]; tb[3] = args.in[3]; tb[4] = args.in[4]; tb[5] = args.in[5]; tb[6] = args.in[6];
            tb[7] = args.in[7]; tb[8] = args.in[8]; tb[9] = args.in[9]; tb[10] = args.in[10]; tb[11] = args.in[11]; tb[12] = args.in[12]; tb[13] = args.in[13]; }
        asm volatile("s_waitcnt vmcnt(0)" ::: "memory"); __syncthreads();
        for (int it = gw; it < I_EARLY; it += 2 * NGW) {
            const bool two = (it + NGW) < I_EARLY;
            const TrD d0 = tr_desc(intab, ws, it), d1 = tr_desc(intab, ws, two ? it + NGW : it);
            f32x4 v0[8], v1[8]; float g0[8], g1[8];
            tr_load(d0, v0, g0, lane); if (two) tr_load(d1, v1, g1, lane);
            tr_fin(d0, v0, g0, scr, lane); if (two) tr_fin(d1, v1, g1, scr, lane);
        }
        for (int it = gw; it < 2 * 1024; it += NGW) { const int l = it >> 10, n = it & 1023; bf16* p = (bf16*)(ws + WS_W + (size_t)l * W_LAYER + W_P) + (size_t)n * 1024 + 128;
            if (lane < 32) ((GAS v4u*)p)[lane] = (v4u){0u, 0u, 0u, 0u}; }
        for (int e = bx * (NWAVES * 64) + tid; e < SEQ * 8; e += G * NWAVES * 64) { const int pos = e >> 3, i = e & 7;
            const float invf = (float)(1.0 / pow(500000.0, (double)i / 8.0)); const float ang = (float)pos * invf;
            const double rev = (double)ang * 0.15915494309189535; const float fr_ = (float)(rev - floor(rev));
            const _Float16 ch = (_Float16)__builtin_amdgcn_cosf(fr_), sh = (_Float16)__builtin_amdgcn_sinf(fr_);
            ((unsigned*)ROPE)[pos * 8 + i] = (unsigned)__builtin_bit_cast(unsigned short, ch) | ((unsigned)__builtin_bit_cast(unsigned short, sh) << 16); }
        for (int m = gw; m < T; m += 2 * NGW) { const int m1 = m + NGW;
            const GAS f32x4* xr = (const GAS f32x4*)(x_in + (size_t)m * D) + lane; const GAS f32x4* xr1 = (const GAS f32x4*)(x_in + (size_t)m1 * D) + lane; f32x4 v[4], w[4]; float s = 0.f, s1 = 0.f;
#pragma unroll
            for (int j = 0; j < 4; ++j) { v[j] = __builtin_nontemporal_load(xr + 64 * j); w[j] = __builtin_nontemporal_load(xr1 + 64 * j); }
#pragma unroll
            for (int j = 0; j < 4; ++j) { s += (v[j].x * v[j].x + v[j].y * v[j].y) + (v[j].z * v[j].z + v[j].w * v[j].w); s1 += (w[j].x * w[j].x + w[j].y * w[j].y) + (w[j].z * w[j].z + w[j].w * w[j].w); }
            s = wave_sum(s); s1 = wave_sum(s1);
            GAS unsigned long long* o8 = (GAS unsigned long long*)(XB + (size_t)m * D) + lane; GAS unsigned long long* o81 = (GAS unsigned long long*)(XB + (size_t)m1 * D) + lane;
#pragma unroll
            for (int j = 0; j < 4; ++j) { o8[64 * j] = (unsigned long long)pk2(v[j].x, v[j].y) | ((unsigned long long)pk2(v[j].z, v[j].w) << 32); o81[64 * j] = (unsigned long long)pk2(w[j].x, w[j].y) | ((unsigned long long)pk2(w[j].z, w[j].w) << 32); }
            if (lane < 4) { SSQ[(size_t)m * 4 + lane] = (lane == 0) ? s : 0.f; SSQ[(size_t)m1 * 4 + lane] = (lane == 0) ? s1 : 0.f; } }
        for (int m = gw; m < NMEMROWS; m += NGW) { const GAS f32x4* xr = (const GAS f32x4*)(mem + (size_t)m * D) + lane; f32x4 v[4]; float s = 0.f;
#pragma unroll
            for (int j = 0; j < 4; ++j) { v[j] = __builtin_nontemporal_load(xr + 64 * j); s += (v[j].x * v[j].x + v[j].y * v[j].y) + (v[j].z * v[j].z + v[j].w * v[j].w); }
            const float rstd = 1.0f / sqrtf(wave_sum(s) * (1.0f / 1024.0f) + 1e-6f);
            GAS unsigned long long* o8 = (GAS unsigned long long*)(MEMN + (size_t)m * D) + lane;
#pragma unroll
            for (int j = 0; j < 4; ++j) o8[64 * j] = (unsigned long long)pk2(v[j].x * rstd, v[j].y * rstd) | ((unsigned long long)pk2(v[j].z * rstd, v[j].w * rstd) << 32); }
    }
    SEAM(0);

    for (int l = 0; l < 2; ++l) {
        const int pb = 1 + 7 * l;
        unsigned char* wl = ws + WS_W + (size_t)l * W_LAYER;
        const bf16* WIN_t = (const bf16*)(wl + W_IN); const bf16* WUP_t = (const bf16*)(wl + W_UP); const bf16* WDN_t = (const bf16*)(wl + W_DN);
        const bf16* WO_t = (const bf16*)(wl + W_O); const bf16* WP_t = (const bf16*)(wl + W_P); const bf16* WMKV_t = (const bf16*)(wl + W_MKV);
        float* KSUM = (float*)(ws + WS_KSUM) + (size_t)l * 64 * 6 * 64;
        if (IN(pb + 0)) {
            { pg8::Gemm g{XB, WIN_t, 1024, 1024, 1024, nullptr, nullptr}; pg8::StaticOrder S; S.init(T, NQKV, G, bx);
              pg8::EpiQKV E{ZQ, ZKV, SSQ, (const unsigned*)ROPE, KSUM};
              pg8::gemm_phase<pg8::EpiQKV, pg8::StaticOrder, true, true>(lds + RING_OFF, g, S, E); }
            { pg8::Gemm g{MEMN, WMKV_t, 1024, 1024, 1024, nullptr, nullptr}; pg8::StaticOrder S; S.init(NMEMROWS, 512, G, (bx + 128) % G);
              pg8::EpiPlain E{MKV, 512};
              pg8::gemm_phase<pg8::EpiPlain, pg8::StaticOrder, true, true>(lds + RING_OFF, g, S, E); }
        }
        const int conv0 = (G > 160) ? 144 : 0;
        if (IN(pb + 0) && bx >= conv0) {
            LAS float* scr = (LAS float*)(lds + RING_OFF + wave * 16384);
            int tl_ = threadIdx.x; asm volatile("" : "+v"(tl_)); const int ln = tl_ & 63;
            const int rank = (bx - conv0) * NWAVES + wave, nrank = (G - conv0) * NWAVES; const float* const* intab2 = (const float* const*)(ws + WS_PTRS);
            const int it_lo = (l == 0) ? I_EARLY : I_LAYER + I_EARLY, it_hi = (l == 0) ? I_LAYER + I_EARLY : 2 * I_LAYER;
            for (int it = it_lo + rank; it < it_hi; it += 2 * nrank) {
                const bool two = (it + nrank) < it_hi;
                const TrD d0 = tr_desc(intab2, ws, it), d1 = tr_desc(intab2, ws, two ? it + nrank : it);
                f32x4 v0[8], v1[8]; float g0[8], g1[8];
                tr_load(d0, v0, g0, ln); tr_load(d1, v1, g1, ln);
                tr_fin(d0, v0, g0, scr, ln); if (two) tr_fin(d1, v1, g1, scr, ln);
            }
        }
        SEAM(pb + 0);
        if (IN(pb + 1)) {
            unsigned* qcnt = (unsigned*)(ctl + CW_QUEUE + 64 * l);
            for (;;) {
                if (threadIdx.x == 0) MISC[16] = __hip_atomic_fetch_add(qcnt, 1u, __ATOMIC_RELAXED, __HIP_MEMORY_SCOPE_AGENT);
                __syncthreads();
                const int idx = (int)MISC[16];
                if (idx >= att::N_UNITS) break;
                att::Unit au; att::make_unit(idx, au, ZQ, ZKV, MKV, KSUM, LSE);
                if (au.kind == 0) att::run_unit<0>(lds + RING_OFF, au); else if (au.kind == 1) att::run_unit<1>(lds + RING_OFF, au); else att::run_unit<2>(lds + RING_OFF, au);
            }
        }
        SEAM(pb + 1);
        if (IN(pb + 2)) {
            { int tl_ = threadIdx.x; asm volatile("" : "+v"(tl_)); const int ln = tl_ & 63, h = ln >> 5, c = 2 * (ln & 31);
              for (int row = gw; row < T; row += NGW) {
                const float l0 = LSE[(size_t)row * 6 + h], l1 = LSE[(size_t)row * 6 + 2 + h], l2 = LSE[(size_t)row * 6 + 4 + h];
                bf16* zr = ZQ + (size_t)row * 1024;
                const unsigned a0 = *(const GAS unsigned*)(zr + h * 64 + c), a1 = *(const GAS unsigned*)(zr + (2 + h) * 64 + c), a2 = *(const GAS unsigned*)(zr + (4 + h) * 64 + c);
                const float mx = fmaxf(l0, fmaxf(l1, l2));
                float w0 = __builtin_amdgcn_exp2f(l0 - mx), w1 = __builtin_amdgcn_exp2f(l1 - mx), w2 = __builtin_amdgcn_exp2f(l2 - mx);
                const float inv = 1.0f / (w0 + w1 + w2); w0 *= inv; w1 *= inv; w2 *= inv;
                const float lo = w0 * __uint_as_float(a0 << 16) + w1 * __uint_as_float(a1 << 16) + w2 * __uint_as_float(a2 << 16);
                const float hi_ = w0 * __uint_as_float(a0 & 0xffff0000u) + w1 * __uint_as_float(a1 & 0xffff0000u) + w2 * __uint_as_float(a2 & 0xffff0000u);
                const unsigned res = pk2(lo, hi_);
                asm volatile("s_waitcnt vmcnt(0)" ::: "memory");
                *(GAS unsigned*)(zr + h * 64 + c) = res; *(GAS unsigned*)(zr + 128 + 2 * ln) = 0u;
              } }
        }
        SEAM(pb + 2);
        if (IN(pb + 3)) {
            pg8::GateProjOrder S; S.init(T, D, G, bx);
            pg8::Gemm g{XB, WIN_t + (size_t)NQKV * 1024, 1024, 1024, 1024, ZQ, WP_t}; pg8::EpiGateProj E{ZG, SSQ};
            pg8::gemm_phase<pg8::EpiGateProj, pg8::GateProjOrder, true, true>(lds + RING_OFF, g, S, E);
        }
        SEAM(pb + 3);
        if (IN(pb + 4)) {
            pg8::Gemm g{ZG, WO_t, 3072, 1024, 1024, nullptr, nullptr}; pg8::StaticOrder S; S.init(T, D, G, bx);
            pg8::EpiRes E{XB, SSQ};
            pg8::gemm_phase<pg8::EpiRes, pg8::StaticOrder, false, true>(lds + RING_OFF, g, S, E);
        }
        SEAM(pb + 4);
        if (IN(pb + 5)) {
            pg8::Gemm g{XB, WUP_t, 1024, 1024, 1024, nullptr, nullptr}; pg8::StaticOrder S; S.init(T, FF, G, bx);
            pg8::EpiUp E{U, SSQ};
            pg8::gemm_phase<pg8::EpiUp, pg8::StaticOrder, true, true>(lds + RING_OFF, g, S, E);
        }
        SEAM(pb + 5);
        if (IN(pb + 6)) {
            pg8::Gemm g{U, WDN_t, 4096, 4096, 4096, nullptr, nullptr}; pg8::StaticOrder S; S.init(T, D, G, bx);
            if (l == 0) { pg8::EpiRes E{XB, SSQ}; pg8::gemm_phase<pg8::EpiRes, pg8::StaticOrder, false, true>(lds + RING_OFF, g, S, E); }
            else { pg8::EpiFinal E{XB, SSQ, out, args.in[13], &bar}; pg8::gemm_phase<pg8::EpiFinal, pg8::StaticOrder, false, true>(lds + RING_OFF, g, S, E); }
        }
#if MK_PROBE
        SEAM(pb + 6);
#else
        if (l == 0) SEAM(pb + 6);
#endif
    }
#if MK_PROBE
    if (IN(15)) {
        int tl_ = threadIdx.x; asm volatile("" : "+v"(tl_)); const int lane = tl_ & 63;
        const float pbv = (float)(__hip_atomic_load(TS + PROBE_B_HI, __ATOMIC_RELAXED, __HIP_MEMORY_SCOPE_AGENT) - __hip_atomic_load(TS + PROBE_B_LO, __ATOMIC_RELAXED, __HIP_MEMORY_SCOPE_AGENT)) * (PROBE_SCALE * 0.1f);
        for (int m = gw; m < T; m += NGW) { GAS f32x4* xr = (GAS f32x4*)(out + (size_t)m * D) + lane;
#pragma unroll
            for (int j = 0; j < 4; ++j) { f32x4 v = xr[64 * j]; v = v + pbv; xr[64 * j] = v; } }
        if (blockIdx.x == 0) { asm volatile("s_waitcnt vmcnt(0)" ::: "memory"); __syncthreads();
            const float pa = (float)(__hip_atomic_load(TS + PROBE_A_HI, __ATOMIC_RELAXED, __HIP_MEMORY_SCOPE_AGENT) - __hip_atomic_load(TS + PROBE_A_LO, __ATOMIC_RELAXED, __HIP_MEMORY_SCOPE_AGENT)) * PROBE_SCALE;
            if (threadIdx.x == 0) out[0] += pa; }
    }
#endif
#undef IN
#undef SEAM
}

extern "C" void kernel_launch(void* const* d_in, const int* in_sizes, int n_in, void* d_out, int out_size, void* d_ws, size_t ws_size, hipStream_t stream) {
    static int grid = 0;
    if (grid == 0) {
        if (n_in != 14 || in_sizes[0] != T * D || out_size != T * D || ws_size < WS_END) { fprintf(stderr, "kernel_launch: unexpected shapes (n_in %d, in0 %d, out %d, ws %zu)\n", n_in, n_in > 0 ? in_sizes[0] : -1, out_size, ws_size); grid = -1; return; }
        int dev = 0, cus = 0;
        if (hipGetDevice(&dev) != hipSuccess || hipDeviceGetAttribute(&cus, hipDeviceAttributeMultiprocessorCount, dev) != hipSuccess) { grid = -1; return; }
        if (hipFuncSetAttribute((const void*)mega, hipFuncAttributeMaxDynamicSharedMemorySize, LDS_BYTES) != hipSuccess) { fprintf(stderr, "kernel_launch: hipFuncSetAttribute failed\n"); grid = -1; return; }
        int per_cu = 0;
        (void)hipOccupancyMaxActiveBlocksPerMultiprocessor(&per_cu, (const void*)mega, NWAVES * 64, LDS_BYTES);
        (void)hipGetLastError();
        grid = cus;
    }
    if (grid < 0) return;
    (void)hipMemsetAsync((char*)d_ws + WS_CTL, 0, CTL_ZERO_BYTES, stream);
    Args a{};
    for (int i = 0; i < 14; ++i) a.in[i] = (const float*)d_in[i];
    a.out = (float*)d_out; a.ws = (unsigned char*)d_ws; a.li = 0; a.pad = 0;
#if MK_ONE_LAUNCH
    a.ph_lo = 0; a.ph_hi = N_PHASES;
    hipLaunchKernelGGL(mega, dim3(grid), dim3(NWAVES * 64), LDS_BYTES, stream, a);
#else
    for (int ph = 0; ph < N_PHASES; ++ph) {
        a.ph_lo = ph; a.ph_hi = ph + 1;
        hipLaunchKernelGGL(mega, dim3(grid), dim3(NWAVES * 64), LDS_BYTES, stream, a);
    }
#endif
}
```

```cpp
#include <hip/hip_runtime.h>
#include <cstdio>
#include <cstdint>
namespace pg8 {
#define PG8_LAS __attribute__((address_space(3)))
typedef unsigned short bf16_t;
typedef short bf16x8 __attribute__((ext_vector_type(8)));
typedef float f32x4 __attribute__((ext_vector_type(4)));
typedef unsigned u32x4 __attribute__((ext_vector_type(4)));
constexpr int BM = 256, BK = 64, HALF = 128, HTB = HALF * BK * 2  , STAGE_BYTES = 8 * HTB, NXCD = 8, WGM = 4;

__host__ __device__ __forceinline__ int lds_byte(int r, int c) { const int st = (r >> 4) * 2 + (c >> 5), rr = r & 15, cc = c & 31, ob = rr * 64 + cc * 2; return st * 1024 + (ob ^ (((ob >> 9) & 1) << 5)); }
__host__ __device__ __forceinline__ void stage_rc(int b, int& R, int& C) { const int st = b / 1024, sb = b % 1024, swz = sb ^ (((sb >> 9) & 1) << 5); R = (st >> 1) * 16 + swz / 64; C = (st & 1) * 32 + (swz % 64) / 2; }
__host__ __device__ __forceinline__ int perm32(int rho) { const int n = rho >> 4, i = rho & 15; return 8 * (i >> 2) + 4 * n + (i & 3); }

struct Unit { int pm, pn, k0, nt, br, pb, sel; };
struct Gemm { const bf16_t* A; const bf16_t* Bt; int lda, ldb, K; const bf16_t* A2; const bf16_t* Bt2; };

struct StaticOrder {
    static constexpr bool KSEG = false;
    __host__ __device__ static bool carry(const Unit&) { return false; }
    int nM, nN, nwg, G, c;
    __host__ __device__ void init(int M, int N, int G_, int c_) { nM = M / BM; nN = N / BM; nwg = nM * nN; G = G_; c = c_; }
    __host__ __device__ bool next(int i, Unit& u) const {
        const long L = (long)i * G + c; if (L >= nwg) return false;
        int wgid = (int)L; { const int q = nwg / NXCD, r = nwg % NXCD, xcd = wgid % NXCD, off = wgid / NXCD; wgid = (xcd < r ? xcd * (q + 1) : r * (q + 1) + (xcd - r) * q) + off; }
        const int nig = WGM * nN, gid = wgid / nig, fm = gid * WGM, gsz = (nM - fm) < WGM ? (nM - fm) : WGM;
        u.pm = fm + ((wgid % nig) % gsz); u.pn = (wgid % nig) / gsz; u.k0 = 0; u.nt = 0; u.br = 0; u.pb = u.pn; u.sel = 0; return true;
    }
    __device__ __forceinline__ void a_ready(const Unit&) const {}
    __device__ __forceinline__ void done(const Unit&) const {}
};

typedef float f32x2c_t __attribute__((ext_vector_type(2))); typedef __bf16 bf16x2c_t __attribute__((ext_vector_type(2)));
__device__ __forceinline__ unsigned cvt_pk_bf16(float lo, float hi) { const f32x2c_t v = {lo, hi}; const bf16x2c_t b = __builtin_convertvector(v, bf16x2c_t); return __builtin_bit_cast(unsigned, b); }
typedef float f32x2 __attribute__((ext_vector_type(2)));
template <class Epi, class Sched, bool ALIGN_EPI = false, bool SP2 = false>
__device__ __forceinline__ void gemm_phase(PG8_LAS unsigned char* lds, const Gemm g, const Sched& S, const Epi& E) {
    int tid_ = threadIdx.x; asm volatile("" : "+v"(tid_));
    const int tid = tid_, wid = __builtin_amdgcn_readfirstlane(tid >> 6), lane = tid & 63, wr = wid >> 2, wc = wid & 3, fr = lane & 15, fq = lane >> 4;
    const int K = g.K; int nt = K / BK;
    unsigned voffA[2], voffB[2];
#pragma unroll
    for (int i = 0; i < 2; ++i) { int R, C; stage_rc(tid * 16 + i * 8192, R, C); const int Rb = Epi::PERM ? ((R & ~31) + perm32(R & 31)) : R;
        voffA[i] = (unsigned)(R * g.lda + C) * 2u; voffB[i] = (unsigned)(Rb * g.ldb + C) * 2u; }
    const size_t kstep = (size_t)(BK * 2);
    const size_t hstepA = (size_t)HALF * g.lda * 2, hstepB = (size_t)HALF * g.ldb * 2;
    const size_t tstepA = 2 * hstepA, tstepB = 2 * hstepB;
    const unsigned ldsw = (unsigned)wid * 1024u;
    const int aoff = lds_byte(wr * 64 + fr, fq * 8), boff = lds_byte(wc * 32 + fr, fq * 8);
#define PG8_SA(b, h) (((b) * 2 + (h)) * HTB)
#define PG8_SB(b, h) ((4 + (b) * 2 + (h)) * HTB)
#define PG8_STAGE(bufoff, gbase, voff) do { _Pragma("unroll") for (int _i = 0; _i < 2; ++_i) \
        __builtin_amdgcn_global_load_lds((const unsigned*)((const char*)(gbase) + (voff)[_i]), (PG8_LAS unsigned*)(lds + (bufoff) + ldsw + _i * 8192), 16, 0, 0); } while (0)
#define PG8_LDA(dst, b, h) do { _Pragma("unroll") for (int m = 0; m < 4; ++m) _Pragma("unroll") for (int k = 0; k < 2; ++k) dst[m][k] = *(const PG8_LAS bf16x8*)(lds + PG8_SA(b, h) + aoff + m * 2048 + k * 1024); } while (0)
#define PG8_LDB(dst, b, h) do { _Pragma("unroll") for (int n = 0; n < 2; ++n) _Pragma("unroll") for (int k = 0; k < 2; ++k) dst[n][k] = *(const PG8_LAS bf16x8*)(lds + PG8_SB(b, h) + boff + n * 2048 + k * 1024); } while (0)
#define PG8_MMA(ai, bj, At, Bt) do { __builtin_amdgcn_s_setprio(1); _Pragma("unroll") for (int m = 0; m < 4; ++m) _Pragma("unroll") for (int n = 0; n < 2; ++n) _Pragma("unroll") for (int k = 0; k < 2; ++k) \
        acc[ai][bj][m][n] = __builtin_amdgcn_mfma_f32_16x16x32_bf16(Bt[n][k], At[m][k], acc[ai][bj][m][n], 0, 0, 0); __builtin_amdgcn_s_setprio(0); } while (0)
#define PG8_WAIT_V(n) asm volatile("s_waitcnt vmcnt(" #n ")" ::: "memory")
#define PG8_WAIT_L(n) asm volatile("s_waitcnt lgkmcnt(" #n ")" ::: "memory")
#define PG8_BAR __builtin_amdgcn_s_barrier()
#define PG8_SCHED __builtin_amdgcn_sched_barrier(0)
    Unit cur, nxt; int ui = 0;
    if (!S.next(0, cur)) return;
    f32x4 acc[2][2][4][2];
#pragma unroll
    for (int a = 0; a < 2; ++a)
#pragma unroll
        for (int b = 0; b < 2; ++b)
#pragma unroll
            for (int m = 0; m < 4; ++m)
#pragma unroll
                for (int n = 0; n < 2; ++n) acc[a][b][m][n] = (f32x4){0.f, 0.f, 0.f, 0.f};
    bf16x8 At[4][2], B0[2][2], B1[2][2];
    if constexpr (Sched::KSEG) nt = cur.nt;
    const char* cA = (const char*)((Sched::KSEG && cur.sel) ? g.A2 : g.A) + (size_t)cur.pm * tstepA + (Sched::KSEG ? (size_t)cur.k0 * 2 : 0); const char* cB = (const char*)((Sched::KSEG && cur.sel) ? g.Bt2 : g.Bt) + (size_t)cur.pb * tstepB + (Sched::KSEG ? (size_t)cur.k0 * 2 : 0);
    S.a_ready(cur);
    if constexpr (SP2) {
        PG8_STAGE(PG8_SB(0, 0), cB, voffB); PG8_STAGE(PG8_SB(0, 1), cB + hstepB, voffB); PG8_STAGE(PG8_SA(0, 0), cA, voffA); PG8_STAGE(PG8_SA(0, 1), cA + hstepA, voffA);
        if (wr == 1) PG8_BAR;
        PG8_WAIT_V(2); PG8_BAR;
        PG8_STAGE(PG8_SB(1, 0), cB + kstep, voffB); PG8_STAGE(PG8_SA(1, 0), cA + kstep, voffA); PG8_STAGE(PG8_SB(1, 1), cB + hstepB + kstep, voffB);
        PG8_WAIT_V(6); PG8_BAR;
    } else {
        PG8_STAGE(PG8_SB(0, 0), cB, voffB); PG8_STAGE(PG8_SA(0, 0), cA, voffA); PG8_STAGE(PG8_SB(0, 1), cB + hstepB, voffB); PG8_STAGE(PG8_SA(0, 1), cA + hstepA, voffA);
        if (wr == 1) PG8_BAR;
        PG8_WAIT_V(4); PG8_BAR;
        PG8_STAGE(PG8_SB(1, 0), cB + kstep, voffB); PG8_STAGE(PG8_SA(1, 0), cA + kstep, voffA); PG8_STAGE(PG8_SB(1, 1), cB + hstepB + kstep, voffB);
        PG8_WAIT_V(6); PG8_BAR;
    }
    for (;;) {
        const bool has_next = S.next(ui + 1, nxt);
        const char* nA = has_next ? (const char*)((Sched::KSEG && nxt.sel) ? g.A2 : g.A) + (size_t)nxt.pm * tstepA + (Sched::KSEG ? (size_t)nxt.k0 * 2 : 0) : cA; const char* nB = has_next ? (const char*)((Sched::KSEG && nxt.sel) ? g.Bt2 : g.Bt) + (size_t)nxt.pb * tstepB + (Sched::KSEG ? (size_t)nxt.k0 * 2 : 0) : cB;
        for (int t = 0; t < nt; t += 2) {
            const bool last = (t == nt - 2);
            const char* a1 = cA + (size_t)(t + 1) * kstep;
            const char* a2 = last ? nA : cA + (size_t)(t + 2) * kstep; const char* b2 = last ? nB : cB + (size_t)(t + 2) * kstep;
            const char* a3 = a2 + kstep; const char* b3 = b2 + kstep;
            if (last && has_next) S.a_ready(nxt);
            if constexpr (SP2) {
            PG8_LDB(B0, 0, 0); PG8_LDB(B1, 0, 1); PG8_SCHED; PG8_LDA(At, 0, 0); PG8_STAGE(PG8_SA(1, 1), a1 + hstepA, voffA);
            PG8_WAIT_V(8); PG8_WAIT_L(0); PG8_BAR; PG8_MMA(0, 0, At, B0); PG8_MMA(0, 1, At, B1); PG8_BAR; PG8_SCHED;
            PG8_LDA(At, 0, 1); PG8_STAGE(PG8_SB(0, 0), b2, voffB); PG8_STAGE(PG8_SB(0, 1), b2 + hstepB, voffB); PG8_STAGE(PG8_SA(0, 0), a2, voffA);
            PG8_WAIT_V(8); PG8_WAIT_L(0); PG8_BAR; PG8_MMA(1, 0, At, B0); PG8_MMA(1, 1, At, B1); PG8_BAR; PG8_SCHED;
            PG8_LDB(B0, 1, 0); PG8_LDB(B1, 1, 1); PG8_SCHED; PG8_LDA(At, 1, 0); PG8_STAGE(PG8_SA(0, 1), a2 + hstepA, voffA);
            PG8_WAIT_V(8); PG8_WAIT_L(0); PG8_BAR; PG8_MMA(0, 0, At, B0); PG8_MMA(0, 1, At, B1); PG8_BAR; PG8_SCHED;
            PG8_LDA(At, 1, 1); PG8_STAGE(PG8_SB(1, 0), b3, voffB); PG8_STAGE(PG8_SB(1, 1), b3 + hstepB, voffB); PG8_STAGE(PG8_SA(1, 0), a3, voffA);
            PG8_WAIT_V(8); PG8_WAIT_L(0); PG8_BAR; PG8_MMA(1, 0, At, B0); PG8_MMA(1, 1, At, B1); PG8_BAR; PG8_SCHED;
            } else {
            PG8_LDB(B0, 0, 0); PG8_SCHED; PG8_LDA(At, 0, 0); PG8_STAGE(PG8_SA(1, 1), a1 + hstepA, voffA);
            PG8_WAIT_L(8); PG8_BAR; PG8_WAIT_L(0); PG8_MMA(0, 0, At, B0); PG8_BAR; PG8_SCHED;
            PG8_LDB(B1, 0, 1); PG8_STAGE(PG8_SB(0, 0), b2, voffB);
            PG8_BAR; PG8_WAIT_L(0); PG8_MMA(0, 1, At, B1); PG8_BAR;
            PG8_LDA(At, 0, 1); PG8_STAGE(PG8_SA(0, 0), a2, voffA);
            PG8_BAR; PG8_WAIT_L(0); PG8_MMA(1, 0, At, B0); PG8_BAR; PG8_SCHED;
            PG8_STAGE(PG8_SB(0, 1), b2 + hstepB, voffB);
            PG8_WAIT_V(6); PG8_BAR; PG8_MMA(1, 1, At, B1); PG8_BAR;
            PG8_LDB(B0, 1, 0); PG8_SCHED; PG8_LDA(At, 1, 0); PG8_STAGE(PG8_SA(0, 1), a2 + hstepA, voffA);
            PG8_WAIT_L(8); PG8_BAR; PG8_WAIT_L(0); PG8_MMA(0, 0, At, B0); PG8_BAR; PG8_SCHED;
            PG8_LDB(B1, 1, 1); PG8_STAGE(PG8_SB(1, 0), b3, voffB);
            PG8_BAR; PG8_WAIT_L(0); PG8_MMA(0, 1, At, B1); PG8_BAR;
            PG8_LDA(At, 1, 1); PG8_STAGE(PG8_SA(1, 0), a3, voffA);
            PG8_BAR; PG8_WAIT_L(0); PG8_MMA(1, 0, At, B0); PG8_BAR; PG8_SCHED;
            PG8_STAGE(PG8_SB(1, 1), b3 + hstepB, voffB);
            PG8_WAIT_V(6); PG8_BAR; PG8_MMA(1, 1, At, B1); PG8_BAR;
            }
        }
        if constexpr (ALIGN_EPI) { if (wr == 0) PG8_BAR; }
        if constexpr (!Epi::AFTER_DRAIN) { int te_ = threadIdx.x; asm volatile("" : "+v"(te_) :: "memory");     E(acc, cur, wr, wc, te_ & 15, (te_ & 63) >> 4); S.done(cur); }
        if (!has_next) break;
        if (!Sched::carry(cur)) {
#pragma unroll
        for (int a = 0; a < 2; ++a)
#pragma unroll
            for (int b = 0; b < 2; ++b)
#pragma unroll
                for (int m = 0; m < 4; ++m)
#pragma unroll
                    for (int n = 0; n < 2; ++n) acc[a][b][m][n] = (f32x4){0.f, 0.f, 0.f, 0.f};
        }
        cur = nxt; cA = nA; cB = nB; ++ui; if constexpr (Sched::KSEG) nt = cur.nt;
        if constexpr (ALIGN_EPI) { if (wr == 1) PG8_BAR; }
    }
    PG8_WAIT_V(0);
    if constexpr (!ALIGN_EPI) { if (wr == 0) PG8_BAR; }
    PG8_BAR;
    if constexpr (Epi::AFTER_DRAIN) { E.fused(acc, cur, wr, wc, fr, fq, lds, wid, lane); S.done(cur); }
#undef PG8_SA
#undef PG8_SB
#undef PG8_STAGE
#undef PG8_LDA
#undef PG8_LDB
#undef PG8_MMA
#undef PG8_WAIT_V
#undef PG8_WAIT_L
#undef PG8_BAR
#undef PG8_SCHED
}
}
namespace pg8 {
__device__ __forceinline__ float row_rstd(const float* ssq, int row) {
    const f32x4 a = *(const f32x4*)(ssq + (size_t)row * 4);
    return 1.0f / sqrtf(((a[0] + a[1]) + (a[2] + a[3])) * (1.0f / 1024.0f) + 1e-6f);
}
__device__ __forceinline__ void rstd8(const float* ssq, int row0, int, float (&rs)[8]) {
    f32x4 q[8];
#pragma unroll
    for (int i = 0; i < 8; ++i) q[i] = *(const f32x4*)(ssq + (size_t)(row0 + (i >> 2) * HALF + (i & 3) * 16) * 4);
#pragma unroll
    for (int i = 0; i < 8; ++i) { const float t = (q[i][0] + q[i][1]) + (q[i][2] + q[i][3]); rs[i] = __builtin_amdgcn_rsqf(t * (1.0f / 1024.0f) + 1e-6f); }
}
__device__ __forceinline__ float xsum32(float v) { const auto r = __builtin_amdgcn_permlane32_swap(__float_as_uint(v), __float_as_uint(v), false, false); return __uint_as_float(r[0]) + __uint_as_float(r[1]); }
__device__ __forceinline__ float xsum16(float v) { const auto r = __builtin_amdgcn_permlane16_swap(__float_as_uint(v), __float_as_uint(v), false, false); return __uint_as_float(r[0]) + __uint_as_float(r[1]); }
__device__ __forceinline__ float xmax32(float v) { const auto r = __builtin_amdgcn_permlane32_swap(__float_as_uint(v), __float_as_uint(v), false, false); return __builtin_fmaxf(__uint_as_float(r[0]), __uint_as_float(r[1])); }
__device__ __forceinline__ float partner16(float v, bool odd16) { const auto r = __builtin_amdgcn_permlane16_swap(__float_as_uint(v), __float_as_uint(v), false, false); return __uint_as_float(odd16 ? r[0] : r[1]); }
__device__ __forceinline__ void store_wt(void* p, u32x4 v) { asm volatile("global_store_dwordx4 %0, %1, off sc1\n\ts_nop 1" :: "v"(p), "v"(v) : "memory"); }
__device__ __forceinline__ u32x4 pack8(const float (&v)[8]) { u32x4 w; w.x = cvt_pk_bf16(v[0], v[1]); w.y = cvt_pk_bf16(v[2], v[3]); w.z = cvt_pk_bf16(v[4], v[5]); w.w = cvt_pk_bf16(v[6], v[7]); return w; }
__device__ __forceinline__ void unpack8(const u32x4 w, float (&v)[8]) {
    v[0] = __uint_as_float(w.x << 16); v[1] = __uint_as_float(w.x & 0xffff0000u); v[2] = __uint_as_float(w.y << 16); v[3] = __uint_as_float(w.y & 0xffff0000u);
    v[4] = __uint_as_float(w.z << 16); v[5] = __uint_as_float(w.z & 0xffff0000u); v[6] = __uint_as_float(w.w << 16); v[7] = __uint_as_float(w.w & 0xffff0000u);
}
#define PG8_V8(v, a, b, sc) do { v[0] = a[0] * (sc); v[1] = a[1] * (sc); v[2] = a[2] * (sc); v[3] = a[3] * (sc); v[4] = b[0] * (sc); v[5] = b[1] * (sc); v[6] = b[2] * (sc); v[7] = b[3] * (sc); } while (0)

struct EpiQKV {
    static constexpr bool PERM = true, AFTER_DRAIN = false;
    bf16_t* ZQ; bf16_t* ZKV; const float* ssq; const unsigned* rope; float* ksum;
    template <int NB, bool KSUM> __device__ __forceinline__ void body(const f32x4 (&acc)[2][2][4][2], const Unit& u, int wr, int wc, int fr, int fq) const {
        const int row0 = u.pm * BM + wr * 64 + fr, colt = u.pn * BM;
        bf16_t* base; int ldc, cb;
        if (colt < 1024) { base = ZQ; ldc = 1024; cb = colt; } else { base = ZKV; ldc = 1536; cb = colt - 1024; }
        const int hg0 = (colt + wc * 32) >> 6;
        const bool half0 = (wc & 1) == 0;
        const bool rope0 = (hg0 < 12) || (hg0 >= 16 && hg0 < 22) || (hg0 >= 28 && hg0 < 34), rope1 = (hg0 + 2 < 12) || (hg0 + 2 >= 16 && hg0 + 2 < 22) || (hg0 + 2 >= 28 && hg0 + 2 < 34);
        const bool anyrope = half0 && (rope0 || rope1);
        float rs[8]; rstd8(ssq, row0, fq, rs);
        asm volatile("" ::: "memory");
        float ks[2][8];
        if (KSUM) {
#pragma unroll
            for (int bj = 0; bj < 2; ++bj)
#pragma unroll
                for (int j = 0; j < 8; ++j) ks[bj][j] = 0.f; }
#pragma unroll
        for (int rb = 0; rb < 8; rb += NB) {
            u32x4 rt[NB][2];
            if (anyrope) {
#pragma unroll
                for (int i = 0; i < NB; ++i) { const int ri = rb + i; const u32x4* rp = (const u32x4*)(rope + (size_t)((row0 + (ri >> 2) * HALF + (ri & 3) * 16) & 2047) * 8);
                    rt[i][0] = rp[0]; rt[i][1] = rp[1]; } }
#pragma unroll
            for (int i = 0; i < NB; ++i) {
                const int ri = rb + i, ai = ri >> 2, m = ri & 3;
                const int row = row0 + ai * HALF + m * 16;
                const float rstd = rs[ri];
#pragma unroll
                for (int bj = 0; bj < 2; ++bj) {
                    const int hg = hg0 + 2 * bj;
                    const bool isrope = bj == 0 ? rope0 : rope1;
                    float v[8]; PG8_V8(v, acc[ai][bj][m][0], acc[ai][bj][m][1], rstd);
                    if (isrope && half0) {
                        float p[8];
#pragma unroll
                        for (int j = 0; j < 8; ++j) p[j] = partner16(v[j], (fq & 1) != 0);
                        if (fq < 2) { const float sg = (fq == 0) ? -1.f : 1.f;
#pragma unroll
                            for (int j = 0; j < 8; ++j) { const unsigned w = rt[i][j >> 2][j & 3]; const float cs = (float)__builtin_bit_cast(_Float16, (unsigned short)(w & 0xffffu)), sn = (float)__builtin_bit_cast(_Float16, (unsigned short)(w >> 16));
                                v[j] = v[j] * cs + sg * (p[j] * sn); } }
                    }
                    if (hg < 16) {
#pragma unroll
                        for (int j = 0; j < 8; ++j) v[j] *= 0.18033688011112042f; }
                    *(u32x4*)(base + ((unsigned)row * (unsigned)ldc + (unsigned)(cb + bj * HALF + wc * 32 + 8 * fq))) = pack8(v);
                    if (KSUM) { if (hg >= 28 && hg < 34) {
#pragma unroll
                        for (int j = 0; j < 8; ++j) ks[bj][j] += v[j]; } }
                }
            }
        }
        if (KSUM) {
#pragma unroll
            for (int bj = 0; bj < 2; ++bj) { const int hg = hg0 + 2 * bj;
                if (hg >= 28 && hg < 34) {
                    float* kp = ksum + (size_t)(u.pm * 6 + (hg - 28)) * 64 + (wc & 1) * 32 + 8 * fq;
#pragma unroll
                    for (int j = 0; j < 8; ++j) { float s = ks[bj][j]; s += __shfl_xor(s, 1); s += __shfl_xor(s, 2); s += __shfl_xor(s, 4); s += __shfl_xor(s, 8);
                        if (fr == 0) atomicAdd(kp + j, s); }
                } }
        }
    }
    __device__ __forceinline__ void operator()(const f32x4 (&acc)[2][2][4][2], const Unit& u, int wr, int wc, int fr, int fq) const {
        if (u.pn == 7 || u.pn == 8) body<4, true>(acc, u, wr, wc, fr, fq); else body<4, false>(acc, u, wr, wc, fr, fq);
    }
};
struct EpiGate {
    static constexpr bool PERM = true, AFTER_DRAIN = false;
    bf16_t* ZG; const float* ssq;
    __device__ __forceinline__ void operator()(const f32x4 (&acc)[2][2][4][2], const Unit& u, int wr, int wc, int fr, int fq) const {
        const int row0 = u.pm * BM + wr * 64 + fr, col0 = u.pn * BM + wc * 32 + 8 * fq;
        float rs[8]; rstd8(ssq, row0, fq, rs);
#pragma unroll
        for (int ai = 0; ai < 2; ++ai)
#pragma unroll
            for (int m = 0; m < 4; ++m) { const int row = row0 + ai * HALF + m * 16; const float rstd = rs[ai * 4 + m];
#pragma unroll
                for (int bj = 0; bj < 2; ++bj) { float v[8]; PG8_V8(v, acc[ai][bj][m][0], acc[ai][bj][m][1], rstd);
#pragma unroll
                    for (int j = 0; j < 8; ++j) v[j] = __builtin_amdgcn_rcpf(1.0f + __builtin_amdgcn_exp2f(v[j] * -1.4426950408889634f));
                    *(u32x4*)(ZG + (size_t)row * 3072 + col0 + bj * HALF) = pack8(v); } }
    }
};
struct EpiPlain {
    static constexpr bool PERM = true, AFTER_DRAIN = false;
    bf16_t* O; int ldc;
    __device__ __forceinline__ void operator()(const f32x4 (&acc)[2][2][4][2], const Unit& u, int wr, int wc, int fr, int fq) const {
        const int row0 = u.pm * BM + wr * 64 + fr, col0 = u.pn * BM + wc * 32 + 8 * fq;
#pragma unroll
        for (int ai = 0; ai < 2; ++ai)
#pragma unroll
            for (int m = 0; m < 4; ++m) { const int row = row0 + ai * HALF + m * 16;
#pragma unroll
                for (int bj = 0; bj < 2; ++bj) { float v[8]; PG8_V8(v, acc[ai][bj][m][0], acc[ai][bj][m][1], 1.0f);
                    *(u32x4*)(O + (size_t)row * ldc + col0 + bj * HALF) = pack8(v); } }
    }
};
template <int BR> struct EpiProj {
    static constexpr bool PERM = true, AFTER_DRAIN = false;
    bf16_t* ZG;
    __device__ __forceinline__ void operator()(const f32x4 (&acc)[2][2][4][2], const Unit& u, int wr, int wc, int fr, int fq) const {
        const int row0 = u.pm * BM + wr * 64 + fr, col0 = u.pn * BM + wc * 32 + 8 * fq;
#pragma unroll
        for (int ai = 0; ai < 2; ++ai)
#pragma unroll
            for (int m = 0; m < 4; ++m) { const int row = row0 + ai * HALF + m * 16;
#pragma unroll
                for (int bj = 0; bj < 2; ++bj) { bf16_t* yp = ZG + (size_t)row * 3072 + col0 + bj * HALF;
                    float g[8], v[8]; unpack8(*(const u32x4*)(yp + BR * 1024), g); PG8_V8(v, acc[ai][bj][m][0], acc[ai][bj][m][1], 1.0f);
                    if (BR > 0) { float y[8]; unpack8(*(const u32x4*)yp, y);
#pragma unroll
                        for (int j = 0; j < 8; ++j) v[j] = y[j] + g[j] * v[j]; }
                    else {
#pragma unroll
                        for (int j = 0; j < 8; ++j) v[j] = g[j] * v[j]; }
                    *(u32x4*)yp = pack8(v); } }
    }
};
struct GateProjOrder : StaticOrder {
    static constexpr bool KSEG = true;
    __host__ __device__ static bool carry(const Unit& u) { return u.br == 3 || u.br == 4; }
    __host__ __device__ bool next(int i, Unit& u) const {
        if (!StaticOrder::next(i / 6, u)) return false;
        const int sg = i % 6; u.br = sg;
        if (sg < 3) { u.sel = 0; u.pb = 4 * sg + u.pn; u.k0 = 0; u.nt = 16; }
        else { u.sel = 1; u.pb = u.pn; u.k0 = (sg == 3) ? 0 : (sg == 4) ? 384 : 768; u.nt = (sg == 3) ? 2 : (sg == 4) ? 6 : 4; }
        return true;
    }
};
struct EpiGateProj {
    static constexpr bool PERM = true, AFTER_DRAIN = false;
    bf16_t* ZG; const float* ssq;
    __device__ __forceinline__ void operator()(f32x4 (&acc)[2][2][4][2], const Unit& u, int wr, int wc, int fr, int fq) const {
        const int row0 = u.pm * BM + wr * 64 + fr, col0 = u.pn * BM + wc * 32 + 8 * fq;
        const unsigned o0 = (unsigned)row0 * 3072u + (unsigned)col0;
        if (u.br < 3) {
            float rs[8]; rstd8(ssq, row0, fq, rs);
            const unsigned og = o0 + (unsigned)u.br * 1024u;
#pragma unroll
            for (int ai = 0; ai < 2; ++ai)
#pragma unroll
                for (int m = 0; m < 4; ++m) { const float rstd = rs[ai * 4 + m];
#pragma unroll
                    for (int bj = 0; bj < 2; ++bj) { float v[8]; PG8_V8(v, acc[ai][bj][m][0], acc[ai][bj][m][1], rstd);
#pragma unroll
                        for (int j = 0; j < 8; ++j) v[j] = __builtin_amdgcn_rcpf(1.0f + __builtin_amdgcn_exp2f(v[j] * -1.4426950408889634f));
                        store_wt(ZG + (og + (unsigned)((ai * HALF + m * 16) * 3072 + bj * HALF)), pack8(v)); } }
        } else if (u.br == 5) {
#pragma unroll
            for (int ai = 0; ai < 2; ++ai) {
                u32x4 g2[4][2];
#pragma unroll
                for (int m = 0; m < 4; ++m)
#pragma unroll
                    for (int bj = 0; bj < 2; ++bj) g2[m][bj] = *(const u32x4*)(ZG + (o0 + 2048u + (unsigned)((ai * HALF + m * 16) * 3072 + bj * HALF)));
#pragma unroll
                for (int m = 0; m < 4; ++m)
#pragma unroll
                    for (int bj = 0; bj < 2; ++bj) { float gn[8], v[8]; unpack8(g2[m][bj], gn); PG8_V8(v, acc[ai][bj][m][0], acc[ai][bj][m][1], 1.0f);
#pragma unroll
                        for (int j = 0; j < 8; ++j) v[j] = gn[j] * v[j];
                        store_wt(ZG + (o0 + (unsigned)((ai * HALF + m * 16) * 3072 + bj * HALF)), pack8(v)); }
            }
        }
        if (u.br == 3 || u.br == 4) {
            const unsigned on = o0 + (unsigned)(u.br - 3) * 1024u;
#pragma unroll
            for (int ai = 0; ai < 2; ++ai)
#pragma unroll
                for (int mp = 0; mp < 4; mp += 2) {
                    u32x4 gn_[2][2], gd_[2][2];
#pragma unroll
                    for (int mm = 0; mm < 2; ++mm)
#pragma unroll
                        for (int bj = 0; bj < 2; ++bj) { const unsigned o = on + (unsigned)((ai * HALF + (mp + mm) * 16) * 3072 + bj * HALF); gn_[mm][bj] = *(const u32x4*)(ZG + o); gd_[mm][bj] = *(const u32x4*)(ZG + (o + 1024u)); }
#pragma unroll
                    for (int mm = 0; mm < 2; ++mm)
#pragma unroll
                        for (int bj = 0; bj < 2; ++bj) { const int m = mp + mm; float gn[8], gd[8]; unpack8(gn_[mm][bj], gn); unpack8(gd_[mm][bj], gd);
#pragma unroll
                            for (int j = 0; j < 8; ++j) gn[j] = gn[j] * __builtin_amdgcn_rcpf(fmaxf(gd[j], 1e-30f));
                            acc[ai][bj][m][0] = acc[ai][bj][m][0] * (f32x4){gn[0], gn[1], gn[2], gn[3]}; acc[ai][bj][m][1] = acc[ai][bj][m][1] * (f32x4){gn[4], gn[5], gn[6], gn[7]};
                            asm volatile("" : "+v"(acc[ai][bj][m][0]), "+v"(acc[ai][bj][m][1])); }
                }
        }
    }
};
struct EpiRes {
    static constexpr bool PERM = true, AFTER_DRAIN = true;
    __device__ static bool stores16(const Unit&) { return true; }
    bf16_t* xb; float* ssq;
    __device__ __forceinline__ void fused(const f32x4 (&acc)[2][2][4][2], const Unit& u, int wr, int wc, int, int, PG8_LAS unsigned char* lds, int, int) const {
        int te_ = threadIdx.x; asm volatile("" : "+v"(te_) :: "memory"); const int fr = te_ & 15, fq = (te_ & 63) >> 4;
        const int row0 = u.pm * BM + wr * 64 + fr, col0 = u.pn * BM + wc * 32 + 8 * fq;
        const unsigned o0 = (unsigned)row0 * 1024u + (unsigned)col0;
        PG8_LAS float* P = (PG8_LAS float*)lds;
        u32x4 bs[2][4][2];
#pragma unroll
        for (int ai = 0; ai < 2; ++ai)
#pragma unroll
            for (int m = 0; m < 4; ++m)
#pragma unroll
                for (int bj = 0; bj < 2; ++bj) bs[ai][m][bj] = *(const u32x4*)(xb + (o0 + (unsigned)((ai * HALF + m * 16) * 1024 + bj * HALF)));
#pragma unroll
        for (int ai = 0; ai < 2; ++ai) {
#pragma unroll
            for (int m = 0; m < 4; ++m) { float sq = 0.f;
#pragma unroll
                for (int bj = 0; bj < 2; ++bj) {
                    float b[8], v[8]; unpack8(bs[ai][m][bj], b); PG8_V8(v, acc[ai][bj][m][0], acc[ai][bj][m][1], 1.0f);
#pragma unroll
                    for (int j = 0; j < 8; ++j) { v[j] += b[j]; sq += v[j] * v[j]; }
                    store_wt(xb + (o0 + (unsigned)((ai * HALF + m * 16) * 1024 + bj * HALF)), pack8(v)); }
                sq = xsum16(sq); sq = xsum32(sq);
                if (fq == 0) P[(ai * HALF + wr * 64 + m * 16 + fr) * 4 + wc] = sq; }
        }
        asm volatile("s_waitcnt lgkmcnt(0)" ::: "memory"); __builtin_amdgcn_s_barrier(); asm volatile("" ::: "memory");
        if (te_ < 256) { const f32x4 p = *(PG8_LAS const f32x4*)(P + te_ * 4); ssq[(unsigned)(u.pm * BM + te_) * 4u + (unsigned)u.pn] = (p[0] + p[1]) + (p[2] + p[3]); }
    }
};
struct EpiUp {
    static constexpr bool PERM = true, AFTER_DRAIN = false;
    bf16_t* U; const float* ssq;
    __device__ __forceinline__ void operator()(const f32x4 (&acc)[2][2][4][2], const Unit& u, int wr, int wc, int fr, int fq) const {
        const int row0 = u.pm * BM + wr * 64 + fr, col0 = u.pn * BM + wc * 32 + 8 * fq;
        float rs[8]; rstd8(ssq, row0, fq, rs);
#pragma unroll
        for (int ai = 0; ai < 2; ++ai)
#pragma unroll
            for (int m = 0; m < 4; ++m) { const int row = row0 + ai * HALF + m * 16; const float rstd = rs[ai * 4 + m];
#pragma unroll
                for (int bj = 0; bj < 2; ++bj) { float v[8]; PG8_V8(v, acc[ai][bj][m][0], acc[ai][bj][m][1], rstd);
#pragma unroll
                    for (int j = 0; j < 8; ++j) { const float r = fmaxf(v[j], 0.f); v[j] = r * r; }
                    store_wt(U + (size_t)row * 4096 + col0 + bj * HALF, pack8(v)); } }
    }
};
}
#define GAS __attribute__((address_space(1)))
#define LAS __attribute__((address_space(3)))
typedef unsigned short bf16;
typedef unsigned v4u __attribute__((ext_vector_type(4)));
typedef float f32x4 __attribute__((ext_vector_type(4)));
typedef short bf16x8 __attribute__((ext_vector_type(8)));
typedef GAS unsigned gu32;
typedef GAS unsigned long long gu64;
#define RLX_AGENT __ATOMIC_RELAXED, __HIP_MEMORY_SCOPE_AGENT
#define LDS_WAIT() asm volatile("s_waitcnt lgkmcnt(0)" ::: "memory")
#define VM_WAIT() asm volatile("s_waitcnt vmcnt(0)" ::: "memory")
__device__ __forceinline__ unsigned long long rt() { return __builtin_amdgcn_s_memrealtime(); }
__device__ __forceinline__ unsigned f2bf(float f) { unsigned u = __builtin_bit_cast(unsigned, f); return (u + 0x7fffu + ((u >> 16) & 1u)) >> 16; }
__device__ __forceinline__ unsigned pk2(float lo, float hi) { return f2bf(lo) | (f2bf(hi) << 16); }

#define XB_TMO      128
#define XB_XCNT(j)  (256  + 64 * (j))
#define XB_XSUB(j)  (1280 + 64 * (j))
#define XB_XGEN(j)  (2304 + 64 * (j))
#define XB_TOP      3328
#define XB_TOPGEN   3392
#define XCD_BAR_WORDS 3456
#define XB_SPIN_CAP (1u << 18)

__device__ __forceinline__ unsigned xb_ld(unsigned* p)              { return __hip_atomic_load(p, __ATOMIC_RELAXED, __HIP_MEMORY_SCOPE_AGENT); }
__device__ __forceinline__ unsigned xb_add(unsigned* p, unsigned v) { return __hip_atomic_fetch_add(p, v, __ATOMIC_RELAXED, __HIP_MEMORY_SCOPE_AGENT); }
__device__ __forceinline__ unsigned xb_xcc_id() { return (unsigned)__builtin_amdgcn_s_getreg((3 << 11) | 20) & 0xFu; }
#define XB_SPIN(cond, bar) do { unsigned _sp = 0; while (cond) { __builtin_amdgcn_s_sleep(1); \
    if ((++_sp & 255u) == 0u) { if (xb_ld(&(bar)[XB_TMO])) break; if (_sp > XB_SPIN_CAP) { atomicAdd(&(bar)[XB_TMO], 1u); break; } } } } while (0)

struct XcdBarrier {
    unsigned* bar; unsigned x;
    volatile LAS unsigned* st;
};

__device__ __forceinline__ XcdBarrier xcd_barrier_post(unsigned* bar, volatile LAS unsigned* st) {
    XcdBarrier b; b.bar = bar; b.x = xb_xcc_id(); b.st = st;
    if (threadIdx.x == 0) (void)xb_add(&bar[XB_XCNT(b.x)], 1u);
    return b;
}
__device__ __forceinline__ void xcd_barrier_complete(unsigned* bar, unsigned x, unsigned& nloc, unsigned& nx) {
    const unsigned G = gridDim.x * gridDim.y * gridDim.z;
    unsigned sum, cnt, mine, sp = 0u;
    for (;;) {
        sum = 0u; cnt = 0u; mine = 0u;
#pragma unroll
        for (unsigned j = 0; j < 16; ++j) { const unsigned c = xb_ld(&bar[XB_XCNT(j)]); sum += c; cnt += (c > 0u) ? 1u : 0u; mine = (j == x) ? c : mine; }
        if (sum == G) break;
        __builtin_amdgcn_s_sleep(1);
        if ((++sp & 255u) == 0u) { if (xb_ld(&bar[XB_TMO])) break; if (sp > XB_SPIN_CAP) { atomicAdd(&bar[XB_TMO], 1u); break; } }
    }
    nloc = mine > 0u ? mine : 1u; nx = cnt > 0u ? cnt : 1u;
}

__device__ __forceinline__ void xcd_barrier(const XcdBarrier& b) {
    asm volatile("s_waitcnt vmcnt(0)" ::: "memory");
    __syncthreads();
    if (threadIdx.x == 0) {
        unsigned* bar = b.bar;
        __builtin_amdgcn_s_waitcnt(0);
        unsigned nloc = b.st[0], nx = b.st[1];
        if (nloc == 0u) { xcd_barrier_complete(bar, b.x, nloc, nx); b.st[0] = nloc; b.st[1] = nx; }
        const unsigned old = xb_add(&bar[XB_XSUB(b.x)], 1u);
        const unsigned gen = old / nloc;
        if (old + 1u == (gen + 1u) * nloc) {
            __builtin_amdgcn_fence(__ATOMIC_RELEASE, "agent");
            asm volatile("s_waitcnt vmcnt(0)" ::: "memory");
            const unsigned og = xb_add(&bar[XB_TOP], 1u);
            const unsigned tg = og / nx;
            if (og + 1u == (tg + 1u) * nx) xb_add(&bar[XB_TOPGEN], 1u);
            else XB_SPIN(xb_ld(&bar[XB_TOPGEN]) == tg, bar);
            __builtin_amdgcn_fence(__ATOMIC_ACQUIRE, "agent");
            xb_add(&bar[XB_XGEN(b.x)], 1u);
            asm volatile("s_waitcnt vmcnt(0)" ::: "memory");
        } else {
            XB_SPIN(xb_ld(&bar[XB_XGEN(b.x)]) == gen, bar);
            __builtin_amdgcn_fence(__ATOMIC_ACQUIRE, "agent");
            asm volatile("s_waitcnt vmcnt(0)" ::: "memory");
        }
    }
    __syncthreads();
}

constexpr int NWAVES = 8;
constexpr int T = 16384, D = 1024, SEQ = 2048, FF = 4096, DIN = 5632, NQKV = 2560, NGATE = 3072, NMEMROWS = 2048;
constexpr size_t MiB = 1u << 20;
constexpr size_t WS_CTL = 0, CTL_ZERO_BYTES = 1 * MiB;
constexpr size_t WS_KSUM = 256 * 1024;
constexpr size_t WS_ROPE = 1 * MiB;
constexpr size_t WS_SSQ = 2 * MiB;
constexpr size_t WS_PTRS = 768 * 1024;
constexpr size_t WS_LSE = 3 * MiB;
constexpr size_t WS_MKV = 4 * MiB;
constexpr size_t WS_MEMN = 6 * MiB;
constexpr size_t WS_W = 10 * MiB;
constexpr size_t W_IN = 0, W_UP = 11 * MiB, W_DN = 19 * MiB, W_O = 27 * MiB, W_P = 29 * MiB, W_MKV = 31 * MiB, W_LAYER = 32 * MiB;
constexpr size_t WS_XB = 74 * MiB;
constexpr size_t WS_ZQ = 106 * MiB;
constexpr size_t WS_ZKV = 138 * MiB;
constexpr size_t WS_ZG = 138 * MiB;
constexpr size_t WS_U = 106 * MiB;
constexpr size_t WS_END = 234 * MiB;
constexpr int CW_QUEUE = 2048;
constexpr int CW_BAR = 4096;
constexpr int RING_OFF = 0, RING_BYTES = 131072, LDSCTL_OFF = RING_BYTES, MISC_OFF = LDSCTL_OFF + 320, LDS_BYTES = 147456;

__device__ __forceinline__ float wave_sum(float v) {
#pragma unroll
    for (int o = 1; o < 64; o <<= 1) v += __shfl_xor(v, o);
    return v;
}
__device__ __forceinline__ float bf2f(bf16 h) { return __uint_as_float((unsigned)h << 16); }

struct TrD { const float* W; const float* gain; bf16* WT; int N, ldt, k0, n0, drow, dcol; };
__device__ __forceinline__ void tr_load(const TrD& d, f32x4 (&v)[8], float (&gn)[8], int lane) {
    const int lr = lane >> 3, n4 = lane & 7;
#pragma unroll
    for (int i = 0; i < 8; ++i) { const int kk = 8 * i + lr; v[i] = __builtin_nontemporal_load((const GAS f32x4*)(d.W + (size_t)(d.k0 + kk) * d.N + d.n0 + 4 * n4)); gn[i] = d.gain ? d.gain[d.k0 + kk] : 1.0f; }
}
__device__ __forceinline__ void tr_fin(const TrD& d, const f32x4 (&v)[8], const float (&gn)[8], LAS float* scr, int lane) {
    const int lr = lane >> 3, n4 = lane & 7;
#pragma unroll
    for (int i = 0; i < 8; ++i) { const int kk = 8 * i + lr; LAS float* q = scr + kk * 33 + 4 * n4; q[0] = v[i].x * gn[i]; q[1] = v[i].y * gn[i]; q[2] = v[i].z * gn[i]; q[3] = v[i].w * gn[i]; }
    LDS_WAIT(); asm volatile("" ::: "memory");
    const int c = lane & 7;
#pragma unroll
    for (int j = 0; j < 4; ++j) { const int n = (lane >> 3) + 8 * j; const LAS float* s = scr + (8 * c) * 33 + n;
        v4u o; o.x = pk2(s[0 * 33], s[1 * 33]); o.y = pk2(s[2 * 33], s[3 * 33]); o.z = pk2(s[4 * 33], s[5 * 33]); o.w = pk2(s[6 * 33], s[7 * 33]);
        *(GAS v4u*)(d.WT + (size_t)(d.drow + n) * d.ldt + d.dcol + d.k0 + 8 * c) = o; }
    LDS_WAIT(); asm volatile("" ::: "memory");
}
__device__ __forceinline__ int win_dest_row(int n) {
    if (n < 384) return n;
    if (n < 768) return 1024 + (n - 384);
    if (n < 1152) return 1024 + 384 + (n - 768);
    if (n < 1536) return 384 + (n - 1152);
    if (n < 1920) return 1024 + 768 + (n - 1536);
    if (n < 2304) return 1024 + 1152 + (n - 1920);
    if (n < 2560) return 768 + (n - 2304);
    return n;
}

typedef unsigned u32x4p __attribute__((ext_vector_type(4)));

namespace att {
typedef short bf16x8 __attribute__((ext_vector_type(8)));
typedef short s16x4 __attribute__((ext_vector_type(4)));
typedef float f32x16 __attribute__((ext_vector_type(16)));
constexpr int KP = 144, VP = 192;
constexpr int KBUF = 64 * KP, VBUF = 64 * VP, BUF = KBUF + VBUF;
constexpr float LOG2E = 1.4426950408889634f;
__device__ __forceinline__ int crow(int r, int hi) { return (r & 3) + 8 * (r >> 2) + 4 * hi; }
__device__ __forceinline__ float xsum(float v) { return pg8::xsum32(v); }
__device__ __forceinline__ float xmax(float v) { return pg8::xmax32(v); }
__device__ __forceinline__ s16x4 vtr(LAS const unsigned char* p) { typedef short v4i16_t __attribute__((ext_vector_type(4))); return __builtin_bit_cast(s16x4, __builtin_amdgcn_ds_read_tr16_b64_v4i16((LAS v4i16_t*)p)); }

struct Unit {
    int kind;
    const bf16* Q; bf16* O;
    int qrow0, qstride, nq;
    const bf16* K; const bf16* V; int kvpitch;
    int krow0, kstride;
    int t_lo, t_hi;
    int qidx0;
    int qb;
    const float* ksum;
    float* lse; int lse_stride;
};

template <int KIND> __device__ __forceinline__ void att_tile(LAS const unsigned char* kb, const Unit& u, int t, int wid, int qi, int hi, unsigned koff, unsigned voff, unsigned sel,
                                                             const bf16x8 (&qf)[4], float& m, f32x16& o0, f32x16& o1, f32x16& o2) {
    bf16x8 ka[4], kc[4];
#pragma unroll
    for (int ks = 0; ks < 4; ++ks) { ka[ks] = *(LAS const bf16x8*)(kb + koff + 32 * ks); kc[ks] = *(LAS const bf16x8*)(kb + koff + 32 * KP + 32 * ks); }
    bf16x8 va[2][2], vc[2][2];
#pragma unroll
    for (int sub_ = 0; sub_ < 2; ++sub_)
#pragma unroll
        for (int s = 0; s < 2; ++s) {
            LAS const unsigned char* vb = kb + voff + (32 * sub_ + 16 * s) * VP;
            const s16x4 a_lo = vtr(vb), a_hi = vtr(vb + 8 * VP), b_lo = vtr(vb + 64), b_hi = vtr(vb + 8 * VP + 64);
            va[sub_][s] = (bf16x8){a_lo[0], a_lo[1], a_lo[2], a_lo[3], a_hi[0], a_hi[1], a_hi[2], a_hi[3]};
            vc[sub_][s] = (bf16x8){b_lo[0], b_lo[1], b_lo[2], b_lo[3], b_hi[0], b_hi[1], b_hi[2], b_hi[3]};
        }
    const int qlo = u.qidx0 + 32 * wid;
    bool bs = true, needmask = false;
    if (KIND == 0) { const int blk = t >> 2; if (blk < u.qb) bs = (sel >> blk) & 1u; else needmask = (64 * t + 63 > qlo); }
    if (KIND == 2) needmask = !((64 * t + 63 <= qlo) && (64 * t >= qlo + 31 - 128));
    const bool unset = (m == -INFINITY);
    const float mref = unset ? 0.f : m;
    const float nv = bs ? -mref : -1e30f;
    f32x16 negt;
#pragma unroll
    for (int r = 0; r < 16; ++r) negt[r] = nv;
    f32x16 p0 = __builtin_amdgcn_mfma_f32_32x32x16_bf16(ka[0], qf[0], negt, 0, 0, 0);
    f32x16 p1 = __builtin_amdgcn_mfma_f32_32x32x16_bf16(kc[0], qf[0], negt, 0, 0, 0);
#pragma unroll
    for (int ks = 1; ks < 4; ++ks) {
        p0 = __builtin_amdgcn_mfma_f32_32x32x16_bf16(ka[ks], qf[ks], p0, 0, 0, 0);
        p1 = __builtin_amdgcn_mfma_f32_32x32x16_bf16(kc[ks], qf[ks], p1, 0, 0, 0);
    }
    if (needmask) {
#pragma unroll
        for (int r = 0; r < 16; ++r) {
            const int j0 = 64 * t + crow(r, hi), j1 = j0 + 32;
            bool v0 = j0 <= qi, v1 = j1 <= qi;
            if (KIND == 2) { v0 = v0 && (j0 >= qi - 128); v1 = v1 && (j1 >= qi - 128); }
            p0[r] = v0 ? p0[r] : -INFINITY; p1[r] = v1 ? p1[r] : -INFINITY;
        }
    }
    float rm = __builtin_fmaxf(p0[0], p1[0]);
#pragma unroll
    for (int r = 1; r < 16; ++r) rm = __builtin_fmaxf(__builtin_fmaxf(rm, p0[r]), p1[r]);
    rm = xmax(rm);
    const bool trig = bs && (rm > 8.0f || (unset && rm > -1e29f));
    if (__any(trig)) {
        const float dl = trig ? rm : 0.f;
        const float alpha = (trig && !unset) ? __builtin_amdgcn_exp2f(-dl) : 1.0f;
        m = trig ? (mref + dl) : m;
#pragma unroll
        for (int r = 0; r < 16; ++r) { p0[r] -= dl; p1[r] -= dl; o0[r] *= alpha; o1[r] *= alpha; o2[r] *= alpha; }
    }
#pragma unroll
    for (int r = 0; r < 16; ++r) { p0[r] = __builtin_amdgcn_exp2f(p0[r]); p1[r] = __builtin_amdgcn_exp2f(p1[r]); }
    bf16x8 pf[2][2];
#pragma unroll
    for (int s = 0; s < 2; ++s) {
        u32x4p w0, w1;
        w0.x = pg8::cvt_pk_bf16(p0[8 * s + 0], p0[8 * s + 1]); w0.y = pg8::cvt_pk_bf16(p0[8 * s + 2], p0[8 * s + 3]); w0.z = pg8::cvt_pk_bf16(p0[8 * s + 4], p0[8 * s + 5]); w0.w = pg8::cvt_pk_bf16(p0[8 * s + 6], p0[8 * s + 7]);
        w1.x = pg8::cvt_pk_bf16(p1[8 * s + 0], p1[8 * s + 1]); w1.y = pg8::cvt_pk_bf16(p1[8 * s + 2], p1[8 * s + 3]); w1.z = pg8::cvt_pk_bf16(p1[8 * s + 4], p1[8 * s + 5]); w1.w = pg8::cvt_pk_bf16(p1[8 * s + 6], p1[8 * s + 7]);
        pf[0][s] = __builtin_bit_cast(bf16x8, w0); pf[1][s] = __builtin_bit_cast(bf16x8, w1);
    }
    const bf16x8 ones = (bf16x8){0x3F80, 0x3F80, 0x3F80, 0x3F80, 0x3F80, 0x3F80, 0x3F80, 0x3F80};
#pragma unroll
    for (int sub_ = 0; sub_ < 2; ++sub_)
#pragma unroll
        for (int s = 0; s < 2; ++s) {
            o0 = __builtin_amdgcn_mfma_f32_32x32x16_bf16(va[sub_][s], pf[sub_][s], o0, 0, 0, 0);
            o1 = __builtin_amdgcn_mfma_f32_32x32x16_bf16(vc[sub_][s], pf[sub_][s], o1, 0, 0, 0);
            o2 = __builtin_amdgcn_mfma_f32_32x32x16_bf16(ones, pf[sub_][s], o2, 0, 0, 0);
        }
}

template <int KIND> __device__ __forceinline__ void run_unit(LAS unsigned char* lds, const Unit& u) {
    int tid_ = threadIdx.x; asm volatile("" : "+v"(tid_));
    const int tid = tid_, lane = tid & 63, wid = __builtin_amdgcn_readfirstlane(tid >> 6), ql = lane & 31, hi = lane >> 5;
    const bool wactive = (32 * wid) < u.nq;
    const int srow = tid >> 3, sch = tid & 7;
    const unsigned kdst = (unsigned)(srow * KP + sch * 16), vdst = (unsigned)(KBUF + srow * VP + sch * 16);
    v4u kA, vA, kB, vB;
#define ATT_LOAD(KR, VR, t) do { const size_t r_ = (size_t)(u.krow0 + (64 * (t) + srow) * u.kstride) * u.kvpitch + sch * 8; KR = *(const GAS v4u*)(u.K + r_); VR = *(const GAS v4u*)(u.V + r_); } while (0)
#define ATT_WRITE(KR, VR, b) do { *(LAS v4u*)(lds + (b) * BUF + kdst) = KR; *(LAS v4u*)(lds + (b) * BUF + vdst) = VR; } while (0)
    ATT_LOAD(kA, vA, u.t_lo);
    if (u.t_lo + 1 < u.t_hi) ATT_LOAD(kB, vB, u.t_lo + 1);
    const int qi = u.qidx0 + 32 * wid + ql;
    const size_t qrow = (size_t)(u.qrow0 + (32 * wid + ql) * u.qstride);
    bf16x8 qf[4];
#pragma unroll
    for (int ks = 0; ks < 4; ++ks) qf[ks] = wactive ? *(const bf16x8*)(u.Q + qrow * 1024 + 16 * ks + 8 * hi) : (bf16x8){0, 0, 0, 0, 0, 0, 0, 0};
    unsigned sel = 0xffu;
    if (KIND == 0) {
        float gsc[7];
#pragma unroll
        for (int n = 0; n < 7; ++n) { gsc[n] = -INFINITY;
            if (n < u.qb) { const float* kp = u.ksum + n * 384 + 8 * hi; float s = 0.f;
#pragma unroll
                for (int ks = 0; ks < 4; ++ks) { const f32x4 k0 = *(const f32x4*)(kp + 16 * ks), k1 = *(const f32x4*)(kp + 16 * ks + 4);
#pragma unroll
                    for (int j = 0; j < 4; ++j) { s += bf2f((bf16)qf[ks][j]) * k0[j]; s += bf2f((bf16)qf[ks][4 + j]) * k1[j]; } }
                s = xsum(s); gsc[n] = s; } }
        sel = 0u;
#pragma unroll
        for (int r = 0; r < 3; ++r) { int best = -1; float bv = -INFINITY;
#pragma unroll
            for (int n = 0; n < 7; ++n) if (n < u.qb && !((sel >> n) & 1u) && gsc[n] > bv) { bv = gsc[n]; best = n; }
            if (best >= 0) sel |= 1u << best; }
    }
    float m = -INFINITY; f32x16 o0 = {}, o1 = {}, o2 = {};
    ATT_WRITE(kA, vA, 0); if (u.t_lo + 1 < u.t_hi) ATT_WRITE(kB, vB, 1);
    __syncthreads();
    const unsigned koff = (unsigned)(ql * KP + 16 * hi);
    const unsigned voff = (unsigned)(KBUF + (4 * hi + ((lane & 15) >> 2)) * VP + ((lane >> 4) & 1) * 32 + (lane & 3) * 8);
#define ATT_NEED(t) (wactive && !(KIND == 0 && ((t) >> 2) == u.qb && 64 * (t) > u.qidx0 + 32 * wid + 31) && !(KIND == 2 && (64 * (t) > u.qidx0 + 32 * wid + 31 || 64 * (t) + 63 < u.qidx0 + 32 * wid - 128)))
    for (int t = u.t_lo; t < u.t_hi; t += 2) {
        const bool more = (t + 2 < u.t_hi), more2 = (t + 3 < u.t_hi);
        if (more) ATT_LOAD(kA, vA, t + 2);
        if (more2) ATT_LOAD(kB, vB, t + 3);
        if (ATT_NEED(t)) att_tile<KIND>(lds, u, t, wid, qi, hi, koff, voff, sel, qf, m, o0, o1, o2);
        if (t + 1 < u.t_hi) { if (ATT_NEED(t + 1)) att_tile<KIND>(lds + BUF, u, t + 1, wid, qi, hi, koff, voff, sel, qf, m, o0, o1, o2); }
        __syncthreads();
        if (more) { ATT_WRITE(kA, vA, 0); if (more2) ATT_WRITE(kB, vB, 1); __syncthreads(); }
    }
    if (wactive) {
        const float lt = o2[0]; const float inv = 1.0f / lt;
        bf16* orow = u.O + qrow * 1024;
#pragma unroll
        for (int g = 0; g < 4; ++g) {
            unsigned long long w0 = (unsigned long long)pg8::cvt_pk_bf16(o0[4 * g] * inv, o0[4 * g + 1] * inv) | ((unsigned long long)pg8::cvt_pk_bf16(o0[4 * g + 2] * inv, o0[4 * g + 3] * inv) << 32);
            unsigned long long w1 = (unsigned long long)pg8::cvt_pk_bf16(o1[4 * g] * inv, o1[4 * g + 1] * inv) | ((unsigned long long)pg8::cvt_pk_bf16(o1[4 * g + 2] * inv, o1[4 * g + 3] * inv) << 32);
            *(unsigned long long*)(orow + 8 * g + 4 * hi) = w0; *(unsigned long long*)(orow + 32 + 8 * g + 4 * hi) = w1;
        }
        if (KIND == 2) { if (hi == 0) u.lse[(size_t)(32 * wid + ql) * u.lse_stride] = m + __builtin_log2f(lt); }
    }
#undef ATT_LOAD
#undef ATT_WRITE
#undef ATT_NEED
}

constexpr int N_UNITS = 1152;
__device__ __forceinline__ void make_unit(int idx, Unit& u, bf16* ZQ, const bf16* ZKV, const bf16* MKV, const float* KSUM, float* LSE) {
    u.qstride = 1; u.nq = 256; u.kstride = 1; u.qb = 0; u.ksum = nullptr; u.lse = nullptr; u.lse_stride = 0; u.qidx0 = 0;
    int mb = -1, mqb = 0;
    if (idx < 288) { mqb = 7 - idx / 48; mb = idx % 48; }
    else if (idx < 336) { mqb = 1; mb = idx - 288; }
    else if (idx >= 592 && idx < 640) { mqb = 0; mb = idx - 592; }
    if (mb >= 0) {
        const int b = mb / 6, h = mb % 6;
        u.kind = 0; u.Q = ZQ + 384 + h * 64; u.O = ZQ + 384 + h * 64; u.qrow0 = b * SEQ + 256 * mqb;
        u.K = ZKV + 768 + h * 64; u.V = ZKV + 1152 + h * 64; u.kvpitch = 1536; u.krow0 = b * SEQ;
        u.t_lo = 0; u.t_hi = 4 * (mqb + 1); u.qidx0 = 256 * mqb; u.qb = mqb; u.ksum = KSUM + (size_t)(b * 8) * 384 + h * 64;
        return;
    }
    if (idx >= 640 && idx < 896) {
        const int i = idx - 640, bh = i >> 3, blk = i & 7, b = bh >> 2, h = bh & 3;
        u.kind = 1; u.Q = ZQ + 768 + h * 64; u.O = ZQ + 768 + h * 64; u.qrow0 = b * SEQ + 256 * blk;
        u.K = MKV + h * 64; u.V = MKV + 256 + h * 64; u.kvpitch = 512; u.krow0 = b * 256; u.t_lo = 0; u.t_hi = 4;
        return;
    }
    u.kind = 2; u.kvpitch = 1536; u.lse_stride = 6;
    int g, b, h, r, m0, nq;
    if (idx < 464) { const int i = idx - 336; g = 0; b = i >> 4; h = (i >> 3) & 1; r = 0; m0 = 256 * (i & 7); nq = 256; }
    else if (idx < 592) { const int i = idx - 464; g = 1; b = i >> 4; h = (i >> 3) & 1; r = (i >> 1) & 3; m0 = 256 * (i & 1); nq = 256; }
    else { const int i = idx - 896; g = 2; b = i >> 5; h = (i >> 4) & 1; r = i & 15; m0 = 0; nq = 128; }
    const int dil = (g == 0) ? 1 : (g == 1) ? 4 : 16, hc = (2 * g + h) * 64;
    u.Q = ZQ + hc; u.O = ZQ + hc; u.qstride = dil; u.nq = nq; u.qrow0 = b * SEQ + m0 * dil + r;
    u.K = ZKV + hc; u.V = ZKV + 384 + hc; u.krow0 = b * SEQ + r; u.kstride = dil;
    u.t_lo = (m0 >= 128) ? (m0 - 128) / 64 : 0; u.t_hi = (m0 + nq) / 64; u.qidx0 = m0;
    u.lse = LSE + (size_t)u.qrow0 * 6 + (2 * g + h); u.lse_stride = 6 * dil;
}
}
struct Args { const float* in[14]; float* out; unsigned char* ws; int ph_lo, ph_hi, li, pad; };
constexpr int I_INQ = 16 * 80, I_ING = 16 * 96, I_PA = 2 * 32, I_PB = 6 * 32, I_PM = 4 * 32, I_O = 16 * 32, I_MKV = 16 * 16, I_UP = 16 * 128, I_DN = 64 * 32;
constexpr int I_LAYER = I_INQ + I_MKV + I_ING + I_PA + I_PB + I_PM + I_O + I_UP + I_DN, I_EARLY = I_INQ + I_MKV;
__device__ __forceinline__ TrD tr_desc(const float* const* in, unsigned char* ws, int it) {
    const int l = it / I_LAYER; int r = it % I_LAYER;
    unsigned char* wl = ws + WS_W + (size_t)l * W_LAYER; TrD d;
    if (r < I_INQ) { const int kb = r / 80, nb = r % 80; d = TrD{in[3] + (size_t)l * D * DIN, in[2] + l * D, (bf16*)(wl + W_IN), DIN, 1024, 64 * kb, 32 * nb, win_dest_row(32 * nb), 0}; return d; } r -= I_INQ;
    if (r < I_MKV) { const int kb = r / 16, nb = r % 16; d = TrD{in[9] + (size_t)l * D * 512, in[8] + l * D, (bf16*)(wl + W_MKV), 512, 1024, 64 * kb, 32 * nb, 32 * nb, 0}; return d; } r -= I_MKV;
    if (r < I_ING) { const int kb = r / 96, nb = 80 + r % 96; d = TrD{in[3] + (size_t)l * D * DIN, in[2] + l * D, (bf16*)(wl + W_IN), DIN, 1024, 64 * kb, 32 * nb, win_dest_row(32 * nb), 0}; return d; } r -= I_ING;
    if (r < I_PA) { const int kb = r / 32, nb = r % 32; d = TrD{in[4] + (size_t)l * 128 * D, nullptr, (bf16*)(wl + W_P), D, 1024, 64 * kb, 32 * nb, 32 * nb, 0}; return d; } r -= I_PA;
    if (r < I_PB) { const int kb = r / 32, nb = r % 32; d = TrD{in[5] + (size_t)l * 384 * D, nullptr, (bf16*)(wl + W_P), D, 1024, 64 * kb, 32 * nb, 32 * nb, 384}; return d; } r -= I_PB;
    if (r < I_PM) { const int kb = r / 32, nb = r % 32; d = TrD{in[6] + (size_t)l * 256 * D, nullptr, (bf16*)(wl + W_P), D, 1024, 64 * kb, 32 * nb, 32 * nb, 768}; return d; } r -= I_PM;
    if (r < I_O) { const int kb = r / 32, nb = r % 32; d = TrD{in[7] + (size_t)l * D * D, nullptr, (bf16*)(wl + W_O), D, 1024, 64 * kb, 32 * nb, 32 * nb, 0}; return d; } r -= I_O;
    if (r < I_UP) { const int kb = r / 128, nb = r % 128; d = TrD{in[11] + (size_t)l * D * FF, in[10] + l * D, (bf16*)(wl + W_UP), FF, 1024, 64 * kb, 32 * nb, 32 * nb, 0}; return d; } r -= I_UP;
    { const int kb = r / 32, nb = r % 32; d = TrD{in[12] + (size_t)l * FF * D, nullptr, (bf16*)(wl + W_DN), D, 4096, 64 * kb, 32 * nb, 32 * nb, 0}; return d; }
}

namespace pg8 {
struct EpiFinal {
    static constexpr bool PERM = true, AFTER_DRAIN = true;
    __device__ static bool stores16(const Unit&) { return true; }
    const bf16_t* xb; float* ssq; float* out; const float* gain; const XcdBarrier* bar;
    __device__ __forceinline__ void fused(f32x4 (&acc)[2][2][4][2], const Unit& u, int wr, int wc, int, int, PG8_LAS unsigned char* lds, int, int) const {
        int te_ = threadIdx.x; asm volatile("" : "+v"(te_) :: "memory"); const int fr = te_ & 15, fq = (te_ & 63) >> 4;
        PG8_LAS float* P = (PG8_LAS float*)lds;
        const int row0 = u.pm * BM + wr * 64 + fr, col0 = u.pn * BM + wc * 32 + 8 * fq;
        const unsigned o0 = (unsigned)row0 * 1024u + (unsigned)col0;
#pragma unroll
        for (int ai = 0; ai < 2; ++ai) {
            u32x4 bs[4][2];
#pragma unroll
            for (int m = 0; m < 4; ++m)
#pragma unroll
                for (int bj = 0; bj < 2; ++bj) bs[m][bj] = *(const u32x4*)(xb + (o0 + (unsigned)((ai * HALF + m * 16) * 1024 + bj * HALF)));
#pragma unroll
            for (int m = 0; m < 4; ++m) { float sq = 0.f;
#pragma unroll
                for (int bj = 0; bj < 2; ++bj) { float b[8]; unpack8(bs[m][bj], b);
                    acc[ai][bj][m][0] = acc[ai][bj][m][0] + (f32x4){b[0], b[1], b[2], b[3]}; acc[ai][bj][m][1] = acc[ai][bj][m][1] + (f32x4){b[4], b[5], b[6], b[7]};
                    const f32x4 x0 = acc[ai][bj][m][0], x1 = acc[ai][bj][m][1];
                    sq += (x0[0] * x0[0] + x0[1] * x0[1]) + (x0[2] * x0[2] + x0[3] * x0[3]) + (x1[0] * x1[0] + x1[1] * x1[1]) + (x1[2] * x1[2] + x1[3] * x1[3]); }
                sq = xsum16(sq); sq = xsum32(sq);
                if (fq == 0) P[(ai * HALF + wr * 64 + m * 16 + fr) * 4 + wc] = sq; }
        }
        asm volatile("s_waitcnt lgkmcnt(0)" ::: "memory"); __builtin_amdgcn_s_barrier(); asm volatile("" ::: "memory");
        if (te_ < 256) { const f32x4 p = *(PG8_LAS const f32x4*)(P + te_ * 4); ssq[(unsigned)(u.pm * BM + te_) * 4u + (unsigned)u.pn] = (p[0] + p[1]) + (p[2] + p[3]); }
        xcd_barrier(*bar);
        float rs[8]; rstd8(ssq, row0, fq, rs);
#pragma unroll
        for (int bj = 0; bj < 2; ++bj) { const f32x4 g0 = *(const f32x4*)(gain + col0 + bj * HALF), g1 = *(const f32x4*)(gain + col0 + bj * HALF + 4);
#pragma unroll
            for (int ai = 0; ai < 2; ++ai)
#pragma unroll
                for (int m = 0; m < 4; ++m) { const float r = rs[ai * 4 + m]; float* op = out + (o0 + (unsigned)((ai * HALF + m * 16) * 1024 + bj * HALF));
                    *(f32x4*)op = acc[ai][bj][m][0] * r * g0; *(f32x4*)(op + 4) = acc[ai][bj][m][1] * r * g1; } }
    }
};
}
constexpr int N_PHASES = 16;
#ifndef MK_ONE_LAUNCH
#define MK_ONE_LAUNCH 1
#endif
__global__ void __launch_bounds__(NWAVES * 64, 2) mega(Args args) {
    extern __shared__ __attribute__((aligned(16))) unsigned char lds_raw[];
    LAS unsigned char* lds = (LAS unsigned char*)lds_raw;
    volatile LAS unsigned* MISC = (volatile LAS unsigned*)(lds + MISC_OFF);
    const int tid = threadIdx.x, lane = tid & 63, wave = __builtin_amdgcn_readfirstlane(tid >> 6);
    const int G = gridDim.x; const int bx = blockIdx.x; const int vcu = (G % 8 == 0) ? (bx % 8) * (G / 8) + bx / 8 : bx;
    unsigned char* ws = args.ws;
    gu32* ctl = (gu32*)(ws + WS_CTL);
    for (int u = tid; u < (LDS_BYTES - LDSCTL_OFF) / 4; u += NWAVES * 64) ((LAS unsigned*)(lds + LDSCTL_OFF))[u] = 0u;
    __syncthreads();
    XcdBarrier bar; bar.bar = (unsigned*)(ctl + CW_BAR); bar.x = 0; bar.st = nullptr;
    if (MK_ONE_LAUNCH) bar = xcd_barrier_post((unsigned*)(ctl + CW_BAR), MISC + 8);
    const int lo = args.ph_lo, hi = args.ph_hi;
#define IN(k) (lo <= (k) && (k) < hi)
#ifndef MK_PROBE
#define MK_PROBE 0
#endif
#if MK_PROBE
    unsigned long long* const TS = (unsigned long long*)(ws + 512 * 1024);
#define STAMP(k) do { if (blockIdx.x == 0) { __hip_atomic_store(TS + (k), rt(), __ATOMIC_RELAXED, __HIP_MEMORY_SCOPE_AGENT); } } while (0)
#else
#define STAMP(k) do { } while (0)
#endif
#define SEAM(k) do { if (IN(k) && IN((k) + 1)) xcd_barrier(bar); STAMP((k) + 1); } while (0)
    STAMP(0);
    const float* x_in = args.in[0]; const float* mem = args.in[1];
    float* out = args.out;
    float* ROPE = (float*)(ws + WS_ROPE); float* SSQ = (float*)(ws + WS_SSQ); float* LSE = (float*)(ws + WS_LSE);
    bf16* MKV = (bf16*)(ws + WS_MKV); bf16* MEMN = (bf16*)(ws + WS_MEMN); bf16* XB = (bf16*)(ws + WS_XB);
    bf16* ZQ = (bf16*)(ws + WS_ZQ); bf16* ZKV = (bf16*)(ws + WS_ZKV); bf16* ZG = (bf16*)(ws + WS_ZG); bf16* U = (bf16*)(ws + WS_U);
    const int gw = vcu * NWAVES + wave, NGW = G * NWAVES;

    if (IN(0)) {
        LAS float* scr = (LAS float*)(lds + RING_OFF + wave * 16384);
        const float* const* intab = (const float* const*)(ws + WS_PTRS);
        if (tid == 0) { const float** tb = (const float**)(ws + WS_PTRS);
            tb[0] = args.in[0]; tb[1] = args.in[1]; tb[2] = args.in[2]; tb[3] = args.in[3]; tb[4] = args.in[4]; tb[5] = args.in[5]; tb[6] = args.in[6];
            tb[7] = args.in[7]; tb[8] = args.in[8]; tb[9] = args.in[9]; tb[10] = args.in[10]; tb[11] = args.in[11]; tb[12] = args.in[12]; tb[13] = args.in[13]; }
        asm volatile("s_waitcnt vmcnt(0)" ::: "memory"); __syncthreads();
        for (int it = gw; it < I_EARLY; it += 2 * NGW) {
            const bool two = (it + NGW) < I_EARLY;
            const TrD d0 = tr_desc(intab, ws, it), d1 = tr_desc(intab, ws, two ? it + NGW : it);
            f32x4 v0[8], v1[8]; float g0[8], g1[8];
            tr_load(d0, v0, g0, lane); if (two) tr_load(d1, v1, g1, lane);
            tr_fin(d0, v0, g0, scr, lane); if (two) tr_fin(d1, v1, g1, scr, lane);
        }
        for (int it = gw; it < 2 * 1024; it += NGW) { const int l = it >> 10, n = it & 1023; bf16* p = (bf16*)(ws + WS_W + (size_t)l * W_LAYER + W_P) + (size_t)n * 1024 + 128;
            if (lane < 32) ((GAS v4u*)p)[lane] = (v4u){0u, 0u, 0u, 0u}; }
        for (int e = bx * (NWAVES * 64) + tid; e < SEQ * 8; e += G * NWAVES * 64) { const int pos = e >> 3, i = e & 7;
            const float invf = (float)(1.0 / pow(500000.0, (double)i / 8.0)); const float ang = (float)pos * invf;
            const double rev = (double)ang * 0.15915494309189535; const float fr_ = (float)(rev - floor(rev));
            const _Float16 ch = (_Float16)__builtin_amdgcn_cosf(fr_), sh = (_Float16)__builtin_amdgcn_sinf(fr_);
            ((unsigned*)ROPE)[pos * 8 + i] = (unsigned)__builtin_bit_cast(unsigned short, ch) | ((unsigned)__builtin_bit_cast(unsigned short, sh) << 16); }
        for (int m = gw; m < T; m += 2 * NGW) { const int m1 = m + NGW;
            const GAS f32x4* xr = (const GAS f32x4*)(x_in + (size_t)m * D) + lane; const GAS f32x4* xr1 = (const GAS f32x4*)(x_in + (size_t)m1 * D) + lane; f32x4 v[4], w[4]; float s = 0.f, s1 = 0.f;
#pragma unroll
            for (int j = 0; j < 4; ++j) { v[j] = __builtin_nontemporal_load(xr + 64 * j); w[j] = __builtin_nontemporal_load(xr1 + 64 * j); }
#pragma unroll
            for (int j = 0; j < 4; ++j) { s += (v[j].x * v[j].x + v[j].y * v[j].y) + (v[j].z * v[j].z + v[j].w * v[j].w); s1 += (w[j].x * w[j].x + w[j].y * w[j].y) + (w[j].z * w[j].z + w[j].w * w[j].w); }
            s = wave_sum(s); s1 = wave_sum(s1);
            GAS unsigned long long* o8 = (GAS unsigned long long*)(XB + (size_t)m * D) + lane; GAS unsigned long long* o81 = (GAS unsigned long long*)(XB + (size_t)m1 * D) + lane;
#pragma unroll
            for (int j = 0; j < 4; ++j) { o8[64 * j] = (unsigned long long)pk2(v[j].x, v[j].y) | ((unsigned long long)pk2(v[j].z, v[j].w) << 32); o81[64 * j] = (unsigned long long)pk2(w[j].x, w[j].y) | ((unsigned long long)pk2(w[j].z, w[j].w) << 32); }
            if (lane < 4) { SSQ[(size_t)m * 4 + lane] = (lane == 0) ? s : 0.f; SSQ[(size_t)m1 * 4 + lane] = (lane == 0) ? s1 : 0.f; } }
        for (int m = gw; m < NMEMROWS; m += NGW) { const GAS f32x4* xr = (const GAS f32x4*)(mem + (size_t)m * D) + lane; f32x4 v[4]; float s = 0.f;
#pragma unroll
            for (int j = 0; j < 4; ++j) { v[j] = __builtin_nontemporal_load(xr + 64 * j); s += (v[j].x * v[j].x + v[j].y * v[j].y) + (v[j].z * v[j].z + v[j].w * v[j].w); }
            const float rstd = 1.0f / sqrtf(wave_sum(s) * (1.0f / 1024.0f) + 1e-6f);
            GAS unsigned long long* o8 = (GAS unsigned long long*)(MEMN + (size_t)m * D) + lane;
#pragma unroll
            for (int j = 0; j < 4; ++j) o8[64 * j] = (unsigned long long)pk2(v[j].x * rstd, v[j].y * rstd) | ((unsigned long long)pk2(v[j].z * rstd, v[j].w * rstd) << 32); }
    }
    SEAM(0);

    for (int l = 0; l < 2; ++l) {
        const int pb = 1 + 7 * l;
        unsigned char* wl = ws + WS_W + (size_t)l * W_LAYER;
        const bf16* WIN_t = (const bf16*)(wl + W_IN); const bf16* WUP_t = (const bf16*)(wl + W_UP); const bf16* WDN_t = (const bf16*)(wl + W_DN);
        const bf16* WO_t = (const bf16*)(wl + W_O); const bf16* WP_t = (const bf16*)(wl + W_P); const bf16* WMKV_t = (const bf16*)(wl + W_MKV);
        float* KSUM = (float*)(ws + WS_KSUM) + (size_t)l * 64 * 6 * 64;
        if (IN(pb + 0)) {
            { pg8::Gemm g{XB, WIN_t, 1024, 1024, 1024, nullptr, nullptr}; pg8::StaticOrder S; S.init(T, NQKV, G, bx);
              pg8::EpiQKV E{ZQ, ZKV, SSQ, (const unsigned*)ROPE, KSUM};
              pg8::gemm_phase<pg8::EpiQKV, pg8::StaticOrder, true, true>(lds + RING_OFF, g, S, E); }
            { pg8::Gemm g{MEMN, WMKV_t, 1024, 1024, 1024, nullptr, nullptr}; pg8::StaticOrder S; S.init(NMEMROWS, 512, G, (bx + 128) % G);
              pg8::EpiPlain E{MKV, 512};
              pg8::gemm_phase<pg8::EpiPlain, pg8::StaticOrder, true, true>(lds + RING_OFF, g, S, E); }
        }
        const int conv0 = (G > 160) ? 144 : 0;
        if (IN(pb + 0) && bx >= conv0) {
            LAS float* scr = (LAS float*)(lds + RING_OFF + wave * 16384);
            int tl_ = threadIdx.x; asm volatile("" : "+v"(tl_)); const int ln = tl_ & 63;
            const int rank = (bx - conv0) * NWAVES + wave, nrank = (G - conv0) * NWAVES; const float* const* intab2 = (const float* const*)(ws + WS_PTRS);
            const int it_lo = (l == 0) ? I_EARLY : I_LAYER + I_EARLY, it_hi = (l == 0) ? I_LAYER + I_EARLY : 2 * I_LAYER;
            for (int it = it_lo + rank; it < it_hi; it += 2 * nrank) {
                const bool two = (it + nrank) < it_hi;
                const TrD d0 = tr_desc(intab2, ws, it), d1 = tr_desc(intab2, ws, two ? it + nrank : it);
                f32x4 v0[8], v1[8]; float g0[8], g1[8];
                tr_load(d0, v0, g0, ln); tr_load(d1, v1, g1, ln);
                tr_fin(d0, v0, g0, scr, ln); if (two) tr_fin(d1, v1, g1, scr, ln);
            }
        }
        SEAM(pb + 0);
        if (IN(pb + 1)) {
            unsigned* qcnt = (unsigned*)(ctl + CW_QUEUE + 64 * l);
            for (;;) {
                if (threadIdx.x == 0) MISC[16] = __hip_atomic_fetch_add(qcnt, 1u, __ATOMIC_RELAXED, __HIP_MEMORY_SCOPE_AGENT);
                __syncthreads();
                const int idx = (int)MISC[16];
                if (idx >= att::N_UNITS) break;
                att::Unit au; att::make_unit(idx, au, ZQ, ZKV, MKV, KSUM, LSE);
                if (au.kind == 0) att::run_unit<0>(lds + RING_OFF, au); else if (au.kind == 1) att::run_unit<1>(lds + RING_OFF, au); else att::run_unit<2>(lds + RING_OFF, au);
            }
        }
        SEAM(pb + 1);
        if (IN(pb + 2)) {
            { int tl_ = threadIdx.x; asm volatile("" : "+v"(tl_)); const int ln = tl_ & 63, h = ln >> 5, c = 2 * (ln & 31);
              for (int row = gw; row < T; row += NGW) {
                const float l0 = LSE[(size_t)row * 6 + h], l1 = LSE[(size_t)row * 6 + 2 + h], l2 = LSE[(size_t)row * 6 + 4 + h];
                bf16* zr = ZQ + (size_t)row * 1024;
                const unsigned a0 = *(const GAS unsigned*)(zr + h * 64 + c), a1 = *(const GAS unsigned*)(zr + (2 + h) * 64 + c), a2 = *(const GAS unsigned*)(zr + (4 + h) * 64 + c);
                const float mx = fmaxf(l0, fmaxf(l1, l2));
                float w0 = __builtin_amdgcn_exp2f(l0 - mx), w1 = __builtin_amdgcn_exp2f(l1 - mx), w2 = __builtin_amdgcn_exp2f(l2 - mx);
                const float inv = 1.0f / (w0 + w1 + w2); w0 *= inv; w1 *= inv; w2 *= inv;
                const float lo = w0 * __uint_as_float(a0 << 16) + w1 * __uint_as_float(a1 << 16) + w2 * __uint_as_float(a2 << 16);
                const float hi_ = w0 * __uint_as_float(a0 & 0xffff0000u) + w1 * __uint_as_float(a1 & 0xffff0000u) + w2 * __uint_as_float(a2 & 0xffff0000u);
                const unsigned res = pk2(lo, hi_);
                asm volatile("s_waitcnt vmcnt(0)" ::: "memory");
                *(GAS unsigned*)(zr + h * 64 + c) = res; *(GAS unsigned*)(zr + 128 + 2 * ln) = 0u;
              } }
        }
        SEAM(pb + 2);
        if (IN(pb + 3)) {
            pg8::GateProjOrder S; S.init(T, D, G, bx);
            pg8::Gemm g{XB, WIN_t + (size_t)NQKV * 1024, 1024, 1024, 1024, ZQ, WP_t}; pg8::EpiGateProj E{ZG, SSQ};
            pg8::gemm_phase<pg8::EpiGateProj, pg8::GateProjOrder, true, true>(lds + RING_OFF, g, S, E);
        }
        SEAM(pb + 3);
        if (IN(pb + 4)) {
            pg8::Gemm g{ZG, WO_t, 3072, 1024, 1024, nullptr, nullptr}; pg8::StaticOrder S; S.init(T, D, G, bx);
            pg8::EpiRes E{XB, SSQ};
            pg8::gemm_phase<pg8::EpiRes, pg8::StaticOrder, false, true>(lds + RING_OFF, g, S, E);
        }
        SEAM(pb + 4);
        if (IN(pb + 5)) {
            pg8::Gemm g{XB, WUP_t, 1024, 1024, 1024, nullptr, nullptr}; pg8::StaticOrder S; S.init(T, FF, G, bx);
            pg8::EpiUp E{U, SSQ};
            pg8::gemm_phase<pg8::EpiUp, pg8::StaticOrder, true, true>(lds + RING_OFF, g, S, E);
        }
        SEAM(pb + 5);
        if (IN(pb + 6)) {
            pg8::Gemm g{U, WDN_t, 4096, 4096, 4096, nullptr, nullptr}; pg8::StaticOrder S; S.init(T, D, G, bx);
            if (l == 0) { pg8::EpiRes E{XB, SSQ}; pg8::gemm_phase<pg8::EpiRes, pg8::StaticOrder, false, true>(lds + RING_OFF, g, S, E); }
            else { pg8::EpiFinal E{XB, SSQ, out, args.in[13], &bar}; pg8::gemm_phase<pg8::EpiFinal, pg8::StaticOrder, false, true>(lds + RING_OFF, g, S, E); }
        }
#if MK_PROBE
        SEAM(pb + 6);
#else
        if (l == 0) SEAM(pb + 6);
#endif
    }
#if MK_PROBE
    if (IN(15)) {
        int tl_ = threadIdx.x; asm volatile("" : "+v"(tl_)); const int lane = tl_ & 63;
        const float pbv = (float)(__hip_atomic_load(TS + PROBE_B_HI, __ATOMIC_RELAXED, __HIP_MEMORY_SCOPE_AGENT) - __hip_atomic_load(TS + PROBE_B_LO, __ATOMIC_RELAXED, __HIP_MEMORY_SCOPE_AGENT)) * (PROBE_SCALE * 0.1f);
        for (int m = gw; m < T; m += NGW) { GAS f32x4* xr = (GAS f32x4*)(out + (size_t)m * D) + lane;
#pragma unroll
            for (int j = 0; j < 4; ++j) { f32x4 v = xr[64 * j]; v = v + pbv; xr[64 * j] = v; } }
        if (blockIdx.x == 0) { asm volatile("s_waitcnt vmcnt(0)" ::: "memory"); __syncthreads();
            const float pa = (float)(__hip_atomic_load(TS + PROBE_A_HI, __ATOMIC_RELAXED, __HIP_MEMORY_SCOPE_AGENT) - __hip_atomic_load(TS + PROBE_A_LO, __ATOMIC_RELAXED, __HIP_MEMORY_SCOPE_AGENT)) * PROBE_SCALE;
            if (threadIdx.x == 0) out[0] += pa; }
    }
#endif
#undef IN
#undef SEAM
}

extern "C" void kernel_launch(void* const* d_in, const int* in_sizes, int n_in, void* d_out, int out_size, void* d_ws, size_t ws_size, hipStream_t stream) {
    static int grid = 0;
    if (grid == 0) {
        if (n_in != 14 || in_sizes[0] != T * D || out_size != T * D || ws_size < WS_END) { fprintf(stderr, "kernel_launch: unexpected shapes (n_in %d, in0 %d, out %d, ws %zu)\n", n_in, n_in > 0 ? in_sizes[0] : -1, out_size, ws_size); grid = -1; return; }
        int dev = 0, cus = 0;
        if (hipGetDevice(&dev) != hipSuccess || hipDeviceGetAttribute(&cus, hipDeviceAttributeMultiprocessorCount, dev) != hipSuccess) { grid = -1; return; }
        if (hipFuncSetAttribute((const void*)mega, hipFuncAttributeMaxDynamicSharedMemorySize, LDS_BYTES) != hipSuccess) { fprintf(stderr, "kernel_launch: hipFuncSetAttribute failed\n"); grid = -1; return; }
        int per_cu = 0;
        (void)hipOccupancyMaxActiveBlocksPerMultiprocessor(&per_cu, (const void*)mega, NWAVES * 64, LDS_BYTES);
        (void)hipGetLastError();
        grid = cus;
    }
    if (grid < 0) return;
    (void)hipMemsetAsync((char*)d_ws + WS_CTL, 0, CTL_ZERO_BYTES, stream);
    Args a{};
    for (int i = 0; i < 14; ++i) a.in[i] = (const float*)d_in[i];
    a.out = (float*)d_out; a.ws = (unsigned char*)d_ws; a.li = 0; a.pad = 0;
#if MK_ONE_LAUNCH
    a.ph_lo = 0; a.ph_hi = N_PHASES;
    hipLaunchKernelGGL(mega, dim3(grid), dim3(NWAVES * 64), LDS_BYTES, stream, a);
#else
    for (int ph = 0; ph < N_PHASES; ++ph) {
        a.ph_lo = ph; a.ph_hi = ph + 1;
        hipLaunchKernelGGL(mega, dim3(grid), dim3(NWAVES * 64), LDS_BYTES, stream, a);
    }
#endif
}
```

```cpp
#include <hip/hip_runtime.h>
#include <cstdio>
#include <cstdint>
namespace pg8 {
#define PG8_LAS __attribute__((address_space(3)))
typedef unsigned short bf16_t;
typedef short bf16x8 __attribute__((ext_vector_type(8)));
typedef float f32x4 __attribute__((ext_vector_type(4)));
typedef unsigned u32x4 __attribute__((ext_vector_type(4)));
constexpr int BM = 256, BK = 64, HALF = 128, HTB = HALF * BK * 2  , STAGE_BYTES = 8 * HTB, NXCD = 8, WGM = 4;

__host__ __device__ __forceinline__ int lds_byte(int r, int c) { const int st = (r >> 4) * 2 + (c >> 5), rr = r & 15, cc = c & 31, ob = rr * 64 + cc * 2; return st * 1024 + (ob ^ (((ob >> 9) & 1) << 5)); }
__host__ __device__ __forceinline__ void stage_rc(int b, int& R, int& C) { const int st = b / 1024, sb = b % 1024, swz = sb ^ (((sb >> 9) & 1) << 5); R = (st >> 1) * 16 + swz / 64; C = (st & 1) * 32 + (swz % 64) / 2; }
__host__ __device__ __forceinline__ int perm32(int rho) { const int n = rho >> 4, i = rho & 15; return 8 * (i >> 2) + 4 * n + (i & 3); }

struct Unit { int pm, pn, k0, nt, br, pb, sel; };
struct Gemm { const bf16_t* A; const bf16_t* Bt; int lda, ldb, K; const bf16_t* A2; const bf16_t* Bt2; };

struct StaticOrder {
    static constexpr bool KSEG = false;
    __host__ __device__ static bool carry(const Unit&) { return false; }
    int nM, nN, nwg, G, c;
    __host__ __device__ void init(int M, int N, int G_, int c_) { nM = M / BM; nN = N / BM; nwg = nM * nN; G = G_; c = c_; }
    __host__ __device__ bool next(int i, Unit& u) const {
        const long L = (long)i * G + c; if (L >= nwg) return false;
        int wgid = (int)L; { const int q = nwg / NXCD, r = nwg % NXCD, xcd = wgid % NXCD, off = wgid / NXCD; wgid = (xcd < r ? xcd * (q + 1) : r * (q + 1) + (xcd - r) * q) + off; }
        const int nig = WGM * nN, gid = wgid / nig, fm = gid * WGM, gsz = (nM - fm) < WGM ? (nM - fm) : WGM;
        u.pm = fm + ((wgid % nig) % gsz); u.pn = (wgid % nig) / gsz; u.k0 = 0; u.nt = 0; u.br = 0; u.pb = u.pn; u.sel = 0; return true;
    }
    __device__ __forceinline__ void a_ready(const Unit&) const {}
    __device__ __forceinline__ void done(const Unit&) const {}
};

typedef float f32x2c_t __attribute__((ext_vector_type(2))); typedef __bf16 bf16x2c_t __attribute__((ext_vector_type(2)));
__device__ __forceinline__ unsigned cvt_pk_bf16(float lo, float hi) { const f32x2c_t v = {lo, hi}; const bf16x2c_t b = __builtin_convertvector(v, bf16x2c_t); return __builtin_bit_cast(unsigned, b); }
typedef float f32x2 __attribute__((ext_vector_type(2)));
template <class Epi, class Sched, bool ALIGN_EPI = false, bool SP2 = false>
__device__ __forceinline__ void gemm_phase(PG8_LAS unsigned char* lds, const Gemm g, const Sched& S, const Epi& E) {
    int tid_ = threadIdx.x; asm volatile("" : "+v"(tid_));
    const int tid = tid_, wid = __builtin_amdgcn_readfirstlane(tid >> 6), lane = tid & 63, wr = wid >> 2, wc = wid & 3, fr = lane & 15, fq = lane >> 4;
    const int K = g.K; int nt = K / BK;
    unsigned voffA[2], voffB[2];
#pragma unroll
    for (int i = 0; i < 2; ++i) { int R, C; stage_rc(tid * 16 + i * 8192, R, C); const int Rb = Epi::PERM ? ((R & ~31) + perm32(R & 31)) : R;
        voffA[i] = (unsigned)(R * g.lda + C) * 2u; voffB[i] = (unsigned)(Rb * g.ldb + C) * 2u; }
    const size_t kstep = (size_t)(BK * 2);
    const size_t hstepA = (size_t)HALF * g.lda * 2, hstepB = (size_t)HALF * g.ldb * 2;
    const size_t tstepA = 2 * hstepA, tstepB = 2 * hstepB;
    const unsigned ldsw = (unsigned)wid * 1024u;
    const int aoff = lds_byte(wr * 64 + fr, fq * 8), boff = lds_byte(wc * 32 + fr, fq * 8);
#define PG8_SA(b, h) (((b) * 2 + (h)) * HTB)
#define PG8_SB(b, h) ((4 + (b) * 2 + (h)) * HTB)
#define PG8_STAGE(bufoff, gbase, voff) do { _Pragma("unroll") for (int _i = 0; _i < 2; ++_i) \
        __builtin_amdgcn_global_load_lds((const unsigned*)((const char*)(gbase) + (voff)[_i]), (PG8_LAS unsigned*)(lds + (bufoff) + ldsw + _i * 8192), 16, 0, 0); } while (0)
#define PG8_LDA(dst, b, h) do { _Pragma("unroll") for (int m = 0; m < 4; ++m) _Pragma("unroll") for (int k = 0; k < 2; ++k) dst[m][k] = *(const PG8_LAS bf16x8*)(lds + PG8_SA(b, h) + aoff + m * 2048 + k * 1024); } while (0)
#define PG8_LDB(dst, b, h) do { _Pragma("unroll") for (int n = 0; n < 2; ++n) _Pragma("unroll") for (int k = 0; k < 2; ++k) dst[n][k] = *(const PG8_LAS bf16x8*)(lds + PG8_SB(b, h) + boff + n * 2048 + k * 1024); } while (0)
#define PG8_MMA(ai, bj, At, Bt) do { __builtin_amdgcn_s_setprio(1); _Pragma("unroll") for (int m = 0; m < 4; ++m) _Pragma("unroll") for (int n = 0; n < 2; ++n) _Pragma("unroll") for (int k = 0; k < 2; ++k) \
        acc[ai][bj][m][n] = __builtin_amdgcn_mfma_f32_16x16x32_bf16(Bt[n][k], At[m][k], acc[ai][bj][m][n], 0, 0, 0); __builtin_amdgcn_s_setprio(0); } while (0)
#define PG8_WAIT_V(n) asm volatile("s_waitcnt vmcnt(" #n ")" ::: "memory")
#define PG8_WAIT_L(n) asm volatile("s_waitcnt lgkmcnt(" #n ")" ::: "memory")
#define PG8_BAR __builtin_amdgcn_s_barrier()
#define PG8_SCHED __builtin_amdgcn_sched_barrier(0)
    Unit cur, nxt; int ui = 0;
    if (!S.next(0, cur)) return;
    f32x4 acc[2][2][4][2];
#pragma unroll
    for (int a = 0; a < 2; ++a)
#pragma unroll
        for (int b = 0; b < 2; ++b)
#pragma unroll
            for (int m = 0; m < 4; ++m)
#pragma unroll
                for (int n = 0; n < 2; ++n) acc[a][b][m][n] = (f32x4){0.f, 0.f, 0.f, 0.f};
    bf16x8 At[4][2], B0[2][2], B1[2][2];
    if constexpr (Sched::KSEG) nt = cur.nt;
    const char* cA = (const char*)((Sched::KSEG && cur.sel) ? g.A2 : g.A) + (size_t)cur.pm * tstepA + (Sched::KSEG ? (size_t)cur.k0 * 2 : 0); const char* cB = (const char*)((Sched::KSEG && cur.sel) ? g.Bt2 : g.Bt) + (size_t)cur.pb * tstepB + (Sched::KSEG ? (size_t)cur.k0 * 2 : 0);
    S.a_ready(cur);
    if constexpr (SP2) {
        PG8_STAGE(PG8_SB(0, 0), cB, voffB); PG8_STAGE(PG8_SB(0, 1), cB + hstepB, voffB); PG8_STAGE(PG8_SA(0, 0), cA, voffA); PG8_STAGE(PG8_SA(0, 1), cA + hstepA, voffA);
        if (wr == 1) PG8_BAR;
        PG8_WAIT_V(2); PG8_BAR;
        PG8_STAGE(PG8_SB(1, 0), cB + kstep, voffB); PG8_STAGE(PG8_SA(1, 0), cA + kstep, voffA); PG8_STAGE(PG8_SB(1, 1), cB + hstepB + kstep, voffB);
        PG8_WAIT_V(6); PG8_BAR;
    } else {
        PG8_STAGE(PG8_SB(0, 0), cB, voffB); PG8_STAGE(PG8_SA(0, 0), cA, voffA); PG8_STAGE(PG8_SB(0, 1), cB + hstepB, voffB); PG8_STAGE(PG8_SA(0, 1), cA + hstepA, voffA);
        if (wr == 1) PG8_BAR;
        PG8_WAIT_V(4); PG8_BAR;
        PG8_STAGE(PG8_SB(1, 0), cB + kstep, voffB); PG8_STAGE(PG8_SA(1, 0), cA + kstep, voffA); PG8_STAGE(PG8_SB(1, 1), cB + hstepB + kstep, voffB);
        PG8_WAIT_V(6); PG8_BAR;
    }
    for (;;) {
        const bool has_next = S.next(ui + 1, nxt);
        const char* nA = has_next ? (const char*)((Sched::KSEG && nxt.sel) ? g.A2 : g.A) + (size_t)nxt.pm * tstepA + (Sched::KSEG ? (size_t)nxt.k0 * 2 : 0) : cA; const char* nB = has_next ? (const char*)((Sched::KSEG && nxt.sel) ? g.Bt2 : g.Bt) + (size_t)nxt.pb * tstepB + (Sched::KSEG ? (size_t)nxt.k0 * 2 : 0) : cB;
        for (int t = 0; t < nt; t += 2) {
            const bool last = (t == nt - 2);
            const char* a1 = cA + (size_t)(t + 1) * kstep;
            const char* a2 = last ? nA : cA + (size_t)(t + 2) * kstep; const char* b2 = last ? nB : cB + (size_t)(t + 2) * kstep;
            const char* a3 = a2 + kstep; const char* b3 = b2 + kstep;
            if (last && has_next) S.a_ready(nxt);
            if constexpr (SP2) {
            PG8_LDB(B0, 0, 0); PG8_LDB(B1, 0, 1); PG8_SCHED; PG8_LDA(At, 0, 0); PG8_STAGE(PG8_SA(1, 1), a1 + hstepA, voffA);
            PG8_WAIT_V(8); PG8_WAIT_L(0); PG8_BAR; PG8_MMA(0, 0, At, B0); PG8_MMA(0, 1, At, B1); PG8_BAR; PG8_SCHED;
            PG8_LDA(At, 0, 1); PG8_STAGE(PG8_SB(0, 0), b2, voffB); PG8_STAGE(PG8_SB(0, 1), b2 + hstepB, voffB); PG8_STAGE(PG8_SA(0, 0), a2, voffA);
            PG8_WAIT_V(8); PG8_WAIT_L(0); PG8_BAR; PG8_MMA(1, 0, At, B0); PG8_MMA(1, 1, At, B1); PG8_BAR; PG8_SCHED;
            PG8_LDB(B0, 1, 0); PG8_LDB(B1, 1, 1); PG8_SCHED; PG8_LDA(At, 1, 0); PG8_STAGE(PG8_SA(0, 1), a2 + hstepA, voffA);
            PG8_WAIT_V(8); PG8_WAIT_L(0); PG8_BAR; PG8_MMA(0, 0, At, B0); PG8_MMA(0, 1, At, B1); PG8_BAR; PG8_SCHED;
            PG8_LDA(At, 1, 1); PG8_STAGE(PG8_SB(1, 0), b3, voffB); PG8_STAGE(PG8_SB(1, 1), b3 + hstepB, voffB); PG8_STAGE(PG8_SA(1, 0), a3, voffA);
            PG8_WAIT_V(8); PG8_WAIT_L(0); PG8_BAR; PG8_MMA(1, 0, At, B0); PG8_MMA(1, 1, At, B1); PG8_BAR; PG8_SCHED;
            } else {
            PG8_LDB(B0, 0, 0); PG8_SCHED; PG8_LDA(At, 0, 0); PG8_STAGE(PG8_SA(1, 1), a1 + hstepA, voffA);
            PG8_WAIT_L(8); PG8_BAR; PG8_WAIT_L(0); PG8_MMA(0, 0, At, B0); PG8_BAR; PG8_SCHED;
            PG8_LDB(B1, 0, 1); PG8_STAGE(PG8_SB(0, 0), b2, voffB);
            PG8_BAR; PG8_WAIT_L(0); PG8_MMA(0, 1, At, B1); PG8_BAR;
            PG8_LDA(At, 0, 1); PG8_STAGE(PG8_SA(0, 0), a2, voffA);
            PG8_BAR; PG8_WAIT_L(0); PG8_MMA(1, 0, At, B0); PG8_BAR; PG8_SCHED;
            PG8_STAGE(PG8_SB(0, 1), b2 + hstepB, voffB);
            PG8_WAIT_V(6); PG8_BAR; PG8_MMA(1, 1, At, B1); PG8_BAR;
            PG8_LDB(B0, 1, 0); PG8_SCHED; PG8_LDA(At, 1, 0); PG8_STAGE(PG8_SA(0, 1), a2 + hstepA, voffA);
            PG8_WAIT_L(8); PG8_BAR; PG8_WAIT_L(0); PG8_MMA(0, 0, At, B0); PG8_BAR; PG8_SCHED;
            PG8_LDB(B1, 1, 1); PG8_STAGE(PG8_SB(1, 0), b3, voffB);
            PG8_BAR; PG8_WAIT_L(0); PG8_MMA(0, 1, At, B1); PG8_BAR;
            PG8_LDA(At, 1, 1); PG8_STAGE(PG8_SA(1, 0), a3, voffA);
            PG8_BAR; PG8_WAIT_L(0); PG8_MMA(1, 0, At, B0); PG8_BAR; PG8_SCHED;
            PG8_STAGE(PG8_SB(1, 1), b3 + hstepB, voffB);
            PG8_WAIT_V(6); PG8_BAR; PG8_MMA(1, 1, At, B1); PG8_BAR;
            }
        }
        if constexpr (ALIGN_EPI) { if (wr == 0) PG8_BAR; }
        if constexpr (!Epi::AFTER_DRAIN) { int te_ = threadIdx.x; asm volatile("" : "+v"(te_) :: "memory");     E(acc, cur, wr, wc, te_ & 15, (te_ & 63) >> 4); S.done(cur); }
        if (!has_next) break;
        if (!Sched::carry(cur)) {
#pragma unroll
        for (int a = 0; a < 2; ++a)
#pragma unroll
            for (int b = 0; b < 2; ++b)
#pragma unroll
                for (int m = 0; m < 4; ++m)
#pragma unroll
                    for (int n = 0; n < 2; ++n) acc[a][b][m][n] = (f32x4){0.f, 0.f, 0.f, 0.f};
        }
        cur = nxt; cA = nA; cB = nB; ++ui; if constexpr (Sched::KSEG) nt = cur.nt;
        if constexpr (ALIGN_EPI) { if (wr == 1) PG8_BAR; }
    }
    PG8_WAIT_V(0);
    if constexpr (!ALIGN_EPI) { if (wr == 0) PG8_BAR; }
    PG8_BAR;
    if constexpr (Epi::AFTER_DRAIN) { E.fused(acc, cur, wr, wc, fr, fq, lds, wid, lane); S.done(cur); }
#undef PG8_SA
#undef PG8_SB
#undef PG8_STAGE
#undef PG8_LDA
#undef PG8_LDB
#undef PG8_MMA
#undef PG8_WAIT_V
#undef PG8_WAIT_L
#undef PG8_BAR
#undef PG8_SCHED
}
}
namespace pg8 {
__device__ __forceinline__ float row_rstd(const float* ssq, int row) {
    const f32x4 a = *(const f32x4*)(ssq + (size_t)row * 4);
    return 1.0f / sqrtf(((a[0] + a[1]) + (a[2] + a[3])) * (1.0f / 1024.0f) + 1e-6f);
}
__device__ __forceinline__ void rstd8(const float* ssq, int row0, int, float (&rs)[8]) {
    f32x4 q[8];
#pragma unroll
    for (int i = 0; i < 8; ++i) q[i] = *(const f32x4*)(ssq + (size_t)(row0 + (i >> 2) * HALF + (i & 3) * 16) * 4);
#pragma unroll
    for (int i = 0; i < 8; ++i) { const float t = (q[i][0] + q[i][1]) + (q[i][2] + q[i][3]); rs[i] = __builtin_amdgcn_rsqf(t * (1.0f / 1024.0f) + 1e-6f); }
}
__device__ __forceinline__ float xsum32(float v) { const auto r = __builtin_amdgcn_permlane32_swap(__float_as_uint(v), __float_as_uint(v), false, false); return __uint_as_float(r[0]) + __uint_as_float(r[1]); }
__device__ __forceinline__ float xsum16(float v) { const auto r = __builtin_amdgcn_permlane16_swap(__float_as_uint(v), __float_as_uint(v), false, false); return __uint_as_float(r[0]) + __uint_as_float(r[1]); }
__device__ __forceinline__ float xmax32(float v) { const auto r = __builtin_amdgcn_permlane32_swap(__float_as_uint(v), __float_as_uint(v), false, false); return __builtin_fmaxf(__uint_as_float(r[0]), __uint_as_float(r[1])); }
__device__ __forceinline__ float partner16(float v, bool odd16) { const auto r = __builtin_amdgcn_permlane16_swap(__float_as_uint(v), __float_as_uint(v), false, false); return __uint_as_float(odd16 ? r[0] : r[1]); }
__device__ __forceinline__ void store_wt(void* p, u32x4 v) { asm volatile("global_store_dwordx4 %0, %1, off sc1\n\ts_nop 1" :: "v"(p), "v"(v) : "memory"); }
__device__ __forceinline__ u32x4 pack8(const float (&v)[8]) { u32x4 w; w.x = cvt_pk_bf16(v[0], v[1]); w.y = cvt_pk_bf16(v[2], v[3]); w.z = cvt_pk_bf16(v[4], v[5]); w.w = cvt_pk_bf16(v[6], v[7]); return w; }
__device__ __forceinline__ void unpack8(const u32x4 w, float (&v)[8]) {
    v[0] = __uint_as_float(w.x << 16); v[1] = __uint_as_float(w.x & 0xffff0000u); v[2] = __uint_as_float(w.y << 16); v[3] = __uint_as_float(w.y & 0xffff0000u);
    v[4] = __uint_as_float(w.z << 16); v[5] = __uint_as_float(w.z & 0xffff0000u); v[6] = __uint_as_float(w.w << 16); v[7] = __uint_as_float(w.w & 0xffff0000u);
}
#define PG8_V8(v, a, b, sc) do { v[0] = a[0] * (sc); v[1] = a[1] * (sc); v[2] = a[2] * (sc); v[3] = a[3] * (sc); v[4] = b[0] * (sc); v[5] = b[1] * (sc); v[6] = b[2] * (sc); v[7] = b[3] * (sc); } while (0)

struct EpiQKV {
    static constexpr bool PERM = true, AFTER_DRAIN = false;
    bf16_t* ZQ; bf16_t* ZKV; const float* ssq; const unsigned* rope; float* ksum;
    template <int NB, bool KSUM> __device__ __forceinline__ void body(const f32x4 (&acc)[2][2][4][2], const Unit& u, int wr, int wc, int fr, int fq) const {
        const int row0 = u.pm * BM + wr * 64 + fr, colt = u.pn * BM;
        bf16_t* base; int ldc, cb;
        if (colt < 1024) { base = ZQ; ldc = 1024; cb = colt; } else { base = ZKV; ldc = 1536; cb = colt - 1024; }
        const int hg0 = (colt + wc * 32) >> 6;
        const bool half0 = (wc & 1) == 0;
        const bool rope0 = (hg0 < 12) || (hg0 >= 16 && hg0 < 22) || (hg0 >= 28 && hg0 < 34), rope1 = (hg0 + 2 < 12) || (hg0 + 2 >= 16 && hg0 + 2 < 22) || (hg0 + 2 >= 28 && hg0 + 2 < 34);
        const bool anyrope = half0 && (rope0 || rope1);
        float rs[8]; rstd8(ssq, row0, fq, rs);
        asm volatile("" ::: "memory");
        float ks[2][8];
        if (KSUM) {
#pragma unroll
            for (int bj = 0; bj < 2; ++bj)
#pragma unroll
                for (int j = 0; j < 8; ++j) ks[bj][j] = 0.f; }
#pragma unroll
        for (int rb = 0; rb < 8; rb += NB) {
            u32x4 rt[NB][2];
            if (anyrope) {
#pragma unroll
                for (int i = 0; i < NB; ++i) { const int ri = rb + i; const u32x4* rp = (const u32x4*)(rope + (size_t)((row0 + (ri >> 2) * HALF + (ri & 3) * 16) & 2047) * 8);
                    rt[i][0] = rp[0]; rt[i][1] = rp[1]; } }
#pragma unroll
            for (int i = 0; i < NB; ++i) {
                const int ri = rb + i, ai = ri >> 2, m = ri & 3;
                const int row = row0 + ai * HALF + m * 16;
                const float rstd = rs[ri];
#pragma unroll
                for (int bj = 0; bj < 2; ++bj) {
                    const int hg = hg0 + 2 * bj;
                    const bool isrope = bj == 0 ? rope0 : rope1;
                    float v[8]; PG8_V8(v, acc[ai][bj][m][0], acc[ai][bj][m][1], rstd);
                    if (isrope && half0) {
                        float p[8];
#pragma unroll
                        for (int j = 0; j < 8; ++j) p[j] = partner16(v[j], (fq & 1) != 0);
                        if (fq < 2) { const float sg = (fq == 0) ? -1.f : 1.f;
#pragma unroll
                            for (int j = 0; j < 8; ++j) { const unsigned w = rt[i][j >> 2][j & 3]; const float cs = (float)__builtin_bit_cast(_Float16, (unsigned short)(w & 0xffffu)), sn = (float)__builtin_bit_cast(_Float16, (unsigned short)(w >> 16));
                                v[j] = v[j] * cs + sg * (p[j] * sn); } }
                    }
                    if (hg < 16) {
#pragma unroll
                        for (int j = 0; j < 8; ++j) v[j] *= 0.18033688011112042f; }
                    *(u32x4*)(base + ((unsigned)row * (unsigned)ldc + (unsigned)(cb + bj * HALF + wc * 32 + 8 * fq))) = pack8(v);
                    if (KSUM) { if (hg >= 28 && hg < 34) {
#pragma unroll
                        for (int j = 0; j < 8; ++j) ks[bj][j] += v[j]; } }
                }
            }
        }
        if (KSUM) {
#pragma unroll
            for (int bj = 0; bj < 2; ++bj) { const int hg = hg0 + 2 * bj;
                if (hg >= 28 && hg < 34) {
                    float* kp = ksum + (size_t)(u.pm * 6 + (hg - 28)) * 64 + (wc & 1) * 32 + 8 * fq;
#pragma unroll
                    for (int j = 0; j < 8; ++j) { float s = ks[bj][j]; s += __shfl_xor(s, 1); s += __shfl_xor(s, 2); s += __shfl_xor(s, 4); s += __shfl_xor(s, 8);
                        if (fr == 0) atomicAdd(kp + j, s); }
                } }
        }
    }
    __device__ __forceinline__ void operator()(const f32x4 (&acc)[2][2][4][2], const Unit& u, int wr, int wc, int fr, int fq) const {
        if (u.pn == 7 || u.pn == 8) body<4, true>(acc, u, wr, wc, fr, fq); else body<4, false>(acc, u, wr, wc, fr, fq);
    }
};
struct EpiGate {
    static constexpr bool PERM = true, AFTER_DRAIN = false;
    bf16_t* ZG; const float* ssq;
    __device__ __forceinline__ void operator()(const f32x4 (&acc)[2][2][4][2], const Unit& u, int wr, int wc, int fr, int fq) const {
        const int row0 = u.pm * BM + wr * 64 + fr, col0 = u.pn * BM + wc * 32 + 8 * fq;
        float rs[8]; rstd8(ssq, row0, fq, rs);
#pragma unroll
        for (int ai = 0; ai < 2; ++ai)
#pragma unroll
            for (int m = 0; m < 4; ++m) { const int row = row0 + ai * HALF + m * 16; const float rstd = rs[ai * 4 + m];
#pragma unroll
                for (int bj = 0; bj < 2; ++bj) { float v[8]; PG8_V8(v, acc[ai][bj][m][0], acc[ai][bj][m][1], rstd);
#pragma unroll
                    for (int j = 0; j < 8; ++j) v[j] = __builtin_amdgcn_rcpf(1.0f + __builtin_amdgcn_exp2f(v[j] * -1.4426950408889634f));
                    *(u32x4*)(ZG + (size_t)row * 3072 + col0 + bj * HALF) = pack8(v); } }
    }
};
struct EpiPlain {
    static constexpr bool PERM = true, AFTER_DRAIN = false;
    bf16_t* O; int ldc;
    __device__ __forceinline__ void operator()(const f32x4 (&acc)[2][2][4][2], const Unit& u, int wr, int wc, int fr, int fq) const {
        const int row0 = u.pm * BM + wr * 64 + fr, col0 = u.pn * BM + wc * 32 + 8 * fq;
#pragma unroll
        for (int ai = 0; ai < 2; ++ai)
#pragma unroll
            for (int m = 0; m < 4; ++m) { const int row = row0 + ai * HALF + m * 16;
#pragma unroll
                for (int bj = 0; bj < 2; ++bj) { float v[8]; PG8_V8(v, acc[ai][bj][m][0], acc[ai][bj][m][1], 1.0f);
                    *(u32x4*)(O + (size_t)row * ldc + col0 + bj * HALF) = pack8(v); } }
    }
};
template <int BR> struct EpiProj {
    static constexpr bool PERM = true, AFTER_DRAIN = false;
    bf16_t* ZG;
    __device__ __forceinline__ void operator()(const f32x4 (&acc)[2][2][4][2], const Unit& u, int wr, int wc, int fr, int fq) const {
        const int row0 = u.pm * BM + wr * 64 + fr, col0 = u.pn * BM + wc * 32 + 8 * fq;
#pragma unroll
        for (int ai = 0; ai < 2; ++ai)
#pragma unroll
            for (int m = 0; m < 4; ++m) { const int row = row0 + ai * HALF + m * 16;
#pragma unroll
                for (int bj = 0; bj < 2; ++bj) { bf16_t* yp = ZG + (size_t)row * 3072 + col0 + bj * HALF;
                    float g[8], v[8]; unpack8(*(const u32x4*)(yp + BR * 1024), g); PG8_V8(v, acc[ai][bj][m][0], acc[ai][bj][m][1], 1.0f);
                    if (BR > 0) { float y[8]; unpack8(*(const u32x4*)yp, y);
#pragma unroll
                        for (int j = 0; j < 8; ++j) v[j] = y[j] + g[j] * v[j]; }
                    else {
#pragma unroll
                        for (int j = 0; j < 8; ++j) v[j] = g[j] * v[j]; }
                    *(u32x4*)yp = pack8(v); } }
    }
};
struct GateProjOrder : StaticOrder {
    static constexpr bool KSEG = true;
    __host__ __device__ static bool carry(const Unit& u) { return u.br == 3 || u.br == 4; }
    __host__ __device__ bool next(int i, Unit& u) const {
        if (!StaticOrder::next(i / 6, u)) return false;
        const int sg = i % 6; u.br = sg;
        if (sg < 3) { u.sel = 0; u.pb = 4 * sg + u.pn; u.k0 = 0; u.nt = 16; }
        else { u.sel = 1; u.pb = u.pn; u.k0 = (sg == 3) ? 0 : (sg == 4) ? 384 : 768; u.nt = (sg == 3) ? 2 : (sg == 4) ? 6 : 4; }
        return true;
    }
};
struct EpiGateProj {
    static constexpr bool PERM = true, AFTER_DRAIN = false;
    bf16_t* Y; unsigned char* GP; const float* ssq;
    static __device__ __forceinline__ unsigned pack4(float a, float b, float c, float d) {
        const unsigned p01 = __builtin_amdgcn_perm(__float_as_uint(b), __float_as_uint(a), 0x0c0c0400u), p23 = __builtin_amdgcn_perm(__float_as_uint(d), __float_as_uint(c), 0x0c0c0400u);
        return __builtin_amdgcn_perm(p23, p01, 0x05040100u);
    }
    static __device__ __forceinline__ f32x4 ub4(unsigned w) { return (f32x4){(float)(w & 0xffu), (float)((w >> 8) & 0xffu), (float)((w >> 16) & 0xffu), (float)(w >> 24)}; }
    __device__ __forceinline__ void operator()(f32x4 (&acc)[2][2][4][2], const Unit& u, int wr, int wc, int fr, int fq) const {
        const int row0 = u.pm * BM + wr * 64 + fr, col0 = u.pn * BM + wc * 32 + 8 * fq;
        const unsigned gb = (unsigned)((u.pm * 4 + u.pn) * 3) * 65536u + (unsigned)((wr * 4 + wc) * 64 + fq * 16 + fr) * 16u;
        if (u.br < 3) {
            float rs[8]; rstd8(ssq, row0, fq, rs);
            unsigned char* gp = GP + (gb + (unsigned)u.br * 65536u);
#pragma unroll
            for (int ai = 0; ai < 2; ++ai)
#pragma unroll
                for (int m = 0; m < 4; ++m) { const float rstd = rs[ai * 4 + m] * -1.4426950408889634f;
                    u32x4 w;
#pragma unroll
                    for (int bj = 0; bj < 2; ++bj) { float q[8]; const f32x4 t0 = acc[ai][bj][m][0] * rstd, t1 = acc[ai][bj][m][1] * rstd;
#pragma unroll
                        for (int j = 0; j < 4; ++j) {
                            q[j] = __builtin_fmaf(__builtin_amdgcn_rcpf(1.0f + fminf(__builtin_amdgcn_exp2f(t0[j]), 254.0f)), 255.0f, 8388608.0f);
                            q[4 + j] = __builtin_fmaf(__builtin_amdgcn_rcpf(1.0f + fminf(__builtin_amdgcn_exp2f(t1[j]), 254.0f)), 255.0f, 8388608.0f); }
                        w[2 * bj] = pack4(q[0], q[1], q[2], q[3]); w[2 * bj + 1] = pack4(q[4], q[5], q[6], q[7]); }
                    store_wt(gp + (ai * 4 + m) * 8192, w); }
        } else if (u.br == 5) {
            const unsigned char* gp = GP + (gb + 2u * 65536u);
            const unsigned oy = (unsigned)row0 * 1024u + (unsigned)col0;
            u32x4 g2[8];
#pragma unroll
            for (int p = 0; p < 8; ++p) g2[p] = *(const u32x4*)(gp + p * 8192);
#pragma unroll
            for (int ai = 0; ai < 2; ++ai)
#pragma unroll
                for (int m = 0; m < 4; ++m)
#pragma unroll
                    for (int bj = 0; bj < 2; ++bj) { const f32x4 y0 = acc[ai][bj][m][0] * (ub4(g2[ai * 4 + m][2 * bj]) * (1.0f / 255.0f)), y1 = acc[ai][bj][m][1] * (ub4(g2[ai * 4 + m][2 * bj + 1]) * (1.0f / 255.0f));
                        float v[8] = {y0[0], y0[1], y0[2], y0[3], y1[0], y1[1], y1[2], y1[3]};
                        store_wt(Y + (oy + (unsigned)((ai * HALF + m * 16) * 1024 + bj * HALF)), pack8(v)); }
        }
        if (u.br == 3 || u.br == 4) {
            const unsigned char* gn = GP + (gb + (unsigned)(u.br - 3) * 65536u);
#pragma unroll
            for (int ai = 0; ai < 2; ++ai) {
                u32x4 n_[4], d_[4];
#pragma unroll
                for (int m = 0; m < 4; ++m) { n_[m] = *(const u32x4*)(gn + (ai * 4 + m) * 8192); d_[m] = *(const u32x4*)(gn + 65536 + (ai * 4 + m) * 8192); }
#pragma unroll
                for (int m = 0; m < 4; ++m)
#pragma unroll
                    for (int bj = 0; bj < 2; ++bj) {
                        const f32x4 n0 = ub4(n_[m][2 * bj]), n1 = ub4(n_[m][2 * bj + 1]), d0 = ub4(d_[m][2 * bj]), d1 = ub4(d_[m][2 * bj + 1]);
                        const f32x4 r0 = {n0[0] * __builtin_amdgcn_rcpf(d0[0]), n0[1] * __builtin_amdgcn_rcpf(d0[1]), n0[2] * __builtin_amdgcn_rcpf(d0[2]), n0[3] * __builtin_amdgcn_rcpf(d0[3])};
                        const f32x4 r1 = {n1[0] * __builtin_amdgcn_rcpf(d1[0]), n1[1] * __builtin_amdgcn_rcpf(d1[1]), n1[2] * __builtin_amdgcn_rcpf(d1[2]), n1[3] * __builtin_amdgcn_rcpf(d1[3])};
                        acc[ai][bj][m][0] = acc[ai][bj][m][0] * r0; acc[ai][bj][m][1] = acc[ai][bj][m][1] * r1;
                        asm volatile("" : "+v"(acc[ai][bj][m][0]), "+v"(acc[ai][bj][m][1])); }
            }
        }
    }
};
struct EpiRes {
    static constexpr bool PERM = true, AFTER_DRAIN = true;
    __device__ static bool stores16(const Unit&) { return true; }
    bf16_t* xb; float* ssq;
    __device__ __forceinline__ void fused(const f32x4 (&acc)[2][2][4][2], const Unit& u, int wr, int wc, int, int, PG8_LAS unsigned char* lds, int, int) const {
        int te_ = threadIdx.x; asm volatile("" : "+v"(te_) :: "memory"); const int fr = te_ & 15, fq = (te_ & 63) >> 4;
        const int row0 = u.pm * BM + wr * 64 + fr, col0 = u.pn * BM + wc * 32 + 8 * fq;
        const unsigned o0 = (unsigned)row0 * 1024u + (unsigned)col0;
        PG8_LAS float* P = (PG8_LAS float*)lds;
        u32x4 bs[2][4][2];
#pragma unroll
        for (int ai = 0; ai < 2; ++ai)
#pragma unroll
            for (int m = 0; m < 4; ++m)
#pragma unroll
                for (int bj = 0; bj < 2; ++bj) bs[ai][m][bj] = *(const u32x4*)(xb + (o0 + (unsigned)((ai * HALF + m * 16) * 1024 + bj * HALF)));
#pragma unroll
        for (int ai = 0; ai < 2; ++ai) {
#pragma unroll
            for (int m = 0; m < 4; ++m) { float sq = 0.f;
#pragma unroll
                for (int bj = 0; bj < 2; ++bj) {
                    float b[8], v[8]; unpack8(bs[ai][m][bj], b); PG8_V8(v, acc[ai][bj][m][0], acc[ai][bj][m][1], 1.0f);
#pragma unroll
                    for (int j = 0; j < 8; ++j) { v[j] += b[j]; sq += v[j] * v[j]; }
                    store_wt(xb + (o0 + (unsigned)((ai * HALF + m * 16) * 1024 + bj * HALF)), pack8(v)); }
                sq = xsum16(sq); sq = xsum32(sq);
                if (fq == 0) P[(ai * HALF + wr * 64 + m * 16 + fr) * 4 + wc] = sq; }
        }
        asm volatile("s_waitcnt lgkmcnt(0)" ::: "memory"); __builtin_amdgcn_s_barrier(); asm volatile("" ::: "memory");
        if (te_ < 256) { const f32x4 p = *(PG8_LAS const f32x4*)(P + te_ * 4); ssq[(unsigned)(u.pm * BM + te_) * 4u + (unsigned)u.pn] = (p[0] + p[1]) + (p[2] + p[3]); }
    }
};
struct EpiUp {
    static constexpr bool PERM = true, AFTER_DRAIN = false;
    bf16_t* U; const float* ssq;
    __device__ __forceinline__ void operator()(const f32x4 (&acc)[2][2][4][2], const Unit& u, int wr, int wc, int fr, int fq) const {
        const int row0 = u.pm * BM + wr * 64 + fr, col0 = u.pn * BM + wc * 32 + 8 * fq;
        float rs[8]; rstd8(ssq, row0, fq, rs);
#pragma unroll
        for (int ai = 0; ai < 2; ++ai)
#pragma unroll
            for (int m = 0; m < 4; ++m) { const int row = row0 + ai * HALF + m * 16; const float rstd = rs[ai * 4 + m];
#pragma unroll
                for (int bj = 0; bj < 2; ++bj) { float v[8]; PG8_V8(v, acc[ai][bj][m][0], acc[ai][bj][m][1], rstd);
#pragma unroll
                    for (int j = 0; j < 8; ++j) { const float r = fmaxf(v[j], 0.f); v[j] = r * r; }
                    store_wt(U + (size_t)row * 4096 + col0 + bj * HALF, pack8(v)); } }
    }
};
}
#define GAS __attribute__((address_space(1)))
#define LAS __attribute__((address_space(3)))
typedef unsigned short bf16;
typedef unsigned v4u __attribute__((ext_vector_type(4)));
typedef float f32x4 __attribute__((ext_vector_type(4)));
typedef short bf16x8 __attribute__((ext_vector_type(8)));
typedef GAS unsigned gu32;
typedef GAS unsigned long long gu64;
#define RLX_AGENT __ATOMIC_RELAXED, __HIP_MEMORY_SCOPE_AGENT
#define LDS_WAIT() asm volatile("s_waitcnt lgkmcnt(0)" ::: "memory")
#define VM_WAIT() asm volatile("s_waitcnt vmcnt(0)" ::: "memory")
__device__ __forceinline__ unsigned long long rt() { return __builtin_amdgcn_s_memrealtime(); }
__device__ __forceinline__ unsigned f2bf(float f) { unsigned u = __builtin_bit_cast(unsigned, f); return (u + 0x7fffu + ((u >> 16) & 1u)) >> 16; }
__device__ __forceinline__ unsigned pk2(float lo, float hi) { return f2bf(lo) | (f2bf(hi) << 16); }

#define XB_TMO      128
#define XB_XCNT(j)  (256  + 64 * (j))
#define XB_XSUB(j)  (1280 + 64 * (j))
#define XB_XGEN(j)  (2304 + 64 * (j))
#define XB_TOP      3328
#define XB_TOPGEN   3392
#define XCD_BAR_WORDS 3456
#define XB_SPIN_CAP (1u << 18)

__device__ __forceinline__ unsigned xb_ld(unsigned* p)              { return __hip_atomic_load(p, __ATOMIC_RELAXED, __HIP_MEMORY_SCOPE_AGENT); }
__device__ __forceinline__ unsigned xb_add(unsigned* p, unsigned v) { return __hip_atomic_fetch_add(p, v, __ATOMIC_RELAXED, __HIP_MEMORY_SCOPE_AGENT); }
__device__ __forceinline__ unsigned xb_xcc_id() { return (unsigned)__builtin_amdgcn_s_getreg((3 << 11) | 20) & 0xFu; }
#define XB_SPIN(cond, bar) do { unsigned _sp = 0; while (cond) { __builtin_amdgcn_s_sleep(1); \
    if ((++_sp & 255u) == 0u) { if (xb_ld(&(bar)[XB_TMO])) break; if (_sp > XB_SPIN_CAP) { atomicAdd(&(bar)[XB_TMO], 1u); break; } } } } while (0)

struct XcdBarrier {
    unsigned* bar; unsigned x;
    volatile LAS unsigned* st;
};

__device__ __forceinline__ XcdBarrier xcd_barrier_post(unsigned* bar, volatile LAS unsigned* st) {
    XcdBarrier b; b.bar = bar; b.x = xb_xcc_id(); b.st = st;
    if (threadIdx.x == 0) (void)xb_add(&bar[XB_XCNT(b.x)], 1u);
    return b;
}
__device__ __forceinline__ void xcd_barrier_complete(unsigned* bar, unsigned x, unsigned& nloc, unsigned& nx) {
    const unsigned G = gridDim.x * gridDim.y * gridDim.z;
    unsigned sum, cnt, mine, sp = 0u;
    for (;;) {
        sum = 0u; cnt = 0u; mine = 0u;
#pragma unroll
        for (unsigned j = 0; j < 16; ++j) { const unsigned c = xb_ld(&bar[XB_XCNT(j)]); sum += c; cnt += (c > 0u) ? 1u : 0u; mine = (j == x) ? c : mine; }
        if (sum == G) break;
        __builtin_amdgcn_s_sleep(1);
        if ((++sp & 255u) == 0u) { if (xb_ld(&bar[XB_TMO])) break; if (sp > XB_SPIN_CAP) { atomicAdd(&bar[XB_TMO], 1u); break; } }
    }
    nloc = mine > 0u ? mine : 1u; nx = cnt > 0u ? cnt : 1u;
}

__device__ __forceinline__ void xcd_barrier(const XcdBarrier& b) {
    asm volatile("s_waitcnt vmcnt(0)" ::: "memory");
    __syncthreads();
    if (threadIdx.x == 0) {
        unsigned* bar = b.bar;
        __builtin_amdgcn_s_waitcnt(0);
        unsigned nloc = b.st[0], nx = b.st[1];
        if (nloc == 0u) { xcd_barrier_complete(bar, b.x, nloc, nx); b.st[0] = nloc; b.st[1] = nx; }
        const unsigned old = xb_add(&bar[XB_XSUB(b.x)], 1u);
        const unsigned gen = old / nloc;
        if (old + 1u == (gen + 1u) * nloc) {
            __builtin_amdgcn_fence(__ATOMIC_RELEASE, "agent");
            asm volatile("s_waitcnt vmcnt(0)" ::: "memory");
            const unsigned og = xb_add(&bar[XB_TOP], 1u);
            const unsigned tg = og / nx;
            if (og + 1u == (tg + 1u) * nx) xb_add(&bar[XB_TOPGEN], 1u);
            else XB_SPIN(xb_ld(&bar[XB_TOPGEN]) == tg, bar);
            __builtin_amdgcn_fence(__ATOMIC_ACQUIRE, "agent");
            xb_add(&bar[XB_XGEN(b.x)], 1u);
            asm volatile("s_waitcnt vmcnt(0)" ::: "memory");
        } else {
            XB_SPIN(xb_ld(&bar[XB_XGEN(b.x)]) == gen, bar);
            __builtin_amdgcn_fence(__ATOMIC_ACQUIRE, "agent");
            asm volatile("s_waitcnt vmcnt(0)" ::: "memory");
        }
    }
    __syncthreads();
}

constexpr int NWAVES = 8;
constexpr int T = 16384, D = 1024, SEQ = 2048, FF = 4096, DIN = 5632, NQKV = 2560, NGATE = 3072, NMEMROWS = 2048;
constexpr size_t MiB = 1u << 20;
constexpr size_t WS_CTL = 0, CTL_ZERO_BYTES = 1 * MiB;
constexpr size_t WS_KSUM = 256 * 1024;
constexpr size_t WS_ROPE = 1 * MiB;
constexpr size_t WS_SSQ = 2 * MiB;
constexpr size_t WS_PTRS = 768 * 1024;
constexpr size_t WS_LSE = 3 * MiB;
constexpr size_t WS_MKV = 4 * MiB;
constexpr size_t WS_MEMN = 6 * MiB;
constexpr size_t WS_W = 10 * MiB;
constexpr size_t W_IN = 0, W_UP = 11 * MiB, W_DN = 19 * MiB, W_O = 27 * MiB, W_P = 29 * MiB, W_MKV = 31 * MiB, W_LAYER = 32 * MiB;
constexpr size_t WS_XB = 74 * MiB;
constexpr size_t WS_ZQ = 106 * MiB;
constexpr size_t WS_ZKV = 138 * MiB;
constexpr size_t WS_ZG = 138 * MiB;
constexpr size_t WS_GP = 170 * MiB;
constexpr size_t WS_U = 106 * MiB;
constexpr size_t WS_END = 234 * MiB;
constexpr int CW_QUEUE = 2048;
constexpr int CW_BAR = 4096;
constexpr int RING_OFF = 0, RING_BYTES = 131072, LDSCTL_OFF = RING_BYTES, MISC_OFF = LDSCTL_OFF + 320, LDS_BYTES = 147456;

__device__ __forceinline__ float wave_sum(float v) {
#pragma unroll
    for (int o = 1; o < 64; o <<= 1) v += __shfl_xor(v, o);
    return v;
}
__device__ __forceinline__ float bf2f(bf16 h) { return __uint_as_float((unsigned)h << 16); }

struct TrD { const float* W; const float* gain; bf16* WT; int N, ldt, k0, n0, drow, dcol; };
__device__ __forceinline__ void tr_load(const TrD& d, f32x4 (&v)[8], float (&gn)[8], int lane) {
    const int lr = lane >> 3, n4 = lane & 7;
#pragma unroll
    for (int i = 0; i < 8; ++i) { const int kk = 8 * i + lr; v[i] = __builtin_nontemporal_load((const GAS f32x4*)(d.W + (size_t)(d.k0 + kk) * d.N + d.n0 + 4 * n4)); gn[i] = d.gain ? d.gain[d.k0 + kk] : 1.0f; }
}
__device__ __forceinline__ void tr_fin(const TrD& d, const f32x4 (&v)[8], const float (&gn)[8], LAS float* scr, int lane) {
    const int lr = lane >> 3, n4 = lane & 7;
#pragma unroll
    for (int i = 0; i < 8; ++i) { const int kk = 8 * i + lr; LAS float* q = scr + kk * 33 + 4 * n4; q[0] = v[i].x * gn[i]; q[1] = v[i].y * gn[i]; q[2] = v[i].z * gn[i]; q[3] = v[i].w * gn[i]; }
    LDS_WAIT(); asm volatile("" ::: "memory");
    const int c = lane & 7;
#pragma unroll
    for (int j = 0; j < 4; ++j) { const int n = (lane >> 3) + 8 * j; const LAS float* s = scr + (8 * c) * 33 + n;
        v4u o; o.x = pk2(s[0 * 33], s[1 * 33]); o.y = pk2(s[2 * 33], s[3 * 33]); o.z = pk2(s[4 * 33], s[5 * 33]); o.w = pk2(s[6 * 33], s[7 * 33]);
        *(GAS v4u*)(d.WT + (size_t)(d.drow + n) * d.ldt + d.dcol + d.k0 + 8 * c) = o; }
    LDS_WAIT(); asm volatile("" ::: "memory");
}
__device__ __forceinline__ int win_dest_row(int n) {
    if (n < 384) return n;
    if (n < 768) return 1024 + (n - 384);
    if (n < 1152) return 1024 + 384 + (n - 768);
    if (n < 1536) return 384 + (n - 1152);
    if (n < 1920) return 1024 + 768 + (n - 1536);
    if (n < 2304) return 1024 + 1152 + (n - 1920);
    if (n < 2560) return 768 + (n - 2304);
    return n;
}

typedef unsigned u32x4p __attribute__((ext_vector_type(4)));

namespace att {
typedef short bf16x8 __attribute__((ext_vector_type(8)));
typedef short s16x4 __attribute__((ext_vector_type(4)));
typedef float f32x16 __attribute__((ext_vector_type(16)));
constexpr int KP = 144, VP = 192;
constexpr int KBUF = 64 * KP, VBUF = 64 * VP, BUF = KBUF + VBUF;
constexpr float LOG2E = 1.4426950408889634f;
__device__ __forceinline__ int crow(int r, int hi) { return (r & 3) + 8 * (r >> 2) + 4 * hi; }
__device__ __forceinline__ float xsum(float v) { return pg8::xsum32(v); }
__device__ __forceinline__ float xmax(float v) { return pg8::xmax32(v); }
__device__ __forceinline__ s16x4 vtr(LAS const unsigned char* p) { typedef short v4i16_t __attribute__((ext_vector_type(4))); return __builtin_bit_cast(s16x4, __builtin_amdgcn_ds_read_tr16_b64_v4i16((LAS v4i16_t*)p)); }

struct Unit {
    int kind;
    const bf16* Q; bf16* O;
    int qrow0, qstride, nq;
    const bf16* K; const bf16* V; int kvpitch;
    int krow0, kstride;
    int t_lo, t_hi;
    int qidx0;
    int qb;
    const float* ksum;
    float* lse; int lse_stride;
};

template <int KIND> __device__ __forceinline__ void att_tile(LAS const unsigned char* kb, const Unit& u, int t, int wid, int qi, int hi, unsigned koff, unsigned voff, unsigned sel,
                                                             const bf16x8 (&qf)[4], float& m, f32x16& o0, f32x16& o1, f32x16& o2) {
    bf16x8 ka[4], kc[4];
#pragma unroll
    for (int ks = 0; ks < 4; ++ks) { ka[ks] = *(LAS const bf16x8*)(kb + koff + 32 * ks); kc[ks] = *(LAS const bf16x8*)(kb + koff + 32 * KP + 32 * ks); }
    bf16x8 va[2][2], vc[2][2];
#pragma unroll
    for (int sub_ = 0; sub_ < 2; ++sub_)
#pragma unroll
        for (int s = 0; s < 2; ++s) {
            LAS const unsigned char* vb = kb + voff + (32 * sub_ + 16 * s) * VP;
            const s16x4 a_lo = vtr(vb), a_hi = vtr(vb + 8 * VP), b_lo = vtr(vb + 64), b_hi = vtr(vb + 8 * VP + 64);
            va[sub_][s] = (bf16x8){a_lo[0], a_lo[1], a_lo[2], a_lo[3], a_hi[0], a_hi[1], a_hi[2], a_hi[3]};
            vc[sub_][s] = (bf16x8){b_lo[0], b_lo[1], b_lo[2], b_lo[3], b_hi[0], b_hi[1], b_hi[2], b_hi[3]};
        }
    const int qlo = u.qidx0 + 32 * wid;
    bool bs = true, needmask = false;
    if (KIND == 0) { const int blk = t >> 2; if (blk < u.qb) bs = (sel >> blk) & 1u; else needmask = (64 * t + 63 > qlo); }
    if (KIND == 2) needmask = !((64 * t + 63 <= qlo) && (64 * t >= qlo + 31 - 128));
    const bool unset = (m == -INFINITY);
    const float mref = unset ? 0.f : m;
    const float nv = bs ? -mref : -1e30f;
    f32x16 negt;
#pragma unroll
    for (int r = 0; r < 16; ++r) negt[r] = nv;
    f32x16 p0 = __builtin_amdgcn_mfma_f32_32x32x16_bf16(ka[0], qf[0], negt, 0, 0, 0);
    f32x16 p1 = __builtin_amdgcn_mfma_f32_32x32x16_bf16(kc[0], qf[0], negt, 0, 0, 0);
#pragma unroll
    for (int ks = 1; ks < 4; ++ks) {
        p0 = __builtin_amdgcn_mfma_f32_32x32x16_bf16(ka[ks], qf[ks], p0, 0, 0, 0);
        p1 = __builtin_amdgcn_mfma_f32_32x32x16_bf16(kc[ks], qf[ks], p1, 0, 0, 0);
    }
    if (needmask) {
#pragma unroll
        for (int r = 0; r < 16; ++r) {
            const int j0 = 64 * t + crow(r, hi), j1 = j0 + 32;
            bool v0 = j0 <= qi, v1 = j1 <= qi;
            if (KIND == 2) { v0 = v0 && (j0 >= qi - 128); v1 = v1 && (j1 >= qi - 128); }
            p0[r] = v0 ? p0[r] : -INFINITY; p1[r] = v1 ? p1[r] : -INFINITY;
        }
    }
    float rm = __builtin_fmaxf(p0[0], p1[0]);
#pragma unroll
    for (int r = 1; r < 16; ++r) rm = __builtin_fmaxf(__builtin_fmaxf(rm, p0[r]), p1[r]);
    rm = xmax(rm);
    const bool trig = bs && (rm > 8.0f || (unset && rm > -1e29f));
    if (__any(trig)) {
        const float dl = trig ? rm : 0.f;
        const float alpha = (trig && !unset) ? __builtin_amdgcn_exp2f(-dl) : 1.0f;
        m = trig ? (mref + dl) : m;
#pragma unroll
        for (int r = 0; r < 16; ++r) { p0[r] -= dl; p1[r] -= dl; o0[r] *= alpha; o1[r] *= alpha; o2[r] *= alpha; }
    }
#pragma unroll
    for (int r = 0; r < 16; ++r) { p0[r] = __builtin_amdgcn_exp2f(p0[r]); p1[r] = __builtin_amdgcn_exp2f(p1[r]); }
    bf16x8 pf[2][2];
#pragma unroll
    for (int s = 0; s < 2; ++s) {
        u32x4p w0, w1;
        w0.x = pg8::cvt_pk_bf16(p0[8 * s + 0], p0[8 * s + 1]); w0.y = pg8::cvt_pk_bf16(p0[8 * s + 2], p0[8 * s + 3]); w0.z = pg8::cvt_pk_bf16(p0[8 * s + 4], p0[8 * s + 5]); w0.w = pg8::cvt_pk_bf16(p0[8 * s + 6], p0[8 * s + 7]);
        w1.x = pg8::cvt_pk_bf16(p1[8 * s + 0], p1[8 * s + 1]); w1.y = pg8::cvt_pk_bf16(p1[8 * s + 2], p1[8 * s + 3]); w1.z = pg8::cvt_pk_bf16(p1[8 * s + 4], p1[8 * s + 5]); w1.w = pg8::cvt_pk_bf16(p1[8 * s + 6], p1[8 * s + 7]);
        pf[0][s] = __builtin_bit_cast(bf16x8, w0); pf[1][s] = __builtin_bit_cast(bf16x8, w1);
    }
    const bf16x8 ones = (bf16x8){0x3F80, 0x3F80, 0x3F80, 0x3F80, 0x3F80, 0x3F80, 0x3F80, 0x3F80};
#pragma unroll
    for (int sub_ = 0; sub_ < 2; ++sub_)
#pragma unroll
        for (int s = 0; s < 2; ++s) {
            o0 = __builtin_amdgcn_mfma_f32_32x32x16_bf16(va[sub_][s], pf[sub_][s], o0, 0, 0, 0);
            o1 = __builtin_amdgcn_mfma_f32_32x32x16_bf16(vc[sub_][s], pf[sub_][s], o1, 0, 0, 0);
            o2 = __builtin_amdgcn_mfma_f32_32x32x16_bf16(ones, pf[sub_][s], o2, 0, 0, 0);
        }
}

template <int KIND> __device__ __forceinline__ void run_unit(LAS unsigned char* lds, const Unit& u) {
    int tid_ = threadIdx.x; asm volatile("" : "+v"(tid_));
    const int tid = tid_, lane = tid & 63, wid = __builtin_amdgcn_readfirstlane(tid >> 6), ql = lane & 31, hi = lane >> 5;
    const bool wactive = (32 * wid) < u.nq;
    const int srow = tid >> 3, sch = tid & 7;
    const unsigned kdst = (unsigned)(srow * KP + sch * 16), vdst = (unsigned)(KBUF + srow * VP + sch * 16);
    v4u kA, vA, kB, vB;
#define ATT_LOAD(KR, VR, t) do { const size_t r_ = (size_t)(u.krow0 + (64 * (t) + srow) * u.kstride) * u.kvpitch + sch * 8; KR = *(const GAS v4u*)(u.K + r_); VR = *(const GAS v4u*)(u.V + r_); } while (0)
#define ATT_WRITE(KR, VR, b) do { *(LAS v4u*)(lds + (b) * BUF + kdst) = KR; *(LAS v4u*)(lds + (b) * BUF + vdst) = VR; } while (0)
    ATT_LOAD(kA, vA, u.t_lo);
    if (u.t_lo + 1 < u.t_hi) ATT_LOAD(kB, vB, u.t_lo + 1);
    const int qi = u.qidx0 + 32 * wid + ql;
    const size_t qrow = (size_t)(u.qrow0 + (32 * wid + ql) * u.qstride);
    bf16x8 qf[4];
#pragma unroll
    for (int ks = 0; ks < 4; ++ks) qf[ks] = wactive ? *(const bf16x8*)(u.Q + qrow * 1024 + 16 * ks + 8 * hi) : (bf16x8){0, 0, 0, 0, 0, 0, 0, 0};
    unsigned sel = 0xffu;
    if (KIND == 0) {
        float gsc[7];
#pragma unroll
        for (int n = 0; n < 7; ++n) { gsc[n] = -INFINITY;
            if (n < u.qb) { const float* kp = u.ksum + n * 384 + 8 * hi; float s = 0.f;
#pragma unroll
                for (int ks = 0; ks < 4; ++ks) { const f32x4 k0 = *(const f32x4*)(kp + 16 * ks), k1 = *(const f32x4*)(kp + 16 * ks + 4);
#pragma unroll
                    for (int j = 0; j < 4; ++j) { s += bf2f((bf16)qf[ks][j]) * k0[j]; s += bf2f((bf16)qf[ks][4 + j]) * k1[j]; } }
                s = xsum(s); gsc[n] = s; } }
        sel = 0u;
#pragma unroll
        for (int r = 0; r < 3; ++r) { int best = -1; float bv = -INFINITY;
#pragma unroll
            for (int n = 0; n < 7; ++n) if (n < u.qb && !((sel >> n) & 1u) && gsc[n] > bv) { bv = gsc[n]; best = n; }
            if (best >= 0) sel |= 1u << best; }
    }
    float m = -INFINITY; f32x16 o0 = {}, o1 = {}, o2 = {};
    ATT_WRITE(kA, vA, 0); if (u.t_lo + 1 < u.t_hi) ATT_WRITE(kB, vB, 1);
    __syncthreads();
    const unsigned koff = (unsigned)(ql * KP + 16 * hi);
    const unsigned voff = (unsigned)(KBUF + (4 * hi + ((lane & 15) >> 2)) * VP + ((lane >> 4) & 1) * 32 + (lane & 3) * 8);
#define ATT_NEED(t) (wactive && !(KIND == 0 && ((t) >> 2) == u.qb && 64 * (t) > u.qidx0 + 32 * wid + 31) && !(KIND == 2 && (64 * (t) > u.qidx0 + 32 * wid + 31 || 64 * (t) + 63 < u.qidx0 + 32 * wid - 128)))
    for (int t = u.t_lo; t < u.t_hi; t += 2) {
        const bool more = (t + 2 < u.t_hi), more2 = (t + 3 < u.t_hi);
        if (more) ATT_LOAD(kA, vA, t + 2);
        if (more2) ATT_LOAD(kB, vB, t + 3);
        if (ATT_NEED(t)) att_tile<KIND>(lds, u, t, wid, qi, hi, koff, voff, sel, qf, m, o0, o1, o2);
        if (t + 1 < u.t_hi) { if (ATT_NEED(t + 1)) att_tile<KIND>(lds + BUF, u, t + 1, wid, qi, hi, koff, voff, sel, qf, m, o0, o1, o2); }
        __syncthreads();
        if (more) { ATT_WRITE(kA, vA, 0); if (more2) ATT_WRITE(kB, vB, 1); __syncthreads(); }
    }
    if (wactive) {
        const float lt = o2[0]; const float inv = 1.0f / lt;
        bf16* orow = u.O + qrow * 1024;
#pragma unroll
        for (int g = 0; g < 4; ++g) {
            unsigned long long w0 = (unsigned long long)pg8::cvt_pk_bf16(o0[4 * g] * inv, o0[4 * g + 1] * inv) | ((unsigned long long)pg8::cvt_pk_bf16(o0[4 * g + 2] * inv, o0[4 * g + 3] * inv) << 32);
            unsigned long long w1 = (unsigned long long)pg8::cvt_pk_bf16(o1[4 * g] * inv, o1[4 * g + 1] * inv) | ((unsigned long long)pg8::cvt_pk_bf16(o1[4 * g + 2] * inv, o1[4 * g + 3] * inv) << 32);
            *(unsigned long long*)(orow + 8 * g + 4 * hi) = w0; *(unsigned long long*)(orow + 32 + 8 * g + 4 * hi) = w1;
        }
        if (KIND == 2) { if (hi == 0) u.lse[(size_t)(32 * wid + ql) * u.lse_stride] = m + __builtin_log2f(lt); }
    }
#undef ATT_LOAD
#undef ATT_WRITE
#undef ATT_NEED
}

constexpr int N_UNITS = 1152;
__device__ __forceinline__ void make_unit(int idx, Unit& u, bf16* ZQ, const bf16* ZKV, const bf16* MKV, const float* KSUM, float* LSE) {
    u.qstride = 1; u.nq = 256; u.kstride = 1; u.qb = 0; u.ksum = nullptr; u.lse = nullptr; u.lse_stride = 0; u.qidx0 = 0;
    int mb = -1, mqb = 0;
    if (idx < 288) { mqb = 7 - idx / 48; mb = idx % 48; }
    else if (idx < 336) { mqb = 1; mb = idx - 288; }
    else if (idx >= 592 && idx < 640) { mqb = 0; mb = idx - 592; }
    if (mb >= 0) {
        const int b = mb / 6, h = mb % 6;
        u.kind = 0; u.Q = ZQ + 384 + h * 64; u.O = ZQ + 384 + h * 64; u.qrow0 = b * SEQ + 256 * mqb;
        u.K = ZKV + 768 + h * 64; u.V = ZKV + 1152 + h * 64; u.kvpitch = 1536; u.krow0 = b * SEQ;
        u.t_lo = 0; u.t_hi = 4 * (mqb + 1); u.qidx0 = 256 * mqb; u.qb = mqb; u.ksum = KSUM + (size_t)(b * 8) * 384 + h * 64;
        return;
    }
    if (idx >= 640 && idx < 896) {
        const int i = idx - 640, bh = i >> 3, blk = i & 7, b = bh >> 2, h = bh & 3;
        u.kind = 1; u.Q = ZQ + 768 + h * 64; u.O = ZQ + 768 + h * 64; u.qrow0 = b * SEQ + 256 * blk;
        u.K = MKV + h * 64; u.V = MKV + 256 + h * 64; u.kvpitch = 512; u.krow0 = b * 256; u.t_lo = 0; u.t_hi = 4;
        return;
    }
    u.kind = 2; u.kvpitch = 1536; u.lse_stride = 6;
    int g, b, h, r, m0, nq;
    if (idx < 464) { const int i = idx - 336; g = 0; b = i >> 4; h = (i >> 3) & 1; r = 0; m0 = 256 * (i & 7); nq = 256; }
    else if (idx < 592) { const int i = idx - 464; g = 1; b = i >> 4; h = (i >> 3) & 1; r = (i >> 1) & 3; m0 = 256 * (i & 1); nq = 256; }
    else { const int i = idx - 896; g = 2; b = i >> 5; h = (i >> 4) & 1; r = i & 15; m0 = 0; nq = 128; }
    const int dil = (g == 0) ? 1 : (g == 1) ? 4 : 16, hc = (2 * g + h) * 64;
    u.Q = ZQ + hc; u.O = ZQ + hc; u.qstride = dil; u.nq = nq; u.qrow0 = b * SEQ + m0 * dil + r;
    u.K = ZKV + hc; u.V = ZKV + 384 + hc; u.krow0 = b * SEQ + r; u.kstride = dil;
    u.t_lo = (m0 >= 128) ? (m0 - 128) / 64 : 0; u.t_hi = (m0 + nq) / 64; u.qidx0 = m0;
    u.lse = LSE + (size_t)u.qrow0 * 6 + (2 * g + h); u.lse_stride = 6 * dil;
}
}
struct Args { const float* in[14]; float* out; unsigned char* ws; int ph_lo, ph_hi, li, pad; };
constexpr int I_INQ = 16 * 80, I_ING = 16 * 96, I_PA = 2 * 32, I_PB = 6 * 32, I_PM = 4 * 32, I_O = 16 * 32, I_MKV = 16 * 16, I_UP = 16 * 128, I_DN = 64 * 32;
constexpr int I_LAYER = I_INQ + I_MKV + I_ING + I_PA + I_PB + I_PM + I_O + I_UP + I_DN, I_EARLY = I_INQ + I_MKV;
__device__ __forceinline__ TrD tr_desc(const float* const* in, unsigned char* ws, int it) {
    const int l = it / I_LAYER; int r = it % I_LAYER;
    unsigned char* wl = ws + WS_W + (size_t)l * W_LAYER; TrD d;
    if (r < I_INQ) { const int kb = r / 80, nb = r % 80; d = TrD{in[3] + (size_t)l * D * DIN, in[2] + l * D, (bf16*)(wl + W_IN), DIN, 1024, 64 * kb, 32 * nb, win_dest_row(32 * nb), 0}; return d; } r -= I_INQ;
    if (r < I_MKV) { const int kb = r / 16, nb = r % 16; d = TrD{in[9] + (size_t)l * D * 512, in[8] + l * D, (bf16*)(wl + W_MKV), 512, 1024, 64 * kb, 32 * nb, 32 * nb, 0}; return d; } r -= I_MKV;
    if (r < I_ING) { const int kb = r / 96, nb = 80 + r % 96; d = TrD{in[3] + (size_t)l * D * DIN, in[2] + l * D, (bf16*)(wl + W_IN), DIN, 1024, 64 * kb, 32 * nb, win_dest_row(32 * nb), 0}; return d; } r -= I_ING;
    if (r < I_PA) { const int kb = r / 32, nb = r % 32; d = TrD{in[4] + (size_t)l * 128 * D, nullptr, (bf16*)(wl + W_P), D, 1024, 64 * kb, 32 * nb, 32 * nb, 0}; return d; } r -= I_PA;
    if (r < I_PB) { const int kb = r / 32, nb = r % 32; d = TrD{in[5] + (size_t)l * 384 * D, nullptr, (bf16*)(wl + W_P), D, 1024, 64 * kb, 32 * nb, 32 * nb, 384}; return d; } r -= I_PB;
    if (r < I_PM) { const int kb = r / 32, nb = r % 32; d = TrD{in[6] + (size_t)l * 256 * D, nullptr, (bf16*)(wl + W_P), D, 1024, 64 * kb, 32 * nb, 32 * nb, 768}; return d; } r -= I_PM;
    if (r < I_O) { const int kb = r / 32, nb = r % 32; d = TrD{in[7] + (size_t)l * D * D, nullptr, (bf16*)(wl + W_O), D, 1024, 64 * kb, 32 * nb, 32 * nb, 0}; return d; } r -= I_O;
    if (r < I_UP) { const int kb = r / 128, nb = r % 128; d = TrD{in[11] + (size_t)l * D * FF, in[10] + l * D, (bf16*)(wl + W_UP), FF, 1024, 64 * kb, 32 * nb, 32 * nb, 0}; return d; } r -= I_UP;
    { const int kb = r / 32, nb = r % 32; d = TrD{in[12] + (size_t)l * FF * D, nullptr, (bf16*)(wl + W_DN), D, 4096, 64 * kb, 32 * nb, 32 * nb, 0}; return d; }
}

namespace pg8 {
struct EpiFinal {
    static constexpr bool PERM = true, AFTER_DRAIN = true;
    __device__ static bool stores16(const Unit&) { return true; }
    const bf16_t* xb; float* ssq; float* out; const float* gain; const XcdBarrier* bar;
    __device__ __forceinline__ void fused(f32x4 (&acc)[2][2][4][2], const Unit& u, int wr, int wc, int, int, PG8_LAS unsigned char* lds, int, int) const {
        int te_ = threadIdx.x; asm volatile("" : "+v"(te_) :: "memory"); const int fr = te_ & 15, fq = (te_ & 63) >> 4;
        PG8_LAS float* P = (PG8_LAS float*)lds;
        const int row0 = u.pm * BM + wr * 64 + fr, col0 = u.pn * BM + wc * 32 + 8 * fq;
        const unsigned o0 = (unsigned)row0 * 1024u + (unsigned)col0;
#pragma unroll
        for (int ai = 0; ai < 2; ++ai) {
            u32x4 bs[4][2];
#pragma unroll
            for (int m = 0; m < 4; ++m)
#pragma unroll
                for (int bj = 0; bj < 2; ++bj) bs[m][bj] = *(const u32x4*)(xb + (o0 + (unsigned)((ai * HALF + m * 16) * 1024 + bj * HALF)));
#pragma unroll
            for (int m = 0; m < 4; ++m) { float sq = 0.f;
#pragma unroll
                for (int bj = 0; bj < 2; ++bj) { float b[8]; unpack8(bs[m][bj], b);
                    acc[ai][bj][m][0] = acc[ai][bj][m][0] + (f32x4){b[0], b[1], b[2], b[3]}; acc[ai][bj][m][1] = acc[ai][bj][m][1] + (f32x4){b[4], b[5], b[6], b[7]};
                    const f32x4 x0 = acc[ai][bj][m][0], x1 = acc[ai][bj][m][1];
                    sq += (x0[0] * x0[0] + x0[1] * x0[1]) + (x0[2] * x0[2] + x0[3] * x0[3]) + (x1[0] * x1[0] + x1[1] * x1[1]) + (x1[2] * x1[2] + x1[3] * x1[3]); }
                sq = xsum16(sq); sq = xsum32(sq);
                if (fq == 0) P[(ai * HALF + wr * 64 + m * 16 + fr) * 4 + wc] = sq; }
        }
        asm volatile("s_waitcnt lgkmcnt(0)" ::: "memory"); __builtin_amdgcn_s_barrier(); asm volatile("" ::: "memory");
        if (te_ < 256) { const f32x4 p = *(PG8_LAS const f32x4*)(P + te_ * 4); ssq[(unsigned)(u.pm * BM + te_) * 4u + (unsigned)u.pn] = (p[0] + p[1]) + (p[2] + p[3]); }
        xcd_barrier(*bar);
        float rs[8]; rstd8(ssq, row0, fq, rs);
#pragma unroll
        for (int bj = 0; bj < 2; ++bj) { const f32x4 g0 = *(const f32x4*)(gain + col0 + bj * HALF), g1 = *(const f32x4*)(gain + col0 + bj * HALF + 4);
#pragma unroll
            for (int ai = 0; ai < 2; ++ai)
#pragma unroll
                for (int m = 0; m < 4; ++m) { const float r = rs[ai * 4 + m]; float* op = out + (o0 + (unsigned)((ai * HALF + m * 16) * 1024 + bj * HALF));
                    *(f32x4*)op = acc[ai][bj][m][0] * r * g0; *(f32x4*)(op + 4) = acc[ai][bj][m][1] * r * g1; } }
    }
};
}
constexpr int N_PHASES = 16;
#ifndef MK_ONE_LAUNCH
#define MK_ONE_LAUNCH 1
#endif
__global__ void __launch_bounds__(NWAVES * 64, 2) mega(Args args) {
    extern __shared__ __attribute__((aligned(16))) unsigned char lds_raw[];
    LAS unsigned char* lds = (LAS unsigned char*)lds_raw;
    volatile LAS unsigned* MISC = (volatile LAS unsigned*)(lds + MISC_OFF);
    const int tid = threadIdx.x, lane = tid & 63, wave = __builtin_amdgcn_readfirstlane(tid >> 6);
    const int G = gridDim.x; const int bx = blockIdx.x; const int vcu = (G % 8 == 0) ? (bx % 8) * (G / 8) + bx / 8 : bx;
    unsigned char* ws = args.ws;
    gu32* ctl = (gu32*)(ws + WS_CTL);
    for (int u = tid; u < (LDS_BYTES - LDSCTL_OFF) / 4; u += NWAVES * 64) ((LAS unsigned*)(lds + LDSCTL_OFF))[u] = 0u;
    __syncthreads();
    XcdBarrier bar; bar.bar = (unsigned*)(ctl + CW_BAR); bar.x = 0; bar.st = nullptr;
    if (MK_ONE_LAUNCH) bar = xcd_barrier_post((unsigned*)(ctl + CW_BAR), MISC + 8);
    const int lo = args.ph_lo, hi = args.ph_hi;
#define IN(k) (lo <= (k) && (k) < hi)
#ifndef MK_PROBE
#define MK_PROBE 0
#endif
#if MK_PROBE
    unsigned long long* const TS = (unsigned long long*)(ws + 512 * 1024);
#define STAMP(k) do { if (blockIdx.x == 0) { __hip_atomic_store(TS + (k), rt(), __ATOMIC_RELAXED, __HIP_MEMORY_SCOPE_AGENT); } } while (0)
#else
#define STAMP(k) do { } while (0)
#endif
#define SEAM(k) do { if (IN(k) && IN((k) + 1)) xcd_barrier(bar); STAMP((k) + 1); } while (0)
    STAMP(0);
    const float* x_in = args.in[0]; const float* mem = args.in[1];
    float* out = args.out;
    float* ROPE = (float*)(ws + WS_ROPE); float* SSQ = (float*)(ws + WS_SSQ); float* LSE = (float*)(ws + WS_LSE);
    bf16* MKV = (bf16*)(ws + WS_MKV); bf16* MEMN = (bf16*)(ws + WS_MEMN); bf16* XB = (bf16*)(ws + WS_XB);
    bf16* ZQ = (bf16*)(ws + WS_ZQ); bf16* ZKV = (bf16*)(ws + WS_ZKV); bf16* ZG = (bf16*)(ws + WS_ZG); bf16* U = (bf16*)(ws + WS_U);
    const int gw = vcu * NWAVES + wave, NGW = G * NWAVES;

    if (IN(0)) {
        LAS float* scr = (LAS float*)(lds + RING_OFF + wave * 16384);
        const float* const* intab = (const float* const*)(ws + WS_PTRS);
        if (tid == 0) { const float** tb = (const float**)(ws + WS_PTRS);
            tb[0] = args.in[0]; tb[1] = args.in[1]; tb[2] = args.in[2]; tb[3] = args.in[3]; tb[4] = args.in[4]; tb[5] = args.in[5]; tb[6] = args.in[6];
            tb[7] = args.in[7]; tb[8] = args.in[8]; tb[9] = args.in[9]; tb[10] = args.in[10]; tb[11] = args.in[11]; tb[12] = args.in[12]; tb[13] = args.in[13]; }
        asm volatile("s_waitcnt vmcnt(0)" ::: "memory"); __syncthreads();
        for (int it = gw; it < I_EARLY; it += 2 * NGW) {
            const bool two = (it + NGW) < I_EARLY;
            const TrD d0 = tr_desc(intab, ws, it), d1 = tr_desc(intab, ws, two ? it + NGW : it);
            f32x4 v0[8], v1[8]; float g0[8], g1[8];
            tr_load(d0, v0, g0, lane); if (two) tr_load(d1, v1, g1, lane);
            tr_fin(d0, v0, g0, scr, lane); if (two) tr_fin(d1, v1, g1, scr, lane);
        }
        for (int it = gw; it < 2 * 1024; it += NGW) { const int l = it >> 10, n = it & 1023; bf16* p = (bf16*)(ws + WS_W + (size_t)l * W_LAYER + W_P) + (size_t)n * 1024 + 128;
            if (lane < 32) ((GAS v4u*)p)[lane] = (v4u){0u, 0u, 0u, 0u}; }
        for (int e = bx * (NWAVES * 64) + tid; e < SEQ * 8; e += G * NWAVES * 64) { const int pos = e >> 3, i = e & 7;
            const float invf = (float)(1.0 / pow(500000.0, (double)i / 8.0)); const float ang = (float)pos * invf;
            const double rev = (double)ang * 0.15915494309189535; const float fr_ = (float)(rev - floor(rev));
            const _Float16 ch = (_Float16)__builtin_amdgcn_cosf(fr_), sh = (_Float16)__builtin_amdgcn_sinf(fr_);
            ((unsigned*)ROPE)[pos * 8 + i] = (unsigned)__builtin_bit_cast(unsigned short, ch) | ((unsigned)__builtin_bit_cast(unsigned short, sh) << 16); }
        for (int m = gw; m < T; m += 2 * NGW) { const int m1 = m + NGW;
            const GAS f32x4* xr = (const GAS f32x4*)(x_in + (size_t)m * D) + lane; const GAS f32x4* xr1 = (const GAS f32x4*)(x_in + (size_t)m1 * D) + lane; f32x4 v[4], w[4]; float s = 0.f, s1 = 0.f;
#pragma unroll
            for (int j = 0; j < 4; ++j) { v[j] = __builtin_nontemporal_load(xr + 64 * j); w[j] = __builtin_nontemporal_load(xr1 + 64 * j); }
#pragma unroll
            for (int j = 0; j < 4; ++j) { s += (v[j].x * v[j].x + v[j].y * v[j].y) + (v[j].z * v[j].z + v[j].w * v[j].w); s1 += (w[j].x * w[j].x + w[j].y * w[j].y) + (w[j].z * w[j].z + w[j].w * w[j].w); }
            s = wave_sum(s); s1 = wave_sum(s1);
            GAS unsigned long long* o8 = (GAS unsigned long long*)(XB + (size_t)m * D) + lane; GAS unsigned long long* o81 = (GAS unsigned long long*)(XB + (size_t)m1 * D) + lane;
#pragma unroll
            for (int j = 0; j < 4; ++j) { o8[64 * j] = (unsigned long long)pk2(v[j].x, v[j].y) | ((unsigned long long)pk2(v[j].z, v[j].w) << 32); o81[64 * j] = (unsigned long long)pk2(w[j].x, w[j].y) | ((unsigned long long)pk2(w[j].z, w[j].w) << 32); }
            if (lane < 4) { SSQ[(size_t)m * 4 + lane] = (lane == 0) ? s : 0.f; SSQ[(size_t)m1 * 4 + lane] = (lane == 0) ? s1 : 0.f; } }
        for (int m = gw; m < NMEMROWS; m += NGW) { const GAS f32x4* xr = (const GAS f32x4*)(mem + (size_t)m * D) + lane; f32x4 v[4]; float s = 0.f;
#pragma unroll
            for (int j = 0; j < 4; ++j) { v[j] = __builtin_nontemporal_load(xr + 64 * j); s += (v[j].x * v[j].x + v[j].y * v[j].y) + (v[j].z * v[j].z + v[j].w * v[j].w); }
            const float rstd = 1.0f / sqrtf(wave_sum(s) * (1.0f / 1024.0f) + 1e-6f);
            GAS unsigned long long* o8 = (GAS unsigned long long*)(MEMN + (size_t)m * D) + lane;
#pragma unroll
            for (int j = 0; j < 4; ++j) o8[64 * j] = (unsigned long long)pk2(v[j].x * rstd, v[j].y * rstd) | ((unsigned long long)pk2(v[j].z * rstd, v[j].w * rstd) << 32); }
    }
    SEAM(0);

    for (int l = 0; l < 2; ++l) {
        const int pb = 1 + 7 * l;
        unsigned char* wl = ws + WS_W + (size_t)l * W_LAYER;
        const bf16* WIN_t = (const bf16*)(wl + W_IN); const bf16* WUP_t = (const bf16*)(wl + W_UP); const bf16* WDN_t = (const bf16*)(wl + W_DN);
        const bf16* WO_t = (const bf16*)(wl + W_O); const bf16* WP_t = (const bf16*)(wl + W_P); const bf16* WMKV_t = (const bf16*)(wl + W_MKV);
        float* KSUM = (float*)(ws + WS_KSUM) + (size_t)l * 64 * 6 * 64;
        if (IN(pb + 0)) {
            { pg8::Gemm g{XB, WIN_t, 1024, 1024, 1024, nullptr, nullptr}; pg8::StaticOrder S; S.init(T, NQKV, G, bx);
              pg8::EpiQKV E{ZQ, ZKV, SSQ, (const unsigned*)ROPE, KSUM};
              pg8::gemm_phase<pg8::EpiQKV, pg8::StaticOrder, true, true>(lds + RING_OFF, g, S, E); }
            { pg8::Gemm g{MEMN, WMKV_t, 1024, 1024, 1024, nullptr, nullptr}; pg8::StaticOrder S; S.init(NMEMROWS, 512, G, (bx + 128) % G);
              pg8::EpiPlain E{MKV, 512};
              pg8::gemm_phase<pg8::EpiPlain, pg8::StaticOrder, true, true>(lds + RING_OFF, g, S, E); }
        }
        const int conv0 = (G > 160) ? 144 : 0;
        if (IN(pb + 0) && bx >= conv0) {
            LAS float* scr = (LAS float*)(lds + RING_OFF + wave * 16384);
            int tl_ = threadIdx.x; asm volatile("" : "+v"(tl_)); const int ln = tl_ & 63;
            const int rank = (bx - conv0) * NWAVES + wave, nrank = (G - conv0) * NWAVES; const float* const* intab2 = (const float* const*)(ws + WS_PTRS);
            const int it_lo = (l == 0) ? I_EARLY : I_LAYER + I_EARLY, it_hi = (l == 0) ? I_LAYER + I_EARLY : 2 * I_LAYER;
            for (int it = it_lo + rank; it < it_hi; it += 2 * nrank) {
                const bool two = (it + nrank) < it_hi;
                const TrD d0 = tr_desc(intab2, ws, it), d1 = tr_desc(intab2, ws, two ? it + nrank : it);
                f32x4 v0[8], v1[8]; float g0[8], g1[8];
                tr_load(d0, v0, g0, ln); tr_load(d1, v1, g1, ln);
                tr_fin(d0, v0, g0, scr, ln); if (two) tr_fin(d1, v1, g1, scr, ln);
            }
        }
        SEAM(pb + 0);
        if (IN(pb + 1)) {
            unsigned* qcnt = (unsigned*)(ctl + CW_QUEUE + 64 * l);
            for (;;) {
                if (threadIdx.x == 0) MISC[16] = __hip_atomic_fetch_add(qcnt, 1u, __ATOMIC_RELAXED, __HIP_MEMORY_SCOPE_AGENT);
                __syncthreads();
                const int idx = (int)MISC[16];
                if (idx >= att::N_UNITS) break;
                att::Unit au; att::make_unit(idx, au, ZQ, ZKV, MKV, KSUM, LSE);
                if (au.kind == 0) att::run_unit<0>(lds + RING_OFF, au); else if (au.kind == 1) att::run_unit<1>(lds + RING_OFF, au); else att::run_unit<2>(lds + RING_OFF, au);
            }
        }
        SEAM(pb + 1);
        if (IN(pb + 2)) {
            { int tl_ = threadIdx.x; asm volatile("" : "+v"(tl_)); const int ln = tl_ & 63, h = ln >> 5, c = 2 * (ln & 31);
              for (int row = gw; row < T; row += NGW) {
                const float l0 = LSE[(size_t)row * 6 + h], l1 = LSE[(size_t)row * 6 + 2 + h], l2 = LSE[(size_t)row * 6 + 4 + h];
                bf16* zr = ZQ + (size_t)row * 1024;
                const unsigned a0 = *(const GAS unsigned*)(zr + h * 64 + c), a1 = *(const GAS unsigned*)(zr + (2 + h) * 64 + c), a2 = *(const GAS unsigned*)(zr + (4 + h) * 64 + c);
                const float mx = fmaxf(l0, fmaxf(l1, l2));
                float w0 = __builtin_amdgcn_exp2f(l0 - mx), w1 = __builtin_amdgcn_exp2f(l1 - mx), w2 = __builtin_amdgcn_exp2f(l2 - mx);
                const float inv = 1.0f / (w0 + w1 + w2); w0 *= inv; w1 *= inv; w2 *= inv;
                const float lo = w0 * __uint_as_float(a0 << 16) + w1 * __uint_as_float(a1 << 16) + w2 * __uint_as_float(a2 << 16);
                const float hi_ = w0 * __uint_as_float(a0 & 0xffff0000u) + w1 * __uint_as_float(a1 & 0xffff0000u) + w2 * __uint_as_float(a2 & 0xffff0000u);
                const unsigned res = pk2(lo, hi_);
                asm volatile("s_waitcnt vmcnt(0)" ::: "memory");
                *(GAS unsigned*)(zr + h * 64 + c) = res; *(GAS unsigned*)(zr + 128 + 2 * ln) = 0u;
              } }
        }
        SEAM(pb + 2);
        if (IN(pb + 3)) {
            pg8::GateProjOrder S; S.init(T, D, G, bx);
            pg8::Gemm g{XB, WIN_t + (size_t)NQKV * 1024, 1024, 1024, 1024, ZQ, WP_t}; pg8::EpiGateProj E{ZG, ws + WS_GP, SSQ};
            pg8::gemm_phase<pg8::EpiGateProj, pg8::GateProjOrder, true, true>(lds + RING_OFF, g, S, E);
        }
        SEAM(pb + 3);
        if (IN(pb + 4)) {
            pg8::Gemm g{ZG, WO_t, 1024, 1024, 1024, nullptr, nullptr}; pg8::StaticOrder S; S.init(T, D, G, bx);
            pg8::EpiRes E{XB, SSQ};
            pg8::gemm_phase<pg8::EpiRes, pg8::StaticOrder, false, true>(lds + RING_OFF, g, S, E);
        }
        SEAM(pb + 4);
        if (IN(pb + 5)) {
            pg8::Gemm g{XB, WUP_t, 1024, 1024, 1024, nullptr, nullptr}; pg8::StaticOrder S; S.init(T, FF, G, bx);
            pg8::EpiUp E{U, SSQ};
            pg8::gemm_phase<pg8::EpiUp, pg8::StaticOrder, true, true>(lds + RING_OFF, g, S, E);
        }
        SEAM(pb + 5);
        if (IN(pb + 6)) {
            pg8::Gemm g{U, WDN_t, 4096, 4096, 4096, nullptr, nullptr}; pg8::StaticOrder S; S.init(T, D, G, bx);
            if (l == 0) { pg8::EpiRes E{XB, SSQ}; pg8::gemm_phase<pg8::EpiRes, pg8::StaticOrder, false, true>(lds + RING_OFF, g, S, E); }
            else { pg8::EpiFinal E{XB, SSQ, out, args.in[13], &bar}; pg8::gemm_phase<pg8::EpiFinal, pg8::StaticOrder, false, true>(lds + RING_OFF, g, S, E); }
        }
#if MK_PROBE
        SEAM(pb + 6);
#else
        if (l == 0) SEAM(pb + 6);
#endif
    }
#if MK_PROBE
    if (IN(15)) {
        int tl_ = threadIdx.x; asm volatile("" : "+v"(tl_)); const int lane = tl_ & 63;
        const float pbv = (float)(__hip_atomic_load(TS + PROBE_B_HI, __ATOMIC_RELAXED, __HIP_MEMORY_SCOPE_AGENT) - __hip_atomic_load(TS + PROBE_B_LO, __ATOMIC_RELAXED, __HIP_MEMORY_SCOPE_AGENT)) * (PROBE_SCALE * 0.1f);
        for (int m = gw; m < T; m += NGW) { GAS f32x4* xr = (GAS f32x4*)(out + (size_t)m * D) + lane;
#pragma unroll
            for (int j = 0; j < 4; ++j) { f32x4 v = xr[64 * j]; v = v + pbv; xr[64 * j] = v; } }
        if (blockIdx.x == 0) { asm volatile("s_waitcnt vmcnt(0)" ::: "memory"); __syncthreads();
            const float pa = (float)(__hip_atomic_load(TS + PROBE_A_HI, __ATOMIC_RELAXED, __HIP_MEMORY_SCOPE_AGENT) - __hip_atomic_load(TS + PROBE_A_LO, __ATOMIC_RELAXED, __HIP_MEMORY_SCOPE_AGENT)) * PROBE_SCALE;
            if (threadIdx.x == 0) out[0] += pa; }
    }
#endif
#undef IN
#undef SEAM
}

extern "C" void kernel_launch(void* const* d_in, const int* in_sizes, int n_in, void* d_out, int out_size, void* d_ws, size_t ws_size, hipStream_t stream) {
    static int grid = 0;
    if (grid == 0) {
        if (n_in != 14 || in_sizes[0] != T * D || out_size != T * D || ws_size < WS_END) { fprintf(stderr, "kernel_launch: unexpected shapes (n_in %d, in0 %d, out %d, ws %zu)\n", n_in, n_in > 0 ? in_sizes[0] : -1, out_size, ws_size); grid = -1; return; }
        int dev = 0, cus = 0;
        if (hipGetDevice(&dev) != hipSuccess || hipDeviceGetAttribute(&cus, hipDeviceAttributeMultiprocessorCount, dev) != hipSuccess) { grid = -1; return; }
        if (hipFuncSetAttribute((const void*)mega, hipFuncAttributeMaxDynamicSharedMemorySize, LDS_BYTES) != hipSuccess) { fprintf(stderr, "kernel_launch: hipFuncSetAttribute failed\n"); grid = -1; return; }
        int per_cu = 0;
        (void)hipOccupancyMaxActiveBlocksPerMultiprocessor(&per_cu, (const void*)mega, NWAVES * 64, LDS_BYTES);
        (void)hipGetLastError();
        grid = cus;
    }
    if (grid < 0) return;
    (void)hipMemsetAsync((char*)d_ws + WS_CTL, 0, CTL_ZERO_BYTES, stream);
    Args a{};
    for (int i = 0; i < 14; ++i) a.in[i] = (const float*)d_in[i];
    a.out = (float*)d_out; a.ws = (unsigned char*)d_ws; a.li = 0; a.pad = 0;
#if MK_ONE_LAUNCH
    a.ph_lo = 0; a.ph_hi = N_PHASES;
    hipLaunchKernelGGL(mega, dim3(grid), dim3(NWAVES * 64), LDS_BYTES, stream, a);
#else
    for (int ph = 0; ph < N_PHASES; ++ph) {
        a.ph_lo = ph; a.ph_hi = ph + 1;
        hipLaunchKernelGGL(mega, dim3(grid), dim3(NWAVES * 64), LDS_BYTES, stream, a);
    }
#endif
}
```
